# Optimizing an MI355X kernel written in HIP

```python
import jax, jax.numpy as jnp
from jax import lax
import numpy as np

D_MODEL = 1024
BATCH = 8
SEQ = 4096
DEPTH = 2

HEAD_DIM = 64
A_HEADS = 8
A_KV_RANK = 128
IDX_HEADS = 4
IDX_DIM = 64
IDX_TOPK_MAX = 256
B_HEADS = 8
C_HEADS = 16
MOBA_BLOCK = 256
MOBA_TOPK = 3
Q_BLOCK = 128
D_FF = -(-8 * D_MODEL // (3 * 256)) * 256
DEEPNORM_ALPHA = (2 * DEPTH) ** 0.25
DEEPNORM_BETA = (8 * DEPTH) ** -0.25
EVEN_IN = A_HEADS * HEAD_DIM + A_KV_RANK + IDX_HEADS * IDX_DIM + IDX_DIM + IDX_HEADS + 3 * B_HEADS * HEAD_DIM
ODD_IN = 3 * C_HEADS * HEAD_DIM
NEG = -1e30

kernel_name = "hybrid_dsa_stickbreak_moba_deepnorm"


def layer_norm(x, g, b, eps=1e-5):
    xf = x.astype(jnp.float32)
    mu = xf.mean(-1, keepdims=True)
    var = jnp.square(xf - mu).mean(-1, keepdims=True)
    return ((xf - mu) * lax.rsqrt(var + eps) * g.astype(jnp.float32) + b.astype(jnp.float32)).astype(x.dtype)


def rms_norm(x, g, eps=1e-6):
    xf = x.astype(jnp.float32)
    return (xf * lax.rsqrt(jnp.mean(xf * xf, -1, keepdims=True) + eps) * g.astype(jnp.float32)).astype(x.dtype)


def alibi_slopes(n):
    return jnp.asarray(2.0 ** (-8.0 * np.arange(1, n + 1) / n), dtype=jnp.float32)


def to_qblocks(t):
    B, S = t.shape[:2]
    return t.reshape((B, S // Q_BLOCK, Q_BLOCK) + t.shape[2:]).swapaxes(0, 1)


def from_qblocks(t):
    t = t.swapaxes(0, 1)
    return t.reshape((t.shape[0], t.shape[1] * t.shape[2]) + t.shape[3:])


def dsa_attention(q, c_kv, q_idx, k_idx, w_idx, w_uk, w_uv):
    B, S = q.shape[:2]
    topk = min(IDX_TOPK_MAX, S // 4)
    nq = S // Q_BLOCK
    slopes = alibi_slopes(A_HEADS)
    key_pos = jnp.arange(S)
    q_lat = jnp.einsum('bshd,hdr->bshr', q, w_uk)

    def block(args):
        qb, qib, wb, t0 = args
        tq = t0 + jnp.arange(Q_BLOCK)
        causal = key_pos[None, :] <= tq[:, None]
        dots = jnp.einsum('bqhd,bsd->bqhs', qib, k_idx).astype(jnp.float32) * IDX_DIM ** -0.5
        index = jnp.einsum('bqh,bqhs->bqs', wb.astype(jnp.float32), jax.nn.relu(dots))
        index = jnp.where(causal[None], index, NEG)
        _, sel = lax.top_k(index, topk)
        c_sel = jax.vmap(lambda c, i: c[i])(c_kv, sel)
        valid = sel <= tq[None, :, None]
        dist = (tq[None, :, None] - sel).astype(jnp.float32)
        logits = jnp.einsum('bqhr,bqkr->bqhk', qb, c_sel).astype(jnp.float32) * HEAD_DIM ** -0.5
        logits = logits - slopes[None, None, :, None] * dist[:, :, None, :]
        logits = jnp.where(valid[:, :, None, :], logits, NEG)
        p = jax.nn.softmax(logits, axis=-1).astype(c_sel.dtype)
        o_lat = jnp.einsum('bqhk,bqkr->bqhr', p, c_sel)
        return jnp.einsum('bqhr,hrd->bqhd', o_lat, w_uv)

    out = lax.map(block, (to_qblocks(q_lat), to_qblocks(q_idx), to_qblocks(w_idx),
                          jnp.arange(nq, dtype=jnp.int32) * Q_BLOCK))
    return from_qblocks(out)


def stick_breaking_attention(q, k, v):
    B, S = q.shape[:2]
    nq = S // Q_BLOCK
    key_pos = jnp.arange(S)

    def block(args):
        qb, t0 = args
        tq = t0 + jnp.arange(Q_BLOCK)
        strict = (key_pos[None, :] < tq[:, None])[None, None]
        z = jnp.einsum('bqhd,bshd->bhqs', qb, k).astype(jnp.float32) * HEAD_DIM ** -0.5
        log_beta = jax.nn.log_sigmoid(z)
        log_1m = jnp.where(strict, jax.nn.log_sigmoid(-z), 0.0)
        log_rem = lax.cumsum(log_1m, axis=3, reverse=True) - log_1m
        a = jnp.where(strict, jnp.exp(log_beta + log_rem), 0.0)
        return jnp.einsum('bhqs,bshd->bqhd', a.astype(v.dtype), v)

    out = lax.map(block, (to_qblocks(q), jnp.arange(nq, dtype=jnp.int32) * Q_BLOCK))
    return from_qblocks(out)


def moba_attention(q, k, v):
    B, S, H, D = q.shape
    P = MOBA_BLOCK
    nb = -(-S // P)
    kk = min(MOBA_TOPK, nb)
    pad = nb * P - S
    kp = jnp.pad(k, ((0, 0), (0, pad), (0, 0), (0, 0)))
    vp = jnp.pad(v, ((0, 0), (0, pad), (0, 0), (0, 0)))
    k_blk = kp.reshape(B, nb, P, H, D).transpose(0, 3, 1, 2, 4)
    v_blk = vp.reshape(B, nb, P, H, D).transpose(0, 3, 1, 2, 4)
    k_mean = k_blk.astype(jnp.float32).mean(axis=3)
    slopes = alibi_slopes(H)
    nq = S // Q_BLOCK
    q_chunks = q.reshape(B * nq, Q_BLOCK, H, D)
    b_ids = jnp.repeat(jnp.arange(B, dtype=jnp.int32), nq)
    t0s = jnp.tile(jnp.arange(nq, dtype=jnp.int32) * Q_BLOCK, B)
    hidx = jnp.arange(H)[None, :, None]
    blk_off = jnp.arange(P)

    def block(args):
        qb, b, t0 = args
        kb, vb, km = k_blk[b], v_blk[b], k_mean[b]
        tq = t0 + jnp.arange(Q_BLOCK)
        cur = t0 // P
        gate = jnp.einsum('qhd,hnd->qhn', qb.astype(jnp.float32), km)
        gate = jnp.where((jnp.arange(nb) < cur)[None, None, :], gate, NEG)
        _, sel = lax.top_k(gate, kk)
        k_sel = kb[hidx, sel]
        v_sel = vb[hidx, sel]
        k_own = lax.dynamic_index_in_dim(kb, cur, axis=1, keepdims=False)
        v_own = lax.dynamic_index_in_dim(vb, cur, axis=1, keepdims=False)
        scale = HEAD_DIM ** -0.5
        s_sel = jnp.einsum('qhd,qhrpd->qhrp', qb, k_sel).astype(jnp.float32) * scale
        s_own = jnp.einsum('qhd,hpd->qhp', qb, k_own).astype(jnp.float32) * scale
        pos_sel = sel[..., None] * P + blk_off
        pos_own = cur * P + blk_off
        s_sel = s_sel - slopes[None, :, None, None] * (tq[:, None, None, None] - pos_sel).astype(jnp.float32)
        s_own = s_own - slopes[None, :, None] * (tq[:, None, None] - pos_own[None, None, :]).astype(jnp.float32)
        s_sel = jnp.where((sel < cur)[..., None], s_sel, NEG)
        s_own = jnp.where((pos_own[None, :] <= tq[:, None])[:, None, :], s_own, NEG)
        logits = jnp.concatenate([s_sel.reshape(Q_BLOCK, H, kk * P), s_own], axis=-1)
        p = jax.nn.softmax(logits, axis=-1).astype(v.dtype)
        p_sel = p[..., :kk * P].reshape(Q_BLOCK, H, kk, P)
        p_own = p[..., kk * P:]
        return (jnp.einsum('qhrp,qhrpd->qhd', p_sel, v_sel)
                + jnp.einsum('qhp,hpd->qhd', p_own, v_own))

    out = lax.map(block, (q_chunks, b_ids, t0s))
    return out.reshape(B, S, H, D)


def dsa_stick_mixer(x, w_in, kv_norm, w_uk, w_uv, w_out):
    B, S, _ = x.shape
    widths = (A_HEADS * HEAD_DIM, A_KV_RANK, IDX_HEADS * IDX_DIM, IDX_DIM, IDX_HEADS,
              B_HEADS * HEAD_DIM, B_HEADS * HEAD_DIM, B_HEADS * HEAD_DIM)
    cuts = np.cumsum(widths)[:-1].tolist()
    q_a, c_kv, q_idx, k_idx, w_idx, q_b, k_b, v_b = jnp.split(x @ w_in, cuts, axis=-1)
    o_a = dsa_attention(q_a.reshape(B, S, A_HEADS, HEAD_DIM), rms_norm(c_kv, kv_norm),
                        q_idx.reshape(B, S, IDX_HEADS, IDX_DIM), k_idx,
                        w_idx * IDX_HEADS ** -0.5, w_uk, w_uv)
    o_b = stick_breaking_attention(q_b.reshape(B, S, B_HEADS, HEAD_DIM),
                                   k_b.reshape(B, S, B_HEADS, HEAD_DIM),
                                   v_b.reshape(B, S, B_HEADS, HEAD_DIM))
    o = jnp.concatenate([o_a.reshape(B, S, -1), o_b.reshape(B, S, -1)], axis=-1)
    return o @ w_out


def moba_mixer(x, w_in, w_out):
    B, S, _ = x.shape
    q, k, v = jnp.split(x @ w_in, 3, axis=-1)
    shp = (B, S, C_HEADS, HEAD_DIM)
    o = moba_attention(q.reshape(shp), k.reshape(shp), v.reshape(shp))
    return o.reshape(B, S, -1) @ w_out


def swiglu(x, w_gate, w_up, w_down):
    return (jax.nn.silu(x @ w_gate) * (x @ w_up)) @ w_down


def setup_inputs(seed: int = 0) -> dict:
    key = jax.random.key(seed)
    ks = jax.random.split(key, 16)
    n_even = (DEPTH + 1) // 2
    n_odd = DEPTH // 2
    f32 = jnp.float32
    nrm = lambda k, shp, s: jax.random.normal(k, shp, f32) * s
    return {
        "x": jax.random.normal(ks[0], (BATCH, SEQ, D_MODEL), f32),
        "even_w_in": nrm(ks[1], (n_even, D_MODEL, EVEN_IN), D_MODEL ** -0.5),
        "even_kv_norm": 1.0 + nrm(ks[2], (n_even, A_KV_RANK), 0.05),
        "even_w_uk": nrm(ks[3], (n_even, A_HEADS, HEAD_DIM, A_KV_RANK), A_KV_RANK ** -0.5),
        "even_w_uv": nrm(ks[4], (n_even, A_HEADS, A_KV_RANK, HEAD_DIM), A_KV_RANK ** -0.5),
        "even_w_out": nrm(ks[5], (n_even, D_MODEL, D_MODEL), D_MODEL ** -0.5 * DEEPNORM_BETA),
        "odd_w_in": nrm(ks[6], (n_odd, D_MODEL, ODD_IN), D_MODEL ** -0.5),
        "odd_w_out": nrm(ks[7], (n_odd, D_MODEL, D_MODEL), D_MODEL ** -0.5 * DEEPNORM_BETA),
        "ln_mix_g": 1.0 + nrm(ks[8], (DEPTH, D_MODEL), 0.05),
        "ln_mix_b": nrm(ks[9], (DEPTH, D_MODEL), 0.02),
        "ffn_gate": nrm(ks[10], (DEPTH, D_MODEL, D_FF), D_MODEL ** -0.5),
        "ffn_up": nrm(ks[11], (DEPTH, D_MODEL, D_FF), D_MODEL ** -0.5),
        "ffn_down": nrm(ks[12], (DEPTH, D_FF, D_MODEL), D_FF ** -0.5 * DEEPNORM_BETA),
        "ln_ffn_g": 1.0 + nrm(ks[13], (DEPTH, D_MODEL), 0.05),
        "ln_ffn_b": nrm(ks[14], (DEPTH, D_MODEL), 0.02),
    }


def reference(x, even_w_in, even_kv_norm, even_w_uk, even_w_uv, even_w_out, odd_w_in, odd_w_out,
              ln_mix_g, ln_mix_b, ffn_gate, ffn_up, ffn_down, ln_ffn_g, ln_ffn_b):
    h = x
    for i in range(DEPTH):
        j = i // 2
        if i % 2 == 0:
            m = dsa_stick_mixer(h, even_w_in[j], even_kv_norm[j], even_w_uk[j], even_w_uv[j], even_w_out[j])
        else:
            m = moba_mixer(h, odd_w_in[j], odd_w_out[j])
        h = layer_norm(DEEPNORM_ALPHA * h + m, ln_mix_g[i], ln_mix_b[i])
        f = swiglu(h, ffn_gate[i], ffn_up[i], ffn_down[i])
        h = layer_norm(DEEPNORM_ALPHA * h + f, ln_ffn_g[i], ln_ffn_b[i])
    return h
```

```cpp
#include <hip/hip_runtime.h>
#include <hip/hip_cooperative_groups.h>
#include <hip/hip_bf16.h>
#include <cstdio>
#include <cstdint>
#include <cmath>
namespace cg = cooperative_groups;
namespace pg8 {
#define PG8_LAS __attribute__((address_space(3)))
typedef unsigned short bf16_t;
typedef short bf16x8 __attribute__((ext_vector_type(8)));
typedef float f32x4 __attribute__((ext_vector_type(4)));
typedef unsigned u32x4 __attribute__((ext_vector_type(4)));
constexpr int BM = 256, BK = 64, HALF = 128, HTB = HALF * BK * 2  , STAGE_BYTES = 8 * HTB, NXCD = 8, WGM = 8;

__host__ __device__ __forceinline__ int lds_byte(int r, int c) { const int st = (r >> 4) * 2 + (c >> 5), rr = r & 15, cc = c & 31, ob = rr * 64 + cc * 2; return st * 1024 + (ob ^ (((ob >> 9) & 1) << 5)); }
__host__ __device__ __forceinline__ void stage_rc(int b, int& R, int& C) { const int st = b / 1024, sb = b % 1024, swz = sb ^ (((sb >> 9) & 1) << 5); R = (st >> 1) * 16 + swz / 64; C = (st & 1) * 32 + (swz % 64) / 2; }
__host__ __device__ __forceinline__ int perm32(int rho) { const int n = rho >> 4, i = rho & 15; return 8 * (i >> 2) + 4 * n + (i & 3); }

struct Unit { int pm, pn; };
struct Gemm { const bf16_t* A; const bf16_t* Bt; int M, N, K; };

struct StaticOrder {
    int nM, nN, nwg, G, c;
    __host__ __device__ void init(int M, int N, int G_, int c_) { nM = M / BM; nN = N / BM; nwg = nM * nN; G = G_; c = c_; }
    __host__ __device__ bool next(int i, Unit& u) const {
        const long L = (long)i * G + c; if (L >= nwg) return false;
        int wgid = (int)L; { const int q = nwg / NXCD, r = nwg % NXCD, xcd = wgid % NXCD, off = wgid / NXCD; wgid = (xcd < r ? xcd * (q + 1) : r * (q + 1) + (xcd - r) * q) + off; }
        const int nig = WGM * nN, gid = wgid / nig, fm = gid * WGM, gsz = (nM - fm) < WGM ? (nM - fm) : WGM;
        u.pm = fm + ((wgid % nig) % gsz); u.pn = (wgid % nig) / gsz; return true;
    }
    __device__ __forceinline__ void a_ready(const Unit&) const {}
    __device__ __forceinline__ void done(const Unit&) const {}
};

__device__ __forceinline__ unsigned cvt_pk_bf16(float lo, float hi) { unsigned r; asm volatile("v_cvt_pk_bf16_f32 %0, %1, %2" : "=v"(r) : "v"(lo), "v"(hi)); return r; }
typedef float f32x2 __attribute__((ext_vector_type(2)));
__device__ __forceinline__ f32x2 gelu_pk(f32x2 v) {
    const f32x2 av = __builtin_elementwise_abs(v), d = av * 0.2316418882f + 1.0f;
    f32x2 t; t.x = __builtin_amdgcn_rcpf(d.x); t.y = __builtin_amdgcn_rcpf(d.y);
    f32x2 q = t * 0.5307027145f + (-0.7265760135f); q = q * t + 0.7107068705f; q = q * t + (-0.142248368f); q = q * t + 0.127414796f; q = q * t;
    const f32x2 s = (v * v) * (-0.72134752044f);
    f32x2 e; e.x = __builtin_amdgcn_exp2f(s.x); e.y = __builtin_amdgcn_exp2f(s.y);
    const f32x2 m = v * (q * e), r = v - m;
    f32x2 o; o.x = v.x < 0.f ? m.x : r.x; o.y = v.y < 0.f ? m.y : r.y; return o;
}

template <int ACT  > struct EpiBf16 {
    static constexpr bool PERM = true, AFTER_DRAIN = false; static_assert(ACT == 0 || ACT == 1, "EpiBf16: ACT is 0 (none) or 1 (gelu_pk)");
    bf16_t* O; int ldc; const float* bias; int split_cols; size_t split_stride; float scale0;
    __device__ __forceinline__ void operator()(const f32x4 (&acc)[2][2][4][2], const Unit& u, int wr, int wc, int fr, int fq) const {
        const int row0 = u.pm * BM + wr * 64 + fr; int colt = u.pn * BM; bf16_t* base = O;
        float sc = 1.f; if (split_cols) { const int t = colt / split_cols; base += (size_t)t * split_stride; colt -= t * split_cols; if (t == 0) sc = scale0; }
        const int col0 = colt + wc * 32 + 8 * fq, bcol0 = u.pn * BM + wc * 32 + 8 * fq;
        f32x4 bv[2][2];
#pragma unroll
        for (int bj = 0; bj < 2; ++bj)
#pragma unroll
            for (int n = 0; n < 2; ++n) bv[bj][n] = bias ? *(const f32x4*)(bias + bcol0 + bj * HALF + 4 * n) : (f32x4){0.f, 0.f, 0.f, 0.f};
#pragma unroll
        for (int ai = 0; ai < 2; ++ai)
#pragma unroll
            for (int m = 0; m < 4; ++m) { bf16_t* rowp = base + (size_t)(row0 + ai * HALF + m * 16) * ldc + col0;
#pragma unroll
                for (int bj = 0; bj < 2; ++bj) { f32x4 v0 = acc[ai][bj][m][0] + bv[bj][0], v1 = acc[ai][bj][m][1] + bv[bj][1];
                    if (ACT == 1) { f32x2 a = gelu_pk((f32x2){v0[0], v0[1]}), b = gelu_pk((f32x2){v0[2], v0[3]}), c = gelu_pk((f32x2){v1[0], v1[1]}), d = gelu_pk((f32x2){v1[2], v1[3]});
                        v0 = (f32x4){a.x, a.y, b.x, b.y}; v1 = (f32x4){c.x, c.y, d.x, d.y}; }
                    v0 = v0 * sc; v1 = v1 * sc; u32x4 w; w.x = cvt_pk_bf16(v0[0], v0[1]); w.y = cvt_pk_bf16(v0[2], v0[3]); w.z = cvt_pk_bf16(v1[0], v1[1]); w.w = cvt_pk_bf16(v1[2], v1[3]);
                    *(u32x4*)(rowp + bj * HALF) = w; } }
    }
};

struct PanelStats {
    unsigned* xbuf;
    unsigned* cnt;
    unsigned* tmo;
    int ntn; float eps;
    unsigned code;
    __device__ __forceinline__ bool run(const f32x4 (&v)[2][2][4][2], const Unit& u, int wr, int wc, int fr, int fq, PG8_LAS unsigned char* lds, int wid, int lane) const {
        typedef float f32x2v __attribute__((ext_vector_type(2)));
        PG8_LAS f32x2v* P = (PG8_LAS f32x2v*)lds;
        PG8_LAS f32x2v* S = (PG8_LAS f32x2v*)(lds + 8192);
        PG8_LAS unsigned* flag = (PG8_LAS unsigned*)(lds + 8192 + 2048);
#pragma unroll
        for (int ai = 0; ai < 2; ++ai)
#pragma unroll
            for (int m = 0; m < 4; ++m) {
                float s = 0.f;
#pragma unroll
                for (int bj = 0; bj < 2; ++bj)
#pragma unroll
                    for (int n = 0; n < 2; ++n) { const f32x4 x = v[ai][bj][m][n]; s += (x[0] + x[1]) + (x[2] + x[3]); }
                s += __shfl_xor(s, 16); s += __shfl_xor(s, 32);
                const float mw = s * (1.0f / 64.0f); float q = 0.f;
#pragma unroll
                for (int bj = 0; bj < 2; ++bj)
#pragma unroll
                    for (int n = 0; n < 2; ++n) { const f32x4 d = v[ai][bj][m][n] - mw; q += (d[0] * d[0] + d[1] * d[1]) + (d[2] * d[2] + d[3] * d[3]); }
                q += __shfl_xor(q, 16); q += __shfl_xor(q, 32);
                if (fq == 0) P[(ai * HALF + wr * 64 + m * 16 + fr) * 4 + wc] = (f32x2v){mw, q};
            }
        asm volatile("s_waitcnt lgkmcnt(0)" ::: "memory"); __builtin_amdgcn_s_barrier(); asm volatile("" ::: "memory");
#if defined(BROKEN_EXCHANGE_NO_WAIT)
#warning BROKEN CONTROL BUILD: the row-statistics exchange does not wait; results are wrong by design
        if (blockIdx.x >= 64) { const long long t0_ = clock64(); while (clock64() - t0_ < 60000) __builtin_amdgcn_s_sleep(8); }
#endif
        const int row = wid * 32 + (lane & 31);
        if (lane < 32) {
            const f32x2v a = P[row * 4 + 0], b = P[row * 4 + 1], c = P[row * 4 + 2], d = P[row * 4 + 3];
            const float mt = (a.x + b.x + c.x + d.x) * 0.25f;
            const float da = a.x - mt, db = b.x - mt, dc = c.x - mt, dd = d.x - mt;
            const float m2 = (a.y + b.y) + (c.y + d.y) + 64.0f * ((da * da + db * db) + (dc * dc + dd * dd));
            unsigned long long* slot = (unsigned long long*)xbuf + ((size_t)(u.pm * BM + row) * 4 + u.pn);
            __hip_atomic_store(slot, ((unsigned long long)__float_as_uint(m2) << 32) | __float_as_uint(mt), __ATOMIC_RELAXED, __HIP_MEMORY_SCOPE_AGENT);
        }
        asm volatile("s_waitcnt vmcnt(0)" ::: "memory");
        if (lane == 0) __hip_atomic_fetch_add(cnt + 64 * u.pm, 1u, __ATOMIC_RELAXED, __HIP_MEMORY_SCOPE_AGENT);
        if (wid == 0) {
            bool dead = false; const unsigned long long t0 = __builtin_amdgcn_s_memrealtime(); const unsigned want = 8u * (unsigned)ntn;
            for (;;) {
#if defined(BROKEN_EXCHANGE_NO_WAIT)
                break;
#endif
                if ((unsigned)__builtin_amdgcn_readfirstlane(__hip_atomic_load(cnt + 64 * u.pm, __ATOMIC_RELAXED, __HIP_MEMORY_SCOPE_AGENT)) >= want) break;
                if (__builtin_amdgcn_s_memrealtime() - t0 > 2000000ull) {
                    if (lane == 0) { unsigned expect = 0u; __hip_atomic_compare_exchange_strong(tmo + 1, &expect, code | (unsigned)(u.pm & 0xff), __ATOMIC_RELAXED, __ATOMIC_RELAXED, __HIP_MEMORY_SCOPE_AGENT);
                                     __hip_atomic_store(tmo, 1u, __ATOMIC_RELAXED, __HIP_MEMORY_SCOPE_AGENT); }
                    dead = true; break; }
                __builtin_amdgcn_s_sleep(2);
            }
            __builtin_amdgcn_fence(__ATOMIC_ACQUIRE, "agent");
            if (lane == 0) flag[0] = dead ? 1u : 0u;
        }
        asm volatile("s_waitcnt vmcnt(0) lgkmcnt(0)" ::: "memory"); __builtin_amdgcn_s_barrier(); asm volatile("" ::: "memory");
        const bool bad = flag[0] != 0u;
        if (lane < 32) {
            const unsigned long long* slot = (const unsigned long long*)xbuf + (size_t)(u.pm * BM + row) * 4; float mt[4], m2[4]; float ms = 0.f;
#pragma unroll
            for (int t = 0; t < 4; ++t) { if (t < ntn) { const unsigned long long w = __hip_atomic_load(slot + t, __ATOMIC_RELAXED, __HIP_MEMORY_SCOPE_AGENT); mt[t] = __uint_as_float((unsigned)w); m2[t] = __uint_as_float((unsigned)(w >> 32)); } else { mt[t] = 0.f; m2[t] = 0.f; } ms += mt[t]; }
            const float mean = ms / (float)ntn; float q = 0.f;
#pragma unroll
            for (int t = 0; t < 4; ++t) if (t < ntn) { const float dm = mt[t] - mean; q += m2[t] + 256.0f * dm * dm; }
            S[row] = (f32x2v){mean, 1.0f / sqrtf(q / (256.0f * (float)ntn) + eps)};
        }
        asm volatile("s_waitcnt lgkmcnt(0)" ::: "memory"); __builtin_amdgcn_s_barrier(); asm volatile("" ::: "memory");
        return bad;
    }
};
struct EpiLnRes {
    static constexpr bool PERM = false, AFTER_DRAIN = true;
    const float* base; float* out; int ldc; const float* bias; PanelStats st; unsigned poison;
    __device__ __forceinline__ void fused(f32x4 (&acc)[2][2][4][2], const Unit& u, int wr, int wc, int fr, int fq, PG8_LAS unsigned char* lds, int wid, int lane) const {
        typedef float f32x2v __attribute__((ext_vector_type(2)));
        const PG8_LAS f32x2v* S = (const PG8_LAS f32x2v*)(lds + 8192);
        const int col0 = u.pn * BM + wc * 32 + 4 * fq;
#pragma unroll
        for (int bj = 0; bj < 2; ++bj)
#pragma unroll
            for (int n = 0; n < 2; ++n) { const f32x4 bv = bias ? *(const f32x4*)(bias + col0 + bj * HALF + n * 16) : (f32x4){0.f, 0.f, 0.f, 0.f};
#pragma unroll
                for (int ai = 0; ai < 2; ++ai)
#pragma unroll
                    for (int m = 0; m < 4; ++m) acc[ai][bj][m][n] += bv; }
        f32x4 pre[4][2][2];
#pragma unroll
        for (int m = 0; m < 4; ++m) { const size_t off = (size_t)(u.pm * BM + wr * 64 + m * 16 + fr) * ldc + col0;
#pragma unroll
            for (int bj = 0; bj < 2; ++bj)
#pragma unroll
                for (int n = 0; n < 2; ++n) pre[m][bj][n] = *(const f32x4*)(base + off + bj * HALF + n * 16); }
        const bool bad = st.run(acc, u, wr, wc, fr, fq, lds, wid, lane) || poison != 0u;
        const float qnan = __builtin_nanf("");
#pragma unroll
        for (int ai = 0; ai < 2; ++ai)
#pragma unroll
            for (int m = 0; m < 4; ++m) { const int r = ai * HALF + wr * 64 + m * 16 + fr; const f32x2v sr = S[r]; const size_t off = (size_t)(u.pm * BM + r) * ldc + col0;
#pragma unroll
                for (int bj = 0; bj < 2; ++bj)
#pragma unroll
                    for (int n = 0; n < 2; ++n) { const f32x4 bs = ai == 0 ? pre[m][bj][n] : *(const f32x4*)(base + off + bj * HALF + n * 16); f32x4 o = bs + (acc[ai][bj][m][n] - sr.x) * sr.y;
                        if (bad) o = (f32x4){qnan, qnan, qnan, qnan}; *(f32x4*)(out + off + bj * HALF + n * 16) = o; }
                if (m & 1) asm volatile("" ::: "memory"); }
    }
};
struct EpiLnResLn {
    static constexpr bool PERM = false, AFTER_DRAIN = true;
    const float* base; float* out; bf16_t* xn; int ldc; const float* bias; PanelStats st1, st2; unsigned poison;
    __device__ __forceinline__ void fused(f32x4 (&acc)[2][2][4][2], const Unit& u, int wr, int wc, int fr, int fq, PG8_LAS unsigned char* lds, int wid, int lane) const {
        typedef float f32x2v __attribute__((ext_vector_type(2))); typedef unsigned u32x2v __attribute__((ext_vector_type(2)));
        const PG8_LAS f32x2v* S = (const PG8_LAS f32x2v*)(lds + 8192);
        const int col0 = u.pn * BM + wc * 32 + 4 * fq;
#pragma unroll
        for (int bj = 0; bj < 2; ++bj)
#pragma unroll
            for (int n = 0; n < 2; ++n) { const f32x4 bv = bias ? *(const f32x4*)(bias + col0 + bj * HALF + n * 16) : (f32x4){0.f, 0.f, 0.f, 0.f};
#pragma unroll
                for (int ai = 0; ai < 2; ++ai)
#pragma unroll
                    for (int m = 0; m < 4; ++m) acc[ai][bj][m][n] += bv; }
        bool bad = st1.run(acc, u, wr, wc, fr, fq, lds, wid, lane) || poison != 0u;
        const float qnan = __builtin_nanf("");
#pragma unroll
        for (int ai = 0; ai < 2; ++ai)
#pragma unroll
            for (int m = 0; m < 4; ++m) { const int r = ai * HALF + wr * 64 + m * 16 + fr; const f32x2v sr = S[r]; const size_t off = (size_t)(u.pm * BM + r) * ldc + col0;
#pragma unroll
                for (int bj = 0; bj < 2; ++bj)
#pragma unroll
                    for (int n = 0; n < 2; ++n) { const f32x4 bs = *(const f32x4*)(base + off + bj * HALF + n * 16); acc[ai][bj][m][n] = bs + (acc[ai][bj][m][n] - sr.x) * sr.y; }
                asm volatile("" : "+v"(acc[ai][0][m][0]), "+v"(acc[ai][0][m][1]), "+v"(acc[ai][1][m][0]), "+v"(acc[ai][1][m][1]));
                if (m & 1) asm volatile("" ::: "memory"); }
        const bool bad1 = bad;
        bad = st2.run(acc, u, wr, wc, fr, fq, lds, wid, lane) || bad;
#pragma unroll
        for (int ai = 0; ai < 2; ++ai)
#pragma unroll
            for (int m = 0; m < 4; ++m) { const int r = ai * HALF + wr * 64 + m * 16 + fr; const f32x2v sr = S[r]; const size_t off = (size_t)(u.pm * BM + r) * ldc + col0;
#pragma unroll
                for (int bj = 0; bj < 2; ++bj)
#pragma unroll
                    for (int n = 0; n < 2; ++n) { const f32x4 x1 = acc[ai][bj][m][n]; *(f32x4*)(out + off + bj * HALF + n * 16) = bad1 ? (f32x4){qnan, qnan, qnan, qnan} : x1;
                        const f32x4 o = (x1 - sr.x) * sr.y; u32x2v w; w.x = cvt_pk_bf16(o[0], o[1]); w.y = cvt_pk_bf16(o[2], o[3]);
                        if (bad) { w.x = 0x7fc07fc0u; w.y = 0x7fc07fc0u; } *(u32x2v*)(xn + off + bj * HALF + n * 16) = w; }
                asm volatile("" ::: "memory"); }
    }
};

template <class Epi, class Sched, bool ALIGN_EPI = false, bool SP2 = false>
__device__ __forceinline__ void gemm_phase(PG8_LAS unsigned char* lds, const Gemm g, const Sched& S, const Epi& E) {
    int tid_l = threadIdx.x; asm volatile("" : "+v"(tid_l));
    const int tid = tid_l, wid = __builtin_amdgcn_readfirstlane(tid >> 6), lane = tid & 63, wr = wid >> 2, wc = wid & 3, fr = lane & 15, fq = lane >> 4;
    const int K = g.K, nt = K / BK;
    unsigned voffA[2], voffB[2];
#pragma unroll
    for (int i = 0; i < 2; ++i) { int R, C; stage_rc(tid * 16 + i * 8192, R, C); const int Rb = Epi::PERM ? ((R & ~31) + perm32(R & 31)) : R;
        voffA[i] = (unsigned)(R * K + C) * 2u; voffB[i] = (unsigned)(Rb * K + C) * 2u; }
    const size_t kstep = (size_t)(BK * 2);
    const size_t hstep = (size_t)HALF * K * 2;
    const size_t tstep = 2 * hstep;
    const unsigned ldsw = (unsigned)wid * 1024u;
    const int aoff = lds_byte(wr * 64 + fr, fq * 8), boff = lds_byte(wc * 32 + fr, fq * 8);
#define PG8_SA(b, h) (((b) * 2 + (h)) * HTB)
#define PG8_SB(b, h) ((4 + (b) * 2 + (h)) * HTB)
#define PG8_STAGE(bufoff, gbase, voff) do { _Pragma("unroll") for (int _i = 0; _i < 2; ++_i) \
        __builtin_amdgcn_global_load_lds((const unsigned*)((const char*)(gbase) + (voff)[_i]), (PG8_LAS unsigned*)(lds + (bufoff) + ldsw + _i * 8192), 16, 0, 0); } while (0)
#define PG8_LDA(dst, b, h) do { _Pragma("unroll") for (int m = 0; m < 4; ++m) _Pragma("unroll") for (int k = 0; k < 2; ++k) dst[m][k] = *(const PG8_LAS bf16x8*)(lds + PG8_SA(b, h) + aoff + m * 2048 + k * 1024); } while (0)
#define PG8_LDB(dst, b, h) do { _Pragma("unroll") for (int n = 0; n < 2; ++n) _Pragma("unroll") for (int k = 0; k < 2; ++k) dst[n][k] = *(const PG8_LAS bf16x8*)(lds + PG8_SB(b, h) + boff + n * 2048 + k * 1024); } while (0)
#define PG8_MMA(ai, bj, At, Bt) do { __builtin_amdgcn_s_setprio(1); _Pragma("unroll") for (int m = 0; m < 4; ++m) _Pragma("unroll") for (int n = 0; n < 2; ++n) _Pragma("unroll") for (int k = 0; k < 2; ++k) \
        acc[ai][bj][m][n] = __builtin_amdgcn_mfma_f32_16x16x32_bf16(Bt[n][k], At[m][k], acc[ai][bj][m][n], 0, 0, 0); __builtin_amdgcn_s_setprio(0); } while (0)
#define PG8_WAIT_V(n) asm volatile("s_waitcnt vmcnt(" #n ")" ::: "memory")
#define PG8_WAIT_L(n) asm volatile("s_waitcnt lgkmcnt(" #n ")" ::: "memory")
#define PG8_BAR __builtin_amdgcn_s_barrier()
#define PG8_SCHED __builtin_amdgcn_sched_barrier(0)
    Unit cur, nxt; int ui = 0;
    if (!S.next(0, cur)) return;
    f32x4 acc[2][2][4][2];
#pragma unroll
    for (int a = 0; a < 2; ++a)
#pragma unroll
        for (int b = 0; b < 2; ++b)
#pragma unroll
            for (int m = 0; m < 4; ++m)
#pragma unroll
                for (int n = 0; n < 2; ++n) acc[a][b][m][n] = (f32x4){0.f, 0.f, 0.f, 0.f};
    bf16x8 At[4][2], B0[2][2], B1[2][2];
    const char* cA = (const char*)g.A + (size_t)cur.pm * tstep; const char* cB = (const char*)g.Bt + (size_t)cur.pn * tstep;
    S.a_ready(cur);
    if constexpr (SP2) {
        PG8_STAGE(PG8_SB(0, 0), cB, voffB); PG8_STAGE(PG8_SB(0, 1), cB + hstep, voffB); PG8_STAGE(PG8_SA(0, 0), cA, voffA); PG8_STAGE(PG8_SA(0, 1), cA + hstep, voffA);
        if (wr == 1) PG8_BAR;
        PG8_WAIT_V(2); PG8_BAR;
        PG8_STAGE(PG8_SB(1, 0), cB + kstep, voffB); PG8_STAGE(PG8_SA(1, 0), cA + kstep, voffA); PG8_STAGE(PG8_SB(1, 1), cB + hstep + kstep, voffB);
        PG8_WAIT_V(6); PG8_BAR;
    } else {
        PG8_STAGE(PG8_SB(0, 0), cB, voffB); PG8_STAGE(PG8_SA(0, 0), cA, voffA); PG8_STAGE(PG8_SB(0, 1), cB + hstep, voffB); PG8_STAGE(PG8_SA(0, 1), cA + hstep, voffA);
        if (wr == 1) PG8_BAR;
        PG8_WAIT_V(4); PG8_BAR;
        PG8_STAGE(PG8_SB(1, 0), cB + kstep, voffB); PG8_STAGE(PG8_SA(1, 0), cA + kstep, voffA); PG8_STAGE(PG8_SB(1, 1), cB + hstep + kstep, voffB);
        PG8_WAIT_V(6); PG8_BAR;
    }
    for (;;) {
        const bool has_next = S.next(ui + 1, nxt);
        const char* nA = has_next ? (const char*)g.A + (size_t)nxt.pm * tstep : cA; const char* nB = has_next ? (const char*)g.Bt + (size_t)nxt.pn * tstep : cB;
        for (int t = 0; t < nt; t += 2) {
            const bool last = (t == nt - 2);
            const char* a1 = cA + (size_t)(t + 1) * kstep;
            const char* a2 = last ? nA : cA + (size_t)(t + 2) * kstep; const char* b2 = last ? nB : cB + (size_t)(t + 2) * kstep;
            const char* a3 = a2 + kstep; const char* b3 = b2 + kstep;
            if (last && has_next) S.a_ready(nxt);
            if constexpr (SP2) {
            PG8_LDB(B0, 0, 0); PG8_LDB(B1, 0, 1); PG8_SCHED; PG8_LDA(At, 0, 0); PG8_STAGE(PG8_SA(1, 1), a1 + hstep, voffA);
            PG8_WAIT_V(8); PG8_WAIT_L(0); PG8_BAR; PG8_MMA(0, 0, At, B0); PG8_MMA(0, 1, At, B1); PG8_BAR; PG8_SCHED;
            PG8_LDA(At, 0, 1); PG8_STAGE(PG8_SB(0, 0), b2, voffB); PG8_STAGE(PG8_SB(0, 1), b2 + hstep, voffB); PG8_STAGE(PG8_SA(0, 0), a2, voffA);
            PG8_WAIT_V(8); PG8_WAIT_L(0); PG8_BAR; PG8_MMA(1, 0, At, B0); PG8_MMA(1, 1, At, B1); PG8_BAR; PG8_SCHED;
            PG8_LDB(B0, 1, 0); PG8_LDB(B1, 1, 1); PG8_SCHED; PG8_LDA(At, 1, 0); PG8_STAGE(PG8_SA(0, 1), a2 + hstep, voffA);
            PG8_WAIT_V(8); PG8_WAIT_L(0); PG8_BAR; PG8_MMA(0, 0, At, B0); PG8_MMA(0, 1, At, B1); PG8_BAR; PG8_SCHED;
            PG8_LDA(At, 1, 1); PG8_STAGE(PG8_SB(1, 0), b3, voffB); PG8_STAGE(PG8_SB(1, 1), b3 + hstep, voffB); PG8_STAGE(PG8_SA(1, 0), a3, voffA);
            PG8_WAIT_V(8); PG8_WAIT_L(0); PG8_BAR; PG8_MMA(1, 0, At, B0); PG8_MMA(1, 1, At, B1); PG8_BAR; PG8_SCHED;
            } else {
            PG8_LDB(B0, 0, 0); PG8_SCHED; PG8_LDA(At, 0, 0); PG8_STAGE(PG8_SA(1, 1), a1 + hstep, voffA);
            PG8_WAIT_L(8); PG8_BAR; PG8_WAIT_L(0); PG8_MMA(0, 0, At, B0); PG8_BAR; PG8_SCHED;
            PG8_LDB(B1, 0, 1); PG8_STAGE(PG8_SB(0, 0), b2, voffB);
            PG8_BAR; PG8_WAIT_L(0); PG8_MMA(0, 1, At, B1); PG8_BAR;
            PG8_LDA(At, 0, 1); PG8_STAGE(PG8_SA(0, 0), a2, voffA);
            PG8_BAR; PG8_WAIT_L(0); PG8_MMA(1, 0, At, B0); PG8_BAR; PG8_SCHED;
            PG8_STAGE(PG8_SB(0, 1), b2 + hstep, voffB);
            PG8_WAIT_V(6); PG8_BAR; PG8_MMA(1, 1, At, B1); PG8_BAR;
            PG8_LDB(B0, 1, 0); PG8_SCHED; PG8_LDA(At, 1, 0); PG8_STAGE(PG8_SA(0, 1), a2 + hstep, voffA);
            PG8_WAIT_L(8); PG8_BAR; PG8_WAIT_L(0); PG8_MMA(0, 0, At, B0); PG8_BAR; PG8_SCHED;
            PG8_LDB(B1, 1, 1); PG8_STAGE(PG8_SB(1, 0), b3, voffB);
            PG8_BAR; PG8_WAIT_L(0); PG8_MMA(0, 1, At, B1); PG8_BAR;
            PG8_LDA(At, 1, 1); PG8_STAGE(PG8_SA(1, 0), a3, voffA);
            PG8_BAR; PG8_WAIT_L(0); PG8_MMA(1, 0, At, B0); PG8_BAR; PG8_SCHED;
            PG8_STAGE(PG8_SB(1, 1), b3 + hstep, voffB);
            PG8_WAIT_V(6); PG8_BAR; PG8_MMA(1, 1, At, B1); PG8_BAR;
            }
        }
        if constexpr (ALIGN_EPI) { if (wr == 0) PG8_BAR; }
        if constexpr (!Epi::AFTER_DRAIN) { E(acc, cur, wr, wc, fr, fq); S.done(cur); }
        if (!has_next) break;
#pragma unroll
        for (int a = 0; a < 2; ++a)
#pragma unroll
            for (int b = 0; b < 2; ++b)
#pragma unroll
                for (int m = 0; m < 4; ++m)
#pragma unroll
                    for (int n = 0; n < 2; ++n) acc[a][b][m][n] = (f32x4){0.f, 0.f, 0.f, 0.f};
        cur = nxt; cA = nA; cB = nB; ++ui;
        if constexpr (ALIGN_EPI) { if (wr == 1) PG8_BAR; }
    }
    PG8_WAIT_V(0);
    if constexpr (!ALIGN_EPI) { if (wr == 0) PG8_BAR; }
    PG8_BAR;
    if constexpr (Epi::AFTER_DRAIN) { E.fused(acc, cur, wr, wc, fr, fq, lds, wid, lane); S.done(cur); }
#undef PG8_SA
#undef PG8_SB
#undef PG8_STAGE
#undef PG8_LDA
#undef PG8_LDB
#undef PG8_MMA
#undef PG8_WAIT_V
#undef PG8_WAIT_L
#undef PG8_BAR
#undef PG8_SCHED
}
}
namespace pg8 {
struct EpiSwiGLU {
    static constexpr bool PERM = true, AFTER_DRAIN = false;
    bf16_t* O; int ldc;
    __device__ __forceinline__ void operator()(const f32x4 (&acc)[2][2][4][2], const Unit& u, int wr, int wc, int fr, int fq) const {
        const int row0 = u.pm * BM + wr * 64 + fr, col0 = u.pn * HALF + wc * 32 + 8 * fq;
#pragma unroll
        for (int ai = 0; ai < 2; ++ai)
#pragma unroll
            for (int m = 0; m < 4; ++m) { bf16_t* rowp = O + (size_t)(row0 + ai * HALF + m * 16) * ldc + col0;
                float v[8];
#pragma unroll
                for (int n = 0; n < 2; ++n)
#pragma unroll
                    for (int j = 0; j < 4; ++j) { const float g = acc[ai][0][m][n][j], up = acc[ai][1][m][n][j];
                        const float e = __builtin_amdgcn_exp2f(g * -1.4426950408889634f); v[4 * n + j] = g * __builtin_amdgcn_rcpf(1.0f + e) * up; }
                u32x4 w; w.x = cvt_pk_bf16(v[0], v[1]); w.y = cvt_pk_bf16(v[2], v[3]); w.z = cvt_pk_bf16(v[4], v[5]); w.w = cvt_pk_bf16(v[6], v[7]);
                *(u32x4*)rowp = w; }
    }
};
struct EpiResid {
    static constexpr bool PERM = true, AFTER_DRAIN = false;
    bf16_t* X; int ldc; float alpha;
    __device__ __forceinline__ void operator()(const f32x4 (&acc)[2][2][4][2], const Unit& u, int wr, int wc, int fr, int fq) const {
        const int row0 = u.pm * BM + wr * 64 + fr, col0 = u.pn * BM + wc * 32 + 8 * fq;
#pragma unroll
        for (int ai = 0; ai < 2; ++ai)
#pragma unroll
            for (int m = 0; m < 4; ++m) { bf16_t* rowp = X + (size_t)(row0 + ai * HALF + m * 16) * ldc + col0;
#pragma unroll
                for (int bj = 0; bj < 2; ++bj) { const u32x4 x = *(const u32x4*)(rowp + bj * HALF);
                    const f32x4 a0 = acc[ai][bj][m][0], a1 = acc[ai][bj][m][1];
                    float r[8];
                    r[0] = alpha * __uint_as_float(x.x << 16) + a0[0]; r[1] = alpha * __uint_as_float(x.x & 0xffff0000u) + a0[1];
                    r[2] = alpha * __uint_as_float(x.y << 16) + a0[2]; r[3] = alpha * __uint_as_float(x.y & 0xffff0000u) + a0[3];
                    r[4] = alpha * __uint_as_float(x.z << 16) + a1[0]; r[5] = alpha * __uint_as_float(x.z & 0xffff0000u) + a1[1];
                    r[6] = alpha * __uint_as_float(x.w << 16) + a1[2]; r[7] = alpha * __uint_as_float(x.w & 0xffff0000u) + a1[3];
                    u32x4 w; w.x = cvt_pk_bf16(r[0], r[1]); w.y = cvt_pk_bf16(r[2], r[3]); w.z = cvt_pk_bf16(r[4], r[5]); w.w = cvt_pk_bf16(r[6], r[7]);
                    *(u32x4*)(rowp + bj * HALF) = w; } }
    }
};
}
#define LAS __attribute__((address_space(3)))
typedef unsigned short bf16;
typedef short bf16x8 __attribute__((ext_vector_type(8)));
typedef short s16x4 __attribute__((ext_vector_type(4)));
typedef float f32x4 __attribute__((ext_vector_type(4)));
typedef float f32x16 __attribute__((ext_vector_type(16)));
typedef unsigned v4u __attribute__((ext_vector_type(4)));
typedef unsigned v2u __attribute__((ext_vector_type(2)));

constexpr int NWAVES = 8, NTHR = 512;
constexpr int BATCH = 8, SEQ = 4096, DM = 1024, M = BATCH * SEQ;
constexpr int NQ0 = 3072;
constexpr int C_QLAT = 0, C_CKV = 1024, C_QIDX = 1152, C_KIDX = 1408, C_QB = 1472, C_KB = 1984, C_VB = 2496, C_WIDX = 3008;
constexpr int KO0 = 1536;
constexpr int DFF = 2816, NGU = 2 * DFF;
constexpr int NQ1 = 3072;
constexpr int TOPK = 256;
constexpr float LOG2E = 1.4426950408889634f;
constexpr float C2 = 0.125f * LOG2E;
constexpr float ALPHA = 1.4142135623730951f;

constexpr size_t MiB = 1u << 20;
constexpr size_t WS_W0IN = 1 * MiB, WS_W0OUT = 7 * MiB, WS_WGU0 = 10 * MiB, WS_WGU1 = 21 * MiB, WS_WDN0 = 32 * MiB, WS_WDN1 = 38 * MiB, WS_W1IN = 44 * MiB, WS_W1OUT = 50 * MiB;
constexpr size_t WS_KMEAN = 52 * MiB, WS_ALLOW = 53 * MiB, WS_CKVN = 56 * MiB, WS_X = 64 * MiB, WS_R1 = 128 * MiB, WS_OCAT = 320 * MiB, WS_END = 416 * MiB;

constexpr int LDS_BYTES = 147456;

__device__ __forceinline__ unsigned f2bf(float f) { unsigned u = __builtin_bit_cast(unsigned, f); return (u + 0x7fffu + ((u >> 16) & 1u)) >> 16; }
__device__ __forceinline__ unsigned pk2(float lo, float hi) { return f2bf(lo) | (f2bf(hi) << 16); }
__device__ __forceinline__ float bflo(unsigned w) { return __uint_as_float(w << 16); }
__device__ __forceinline__ float bfhi(unsigned w) { return __uint_as_float(w & 0xffff0000u); }
__device__ __forceinline__ float bf1(unsigned short h) { return __uint_as_float(((unsigned)h) << 16); }
#define LDS_WAIT() asm volatile("s_waitcnt lgkmcnt(0)" ::: "memory")
__device__ __forceinline__ float wave_sum(float v) {
#pragma unroll
    for (int o = 1; o < 64; o <<= 1) v += __shfl_xor(v, o);
    return v;
}
__device__ __forceinline__ int crow(int r, int hi) { return (r & 3) + 8 * (r >> 2) + 4 * hi; }

__device__ __forceinline__ void tr_item(const float* W, int ldsrc, int k0, int c0, int cvalid, bf16* WT, int lddst, int r0, int dk0, float scale, LAS float* scr, int lane) {
#pragma unroll 8
    for (int i = 0; i < 32; ++i) { const int kk = 2 * i + (lane >> 5), c = lane & 31;
        scr[kk * 33 + c] = (c < cvalid) ? W[(size_t)(k0 + kk) * ldsrc + c0 + c] * scale : 0.f; }
    LDS_WAIT(); asm volatile("" ::: "memory");
    const int c8 = lane & 7;
#pragma unroll
    for (int j = 0; j < 4; ++j) { const int n = (lane >> 3) + 8 * j; const LAS float* s = scr + (8 * c8) * 33 + n;
        v4u o; o.x = pk2(s[0 * 33], s[1 * 33]); o.y = pk2(s[2 * 33], s[3 * 33]); o.z = pk2(s[4 * 33], s[5 * 33]); o.w = pk2(s[6 * 33], s[7 * 33]);
        *(v4u*)(WT + (size_t)(r0 + n) * lddst + dk0 + k0 + 8 * c8) = o; }
    LDS_WAIT(); asm volatile("" ::: "memory");
}
__device__ __forceinline__ void tr_job(const float* W, int ldsrc, int K, int cs, int ncols, int nvalid, bf16* WT, int lddst, int r0, int dk0, float scale, int mode,
                                       LAS float* scr, int lane, int gw, int NGW, int& rot) {
    const int ncg = ncols / 32, nitems = (K / 64) * ncg;
    int start = gw - rot; if (start < 0) start += NGW;
    for (int it = start; it < nitems; it += NGW) {
        const int kb = it / ncg, cg_ = it % ncg, crel = 32 * cg_;
        const int cv = nvalid - crel < 0 ? 0 : (nvalid - crel > 32 ? 32 : nvalid - crel);
        const int col = cs + crel;
        const int row = mode == 0 ? r0 + crel : 256 * (col / 128) + 128 * (mode - 1) + (col % 128);
        tr_item(W, ldsrc, 64 * kb, col, cv, WT, lddst, row, dk0, scale, scr, lane);
    }
    rot = (rot + nitems) % NGW;
}

template <bool FINAL> __device__ __forceinline__ void ln_row(bf16* xrow, const float* g, const float* bta, float* orow, int lane) {
    const v4u* xp = (const v4u*)xrow; v4u w[2]; float v[16]; float s = 0.f;
#pragma unroll
    for (int j = 0; j < 2; ++j) { w[j] = xp[lane + 64 * j];
        v[8 * j + 0] = bflo(w[j].x); v[8 * j + 1] = bfhi(w[j].x); v[8 * j + 2] = bflo(w[j].y); v[8 * j + 3] = bfhi(w[j].y);
        v[8 * j + 4] = bflo(w[j].z); v[8 * j + 5] = bfhi(w[j].z); v[8 * j + 6] = bflo(w[j].w); v[8 * j + 7] = bfhi(w[j].w); }
#pragma unroll
    for (int i = 0; i < 16; ++i) s += v[i];
    const float mean = wave_sum(s) * (1.f / DM); float s2 = 0.f;
#pragma unroll
    for (int i = 0; i < 16; ++i) { v[i] -= mean; s2 += v[i] * v[i]; }
    const float rstd = 1.f / sqrtf(wave_sum(s2) * (1.f / DM) + 1e-5f);
#pragma unroll
    for (int j = 0; j < 2; ++j) { const int c0 = 8 * (lane + 64 * j);
        const f32x4 g0 = *(const f32x4*)(g + c0), g1 = *(const f32x4*)(g + c0 + 4), b0 = *(const f32x4*)(bta + c0), b1 = *(const f32x4*)(bta + c0 + 4);
        float r[8];
#pragma unroll
        for (int i = 0; i < 4; ++i) { r[i] = v[8 * j + i] * rstd * g0[i] + b0[i]; r[4 + i] = v[8 * j + 4 + i] * rstd * g1[i] + b1[i]; }
        if (FINAL) { *(f32x4*)(orow + c0) = (f32x4){r[0], r[1], r[2], r[3]}; *(f32x4*)(orow + c0 + 4) = (f32x4){r[4], r[5], r[6], r[7]}; }
        else { v4u o; o.x = pk2(r[0], r[1]); o.y = pk2(r[2], r[3]); o.z = pk2(r[4], r[5]); o.w = pk2(r[6], r[7]); ((v4u*)xrow)[lane + 64 * j] = o; } }
}

__device__ __forceinline__ void stick_unit(const bf16* QKV, bf16* OCAT, int b, int h, int qt, int lane) {
    const int r32 = lane & 31, hi = lane >> 5, q0 = qt * 32, t = q0 + r32; const size_t rowb = (size_t)b * SEQ;
    bf16x8 qf[4];
    { const bf16* qp = QKV + (rowb + q0 + r32) * NQ0 + C_QB + h * 64 + hi * 8;
#pragma unroll
      for (int ks = 0; ks < 4; ++ks) qf[ks] = *(const bf16x8*)(qp + ks * 16); }
    f32x16 o0 = f32x16{}, o1 = f32x16{}; float carry = 0.f;
    for (int kt = qt; kt >= 0; --kt) {
        const int kb = kt * 32;
        const bf16* kp = QKV + (rowb + kb + r32) * NQ0 + C_KB + h * 64 + hi * 8;
        f32x16 z = f32x16{};
#pragma unroll
        for (int ks = 0; ks < 4; ++ks) { const bf16x8 kf = *(const bf16x8*)(kp + ks * 16); z = __builtin_amdgcn_mfma_f32_32x32x16_bf16(kf, qf[ks], z, 0, 0, 0); }
        bf16x8 vf[2][2];
        { const bf16* vp = QKV + (rowb + kb + 4 * hi) * NQ0 + C_VB + h * 64 + r32;
#pragma unroll
          for (int s = 0; s < 2; ++s)
#pragma unroll
            for (int dh = 0; dh < 2; ++dh)
#pragma unroll
              for (int j = 0; j < 8; ++j) vf[s][dh][j] = (short)vp[(size_t)(16 * s + 8 * (j >> 2) + (j & 3)) * NQ0 + 32 * dh]; }
        float l1m[16], L2v[16];
#pragma unroll
        for (int r = 0; r < 16; ++r) { const float zz = z[r], e = __builtin_amdgcn_exp2f(-__builtin_fabsf(zz)), lg = __builtin_amdgcn_logf(1.0f + e);
            const bool strict = (kb + crow(r, hi)) < t;
            L2v[r] = __builtin_fminf(zz, 0.f) - lg;
            l1m[r] = strict ? -(__builtin_fmaxf(zz, 0.f) + lg) : 0.f; }
        float gs[4], ps[4];
#pragma unroll
        for (int j = 0; j < 4; ++j) { gs[j] = (l1m[4 * j] + l1m[4 * j + 1]) + (l1m[4 * j + 2] + l1m[4 * j + 3]); ps[j] = __shfl_xor(gs[j], 32); }
        float a[16]; float above = carry;
#pragma unroll
        for (int j = 3; j >= 0; --j) {
            float rem = above + (hi == 0 ? ps[j] : 0.f);
#pragma unroll
            for (int i = 3; i >= 0; --i) { const int r = 4 * j + i; const bool strict = (kb + crow(r, hi)) < t;
                a[r] = strict ? __builtin_amdgcn_exp2f(L2v[r] + rem) : 0.f; rem += l1m[r]; }
            above += gs[j] + ps[j]; }
        carry = above;
        bf16x8 pa0, pa1;
#pragma unroll
        for (int j = 0; j < 8; ++j) { pa0[j] = (short)f2bf(a[j]); pa1[j] = (short)f2bf(a[8 + j]); }
        o0 = __builtin_amdgcn_mfma_f32_32x32x16_bf16(pa0, vf[0][0], o0, 0, 0, 0); o1 = __builtin_amdgcn_mfma_f32_32x32x16_bf16(pa0, vf[0][1], o1, 0, 0, 0);
        o0 = __builtin_amdgcn_mfma_f32_32x32x16_bf16(pa1, vf[1][0], o0, 0, 0, 0); o1 = __builtin_amdgcn_mfma_f32_32x32x16_bf16(pa1, vf[1][1], o1, 0, 0, 0);
        if (kt > 0 && __all(carry < -48.f)) break;
    }
    bf16* op = OCAT + (rowb + q0) * KO0 + 1024 + h * 64 + r32;
#pragma unroll
    for (int r = 0; r < 16; ++r) { op[(size_t)crow(r, hi) * KO0] = (bf16)f2bf(o0[r]); op[(size_t)crow(r, hi) * KO0 + 32] = (bf16)f2bf(o1[r]); }
}

constexpr int IX_HIST = 0, IX_HSTRIDE = 513;
constexpr int IX_STAGE = 0, IX_SROW = 272, IX_SBYTES = 32 * IX_SROW;
constexpr int IX_MASK = 69632;
constexpr int IX_SEL = IX_MASK + 16384;
constexpr int IX_ST = IX_SEL + 16384;
constexpr int IX_END = IX_ST + 2048;
static_assert(NWAVES * IX_SBYTES <= IX_MASK && 32 * IX_HSTRIDE * 4 <= IX_MASK && IX_END <= 131072, "indexer LDS map");
enum { ST_LO = 0, ST_HI = 1, ST_NEED = 2, ST_MODE = 3, ST_TGE = 4, ST_TEQ = 5, ST_TI = 6, ST_ILO = 7, ST_IHI = 8, ST_NSEL = 9 };

struct IdxTile { float v[16]; };
__device__ __forceinline__ void idx_tile(const bf16* QKV, size_t rowb, int kt, const bf16x8 (&qf)[4][4], const float (&w)[4], int r32, int hi, float (&v)[16]) {
    const bf16* kp = QKV + (rowb + 32 * kt + r32) * NQ0 + C_KIDX + hi * 8;
    bf16x8 kf[4];
#pragma unroll
    for (int ks = 0; ks < 4; ++ks) kf[ks] = *(const bf16x8*)(kp + ks * 16);
#pragma unroll
    for (int r = 0; r < 16; ++r) v[r] = 0.f;
#pragma unroll
    for (int hd = 0; hd < 4; ++hd) { f32x16 d = f32x16{};
#pragma unroll
        for (int ks = 0; ks < 4; ++ks) d = __builtin_amdgcn_mfma_f32_32x32x16_bf16(kf[ks], qf[hd][ks], d, 0, 0, 0);
#pragma unroll
        for (int r = 0; r < 16; ++r) v[r] = __builtin_fmaf(w[hd], __builtin_fmaxf(d[r], 0.f), v[r]); }
}
__device__ __forceinline__ unsigned okey(float v) {
    unsigned b = __float_as_uint(v); if ((b << 1) == 0u) b = 0u;
    return b ^ ((unsigned)((int)b >> 31) | 0x80000000u);
}
__device__ __forceinline__ int range_shift(unsigned span) {
    const int bits = 32 - __builtin_clz(span | 1u); return bits > 10 ? bits - 10 : 0;
}

__device__ __forceinline__ void dsa_unit(const bf16* QKV, const bf16* CKVN, bf16* OCAT, int b, int qt, LAS unsigned char* lds, int tid, int wave, int lane) {
    const int r32 = lane & 31, hi = lane >> 5, q0 = qt * 32, t = q0 + r32; const size_t rowb = (size_t)b * SEQ;
    LAS unsigned* HIST = (LAS unsigned*)(lds + IX_HIST); LAS unsigned* MASK = (LAS unsigned*)(lds + IX_MASK);
    LAS unsigned short* SEL = (LAS unsigned short*)(lds + IX_SEL); LAS unsigned* ST = (LAS unsigned*)(lds + IX_ST);
#define LOAD_QF() bf16x8 qf[4][4]; float w[4]; \
    { const bf16* qp = QKV + (rowb + t) * NQ0; \
      _Pragma("unroll") for (int hd = 0; hd < 4; ++hd) { w[hd] = bf1(qp[C_WIDX + hd]); \
        _Pragma("unroll") for (int ks = 0; ks < 4; ++ks) qf[hd][ks] = *(const bf16x8*)(qp + C_QIDX + hd * 64 + ks * 16 + hi * 8); } }
    const bool select_all = (q0 + 32 <= TOPK);
    if (tid < 32) { LAS unsigned* s = ST + tid * 16;
        s[ST_LO] = 0u; s[ST_HI] = 0xffffffffu; s[ST_NEED] = TOPK; s[ST_MODE] = select_all ? 2u : 0u; s[ST_TGE] = 0u; s[ST_TEQ] = 0u; s[ST_TI] = 0xffffu; s[ST_ILO] = 0u; s[ST_IHI] = (unsigned)(q0 + tid); }
    __syncthreads();
    for (int pass = 0; pass < 12; ++pass) {
        bool alldone = true;
#pragma unroll 4
        for (int q = 0; q < 32; ++q) alldone = alldone && (ST[q * 16 + ST_MODE] == 2u);
        if (alldone) break;
        for (int i = tid; i < 32 * IX_HSTRIDE; i += NTHR) HIST[i] = 0u;
        const unsigned mode = ST[r32 * 16 + ST_MODE], lo = ST[r32 * 16 + ST_LO], hi_u = ST[r32 * 16 + ST_HI], ilo = ST[r32 * 16 + ST_ILO], ihi = ST[r32 * 16 + ST_IHI];
        const int sh = range_shift(hi_u - lo), ish = range_shift(ihi - ilo);
        __syncthreads();
        { LOAD_QF();
        for (int kt = wave; kt <= qt; kt += NWAVES) {
            float v[16]; idx_tile(QKV, rowb, kt, qf, w, r32, hi, v);
#pragma unroll
            for (int r = 0; r < 16; ++r) { const int key = 32 * kt + crow(r, hi); const unsigned u = okey(v[r]);
                bool hit; unsigned bin;
                if (mode == 0u) { hit = (u >= lo) && (u <= hi_u); bin = (u - lo) >> sh; }
                else { hit = (mode == 1u) && (u == lo) && ((unsigned)key >= ilo) && ((unsigned)key <= ihi); bin = ((unsigned)key - ilo) >> ish; }
                if (hit && key <= t) __hip_atomic_fetch_add(HIST + r32 * IX_HSTRIDE + (bin >> 1), (bin & 1u) ? 0x10000u : 1u, __ATOMIC_RELAXED, __HIP_MEMORY_SCOPE_WORKGROUP); }
        } }
        __syncthreads();
        { const int q = tid >> 4, sub = tid & 15; LAS unsigned* s = ST + q * 16; const unsigned md = s[ST_MODE];
          const LAS unsigned* hq = HIST + q * IX_HSTRIDE + sub * 32; unsigned csum = 0;
#pragma unroll 8
          for (int i = 0; i < 32; ++i) { const unsigned x = hq[i]; csum += (x & 0xffffu) + (x >> 16); }
          unsigned incl = csum;
#pragma unroll
          for (int o = 1; o < 16; o <<= 1) { const unsigned y = __shfl_up(incl, o, 16); if (sub >= o) incl += y; }
          const unsigned total = __shfl(incl, 15, 16);
          const unsigned need = s[ST_NEED];
          if (md == 0u) {
              const unsigned sufx = total - incl;
              if (sufx < need && need <= sufx + csum) {
                  const unsigned lo_ = s[ST_LO], hi_ = s[ST_HI]; const int sh_ = range_shift(hi_ - lo_);
                  unsigned cum = sufx; int bsel = 0; unsigned cb = 0;
                  for (int bn = 63; bn >= 0; --bn) { const unsigned x = hq[bn >> 1]; const unsigned c = (bn & 1) ? (x >> 16) : (x & 0xffffu);
                      if (cum + c >= need) { bsel = bn; cb = c; break; } cum += c; }
                  const unsigned bglob = (unsigned)(sub * 64 + bsel); const unsigned nlo = lo_ + (bglob << sh_); const unsigned wdt = (sh_ >= 32) ? 0xffffffffu : ((1u << sh_) - 1u);
                  const unsigned nhi = (hi_ - nlo < wdt) ? hi_ : nlo + wdt; const unsigned nneed = need - cum;
                  s[ST_LO] = nlo; s[ST_HI] = nhi; s[ST_NEED] = nneed;
                  if (cb == nneed) { s[ST_TGE] = nlo; s[ST_TEQ] = 0u; s[ST_TI] = 0xffffu; s[ST_MODE] = 2u; }
                  else if (nlo == nhi) { s[ST_MODE] = 1u; }
              }
          } else if (md == 1u) {
              const unsigned prefx = incl - csum;
              if (prefx < need && need <= prefx + csum) {
                  const unsigned ilo_ = s[ST_ILO], ihi_ = s[ST_IHI]; const int ish_ = range_shift(ihi_ - ilo_);
                  unsigned cum = prefx; int bsel = 0; unsigned cb = 0;
                  for (int bn = 0; bn < 64; ++bn) { const unsigned x = hq[bn >> 1]; const unsigned c = (bn & 1) ? (x >> 16) : (x & 0xffffu);
                      if (cum + c >= need) { bsel = bn; cb = c; break; } cum += c; }
                  const unsigned bglob = (unsigned)(sub * 64 + bsel); const unsigned nilo = ilo_ + (bglob << ish_); const unsigned wdt = (1u << ish_) - 1u;
                  const unsigned nihi = (ihi_ - nilo < wdt) ? ihi_ : nilo + wdt; const unsigned nneed = need - cum;
                  s[ST_ILO] = nilo; s[ST_IHI] = nihi; s[ST_NEED] = nneed;
                  if (cb == nneed || nilo == nihi) { s[ST_TGE] = s[ST_LO]; s[ST_TEQ] = s[ST_LO]; s[ST_TI] = nihi; s[ST_MODE] = 2u; }
              }
          } }
        __syncthreads();
    }
    { const unsigned tge = ST[r32 * 16 + ST_TGE], teq = ST[r32 * 16 + ST_TEQ], ti = ST[r32 * 16 + ST_TI]; const bool tie = (ti != 0xffffu);
      LOAD_QF();
      for (int kt = wave; kt <= qt; kt += NWAVES) {
          float v[16]; idx_tile(QKV, rowb, kt, qf, w, r32, hi, v); unsigned bits = 0u;
#pragma unroll
          for (int r = 0; r < 16; ++r) { const int key = 32 * kt + crow(r, hi); const unsigned u = okey(v[r]);
              const bool sel = (key <= t) && (u >= tge) && !(tie && u == teq && (unsigned)key > ti);
              bits |= sel ? (1u << crow(r, hi)) : 0u; }
          bits |= __shfl_xor(bits, 32);
          if (hi == 0) MASK[r32 * 128 + kt] = bits; } }
    __syncthreads();
    for (int qi = 0; qi < 4; ++qi) { const int q = wave * 4 + qi;
        const int w0i = 2 * lane, w1i = 2 * lane + 1;
        unsigned m0 = (w0i <= qt) ? MASK[q * 128 + w0i] : 0u, m1 = (w1i <= qt) ? MASK[q * 128 + w1i] : 0u;
        const int cnt = __builtin_popcount(m0) + __builtin_popcount(m1); int incl = cnt;
#pragma unroll
        for (int o = 1; o < 64; o <<= 1) { const int y = __shfl_up(incl, o); if (lane >= o) incl += y; }
        int pos = incl - cnt; const int total = __shfl(incl, 63);
        while (m0) { const int bpos = __builtin_ctz(m0); m0 &= m0 - 1u; if (pos < TOPK) SEL[q * 256 + pos] = (unsigned short)(64 * lane + bpos); ++pos; }
        while (m1) { const int bpos = __builtin_ctz(m1); m1 &= m1 - 1u; if (pos < TOPK) SEL[q * 256 + pos] = (unsigned short)(64 * lane + 32 + bpos); ++pos; }
        if (lane == 0) ST[q * 16 + ST_NSEL] = (unsigned)(total < TOPK ? total : TOPK); }
    LDS_WAIT(); asm volatile("" ::: "memory");
    { const int c = lane & 15, g = lane >> 4;
      LAS unsigned char* stg = lds + IX_STAGE + wave * IX_SBYTES;
      const float slope2 = (c < 8) ? LOG2E * __builtin_amdgcn_exp2f(-(float)(c + 1)) : 0.f;
      for (int qi = 0; qi < 4; ++qi) { const int q = wave * 4 + qi, tq = q0 + q; const size_t mrow = rowb + tq;
          const int nsel = (int)ST[q * 16 + ST_NSEL]; const int nsteps = (nsel + 31) >> 5;
          bf16x8 ql[4];
#pragma unroll
          for (int ks = 0; ks < 4; ++ks) { ql[ks] = bf16x8{}; if (c < 8) ql[ks] = *(const bf16x8*)(QKV + mrow * NQ0 + C_QLAT + c * 128 + 32 * ks + 8 * g); }
          float mrun = -INFINITY, lrun = 0.f; f32x4 o[8];
#pragma unroll
          for (int dt = 0; dt < 8; ++dt) o[dt] = f32x4{};
          v4u rv[8];
          {
#pragma unroll
            for (int i = 0; i < 8; ++i) { const int j = 4 * i + g; const int key = (j < nsel) ? (int)SEL[q * 256 + j] : 0;
                rv[i] = *(const v4u*)(CKVN + (rowb + key) * 128 + c * 8); } }
          for (int st = 0; st < nsteps; ++st) {
#pragma unroll
              for (int i = 0; i < 8; ++i) *(LAS v4u*)(stg + (4 * i + g) * IX_SROW + c * 16) = rv[i];
              if (st + 1 < nsteps) {
#pragma unroll
                  for (int i = 0; i < 8; ++i) { const int j = 32 * (st + 1) + 4 * i + g; const int key = (j < nsel) ? (int)SEL[q * 256 + j] : 0;
                      rv[i] = *(const v4u*)(CKVN + (rowb + key) * 128 + c * 8); } }
              float sc[8];
              { const LAS unsigned short* sp = SEL + q * 256 + 32 * st + 4 * g;
                f32x4 sa = f32x4{}, sb = f32x4{};
#pragma unroll
                for (int ks = 0; ks < 4; ++ks) { const bf16x8 ka = *(const LAS bf16x8*)(stg + c * IX_SROW + (32 * ks + 8 * g) * 2), kb2 = *(const LAS bf16x8*)(stg + (16 + c) * IX_SROW + (32 * ks + 8 * g) * 2);
                    sa = __builtin_amdgcn_mfma_f32_16x16x32_bf16(ka, ql[ks], sa, 0, 0, 0); sb = __builtin_amdgcn_mfma_f32_16x16x32_bf16(kb2, ql[ks], sb, 0, 0, 0); }
#pragma unroll
                for (int jj = 0; jj < 8; ++jj) { const int li = (jj < 4) ? jj : 12 + jj; const int j = 32 * st + 4 * g + li;
                    const float raw = (jj < 4) ? sa[jj] : sb[jj - 4]; const float dist = (float)(tq - (int)sp[li]);
                    sc[jj] = (j < nsel) ? raw - slope2 * dist : -INFINITY; } }
              float smax = __builtin_fmaxf(__builtin_fmaxf(__builtin_fmaxf(sc[0], sc[1]), __builtin_fmaxf(sc[2], sc[3])), __builtin_fmaxf(__builtin_fmaxf(sc[4], sc[5]), __builtin_fmaxf(sc[6], sc[7])));
              smax = __builtin_fmaxf(smax, __shfl_xor(smax, 16)); smax = __builtin_fmaxf(smax, __shfl_xor(smax, 32));
              const float mnew = __builtin_fmaxf(mrun, smax); const float alpha = __builtin_amdgcn_exp2f(mrun - mnew); mrun = mnew;
              bf16x8 pb; float psum = 0.f;
#pragma unroll
              for (int jj = 0; jj < 8; ++jj) { const float p = __builtin_amdgcn_exp2f(sc[jj] - mnew); psum += p; pb[jj] = (short)f2bf(p); }
              lrun = lrun * alpha + psum;
#pragma unroll
              for (int dt = 0; dt < 8; ++dt) { o[dt] = o[dt] * alpha;
                  const LAS unsigned char* a0 = stg + (4 * g + (c >> 2)) * IX_SROW + (16 * dt + 4 * (c & 3)) * 2;
                  const s16x4 lo4 = __builtin_bit_cast(s16x4, __builtin_amdgcn_ds_read_tr16_b64_v4i16((LAS s16x4*)a0));
                  const s16x4 hi4 = __builtin_bit_cast(s16x4, __builtin_amdgcn_ds_read_tr16_b64_v4i16((LAS s16x4*)(a0 + 16 * IX_SROW)));
                  const bf16x8 ca = (bf16x8){lo4[0], lo4[1], lo4[2], lo4[3], hi4[0], hi4[1], hi4[2], hi4[3]};
                  o[dt] = __builtin_amdgcn_mfma_f32_16x16x32_bf16(ca, pb, o[dt], 0, 0, 0); }
              LDS_WAIT(); asm volatile("" ::: "memory");
          }
          lrun += __shfl_xor(lrun, 16); lrun += __shfl_xor(lrun, 32);
          const float rl = 1.0f / lrun;
          if (c < 8) { bf16* op = OCAT + mrow * KO0 + c * 128 + 4 * g;
#pragma unroll
              for (int dt = 0; dt < 8; ++dt) { v2u wv; wv.x = pk2(o[dt][0] * rl, o[dt][1] * rl); wv.y = pk2(o[dt][2] * rl, o[dt][3] * rl); *(v2u*)(op + 16 * dt) = wv; } }
      } }
    __syncthreads();
#undef LOAD_QF
}
#define XB_TMO      128
#define XB_XCNT(j)  (256  + 64 * (j))
#define XB_XSUB(j)  (1280 + 64 * (j))
#define XB_XGEN(j)  (2304 + 64 * (j))
#define XB_TOP      3328
#define XB_TOPGEN   3392
#define XCD_BAR_WORDS 3456
#define XB_SPIN_CAP (1u << 18)

__device__ __forceinline__ unsigned xb_ld(unsigned* p)              { return __hip_atomic_load(p, __ATOMIC_RELAXED, __HIP_MEMORY_SCOPE_AGENT); }
__device__ __forceinline__ unsigned xb_add(unsigned* p, unsigned v) { return __hip_atomic_fetch_add(p, v, __ATOMIC_RELAXED, __HIP_MEMORY_SCOPE_AGENT); }
__device__ __forceinline__ unsigned xb_xcc_id() { return (unsigned)__builtin_amdgcn_s_getreg((3 << 11) | 20) & 0xFu; }
#define XB_SPIN(cond, bar) do { unsigned _sp = 0; while (cond) { __builtin_amdgcn_s_sleep(1); \
    if ((++_sp & 255u) == 0u) { if (xb_ld(&(bar)[XB_TMO])) break; if (_sp > XB_SPIN_CAP) { atomicAdd(&(bar)[XB_TMO], 1u); break; } } } } while (0)

struct XcdBarrier {
    unsigned* bar; unsigned x;
    volatile LAS unsigned* st;
};

__device__ __forceinline__ XcdBarrier xcd_barrier_post(unsigned* bar, volatile LAS unsigned* st) {
    XcdBarrier b; b.bar = bar; b.x = xb_xcc_id(); b.st = st;
    if (threadIdx.x == 0) (void)xb_add(&bar[XB_XCNT(b.x)], 1u);
    return b;
}
__device__ __forceinline__ void xcd_barrier_complete(unsigned* bar, unsigned x, unsigned& nloc, unsigned& nx) {
    const unsigned G = gridDim.x * gridDim.y * gridDim.z;
    unsigned sum, cnt, mine, sp = 0u;
    for (;;) {
        sum = 0u; cnt = 0u; mine = 0u;
#pragma unroll
        for (unsigned j = 0; j < 16; ++j) { const unsigned c = xb_ld(&bar[XB_XCNT(j)]); sum += c; cnt += (c > 0u) ? 1u : 0u; mine = (j == x) ? c : mine; }
        if (sum == G) break;
        __builtin_amdgcn_s_sleep(1);
        if ((++sp & 255u) == 0u) { if (xb_ld(&bar[XB_TMO])) break; if (sp > XB_SPIN_CAP) { atomicAdd(&bar[XB_TMO], 1u); break; } }
    }
    nloc = mine > 0u ? mine : 1u; nx = cnt > 0u ? cnt : 1u;
}

__device__ __forceinline__ void xcd_barrier(const XcdBarrier& b) {
    asm volatile("s_waitcnt vmcnt(0)" ::: "memory");
    __syncthreads();
    if (threadIdx.x == 0) {
        unsigned* bar = b.bar;
        __builtin_amdgcn_s_waitcnt(0);
        unsigned nloc = b.st[0], nx = b.st[1];
        if (nloc == 0u) { xcd_barrier_complete(bar, b.x, nloc, nx); b.st[0] = nloc; b.st[1] = nx; }
        const unsigned old = xb_add(&bar[XB_XSUB(b.x)], 1u);
        const unsigned gen = old / nloc;
        if (old + 1u == (gen + 1u) * nloc) {
            __builtin_amdgcn_fence(__ATOMIC_RELEASE, "agent");
            asm volatile("s_waitcnt vmcnt(0)" ::: "memory");
            const unsigned og = xb_add(&bar[XB_TOP], 1u);
            const unsigned tg = og / nx;
            if (og + 1u == (tg + 1u) * nx) xb_add(&bar[XB_TOPGEN], 1u);
            else XB_SPIN(xb_ld(&bar[XB_TOPGEN]) == tg, bar);
            __builtin_amdgcn_fence(__ATOMIC_ACQUIRE, "agent");
            xb_add(&bar[XB_XGEN(b.x)], 1u);
            asm volatile("s_waitcnt vmcnt(0)" ::: "memory");
        } else {
            XB_SPIN(xb_ld(&bar[XB_XGEN(b.x)]) == gen, bar);
            __builtin_amdgcn_fence(__ATOMIC_ACQUIRE, "agent");
            asm volatile("s_waitcnt vmcnt(0)" ::: "memory");
        }
    }
    __syncthreads();
}
namespace moba {
using bf16=__hip_bfloat16;
using bf16x8=__attribute__((ext_vector_type(8)))short;
using s16x4=__attribute__((ext_vector_type(4)))short;
using f32x16=__attribute__((ext_vector_type(16)))float;
using u32x4=__attribute__((ext_vector_type(4)))unsigned;
constexpr int SEQ=4096,D=64,PQ=3072,PO=1024;
constexpr int NW=8,QBLK=32,QB=QBLK*NW,KVBLK=64,NQB=SEQ/QB;
constexpr int ATTN_UNIT_ROWS=QB;
__device__ __forceinline__ int crow(int r,int hi){return (r&3)+8*(r>>2)+4*hi;}
#define SBAR() __builtin_amdgcn_sched_barrier(0)
__device__ __forceinline__ void cmask(f32x16&p0,f32x16&p1,int jb,int qrel,int hi){
  const float NEG=-INFINITY; int kb=64*jb+4*hi;
  #pragma unroll
  for(int r=0;r<16;++r){int kv=kb+(r&3)+8*(r>>2); if(kv>qrel)p0[r]=NEG; if(kv+32>qrel)p1[r]=NEG;}
}

constexpr int NSLOT=3, SLOTB=8192;
constexpr int LDS_K=0, LDS_V=NSLOT*SLOTB, LDS_WS=2*NSLOT*SLOTB, LDS_OST=LDS_WS+NW*64*4, LDS_BYTES=LDS_OST+NW*4096;
constexpr float C2=0.125f*1.4426950408889634f;
__device__ __forceinline__ void glds16(const void*gsrc,unsigned lds_dst){unsigned keep;
  asm volatile("s_mov_b32 %0, m0\n\ts_mov_b32 m0, %2\n\ts_nop 0\n\tglobal_load_lds_dwordx4 %1, off\n\ts_mov_b32 m0, %0":"=&s"(keep):"v"(gsrc),"s"(lds_dst):"memory");}
__device__ __forceinline__ float max3f(float a,float b,float c){float r;asm("v_max3_f32 %0, %1, %2, %3":"=v"(r):"v"(a),"v"(b),"v"(c));return r;}
__device__ __forceinline__ float max2f(float a,float b){float r;asm("v_max_f32_e32 %0, %1, %2":"=v"(r):"v"(a),"v"(b));return r;}
__device__ __forceinline__ float fadd_s(float a,float b){float r;asm("v_add_f32_e32 %0, %1, %2":"=v"(r):"v"(a),"v"(b));return r;}
__device__ __forceinline__ float fsub_s(float a,float b){float r;asm("v_sub_f32_e32 %0, %1, %2":"=v"(r):"v"(a),"v"(b));return r;}
typedef float f32x2_t __attribute__((ext_vector_type(2))); typedef __bf16 bf16x2_t __attribute__((ext_vector_type(2)));
__device__ __forceinline__ unsigned cvtpk_s(float lo,float hi){f32x2_t v={lo,hi};bf16x2_t b=__builtin_convertvector(v,bf16x2_t);return __builtin_bit_cast(unsigned,b);}
#define WAIT_BAR(N) asm volatile("s_waitcnt vmcnt(" #N ") lgkmcnt(0)\n\ts_barrier":::"memory")

__device__ __forceinline__ void qkt(f32x16&p0,f32x16&p1,const char*Kslot,const bf16x8*qr,int r32,int hi){ const f32x16 negm=f32x16{};
  const char*kb=Kslot+hi*1024+r32*16;
  #pragma unroll
  for(int d0=0;d0<4;++d0){
    const bf16x8 b0=*reinterpret_cast<const bf16x8*>(kb+d0*2048);
    const bf16x8 b1=*reinterpret_cast<const bf16x8*>(kb+d0*2048+512);
    if(d0==0){p0=__builtin_amdgcn_mfma_f32_32x32x16_bf16(b0,qr[0],negm,0,0,0);p1=__builtin_amdgcn_mfma_f32_32x32x16_bf16(b1,qr[0],negm,0,0,0);}
    else{p0=__builtin_amdgcn_mfma_f32_32x32x16_bf16(b0,qr[d0],p0,0,0,0);p1=__builtin_amdgcn_mfma_f32_32x32x16_bf16(b1,qr[d0],p1,0,0,0);}}
}
typedef __attribute__((address_space(3))) const char* lds_cptr;
typedef short v4i16_t __attribute__((ext_vector_type(4)));
__device__ __forceinline__ void kload8(bf16x8*kf,lds_cptr kp){
  kf[0]=*(const __attribute__((address_space(3))) bf16x8*)(kp);      kf[1]=*(const __attribute__((address_space(3))) bf16x8*)(kp+512);
  kf[2]=*(const __attribute__((address_space(3))) bf16x8*)(kp+2048); kf[3]=*(const __attribute__((address_space(3))) bf16x8*)(kp+2560);
  kf[4]=*(const __attribute__((address_space(3))) bf16x8*)(kp+4096); kf[5]=*(const __attribute__((address_space(3))) bf16x8*)(kp+4608);
  kf[6]=*(const __attribute__((address_space(3))) bf16x8*)(kp+6144); kf[7]=*(const __attribute__((address_space(3))) bf16x8*)(kp+6656);
}
__device__ __forceinline__ void kload2(bf16x8*kf,lds_cptr kp,int j){ kf[2*j]=*(const __attribute__((address_space(3))) bf16x8*)(kp+j*2048); kf[2*j+1]=*(const __attribute__((address_space(3))) bf16x8*)(kp+j*2048+512); }
__device__ __forceinline__ s16x4 vtr(lds_cptr p){ return __builtin_bit_cast(s16x4,__builtin_amdgcn_ds_read_tr16_b64_v4i16((__attribute__((address_space(3))) v4i16_t*)p)); }
__device__ __forceinline__ float rowmax(const f32x16&p0,const f32x16&p1){
  float a=max3f(p0[0],p0[1],p1[0]),b=max3f(p0[2],p0[3],p1[1]);a=max3f(a,p1[2],p1[3]);
  #pragma unroll
  for(int r=4;r<16;r+=4){a=max3f(a,p0[r],p0[r+1]);b=max3f(b,p0[r+2],p0[r+3]);a=max3f(a,p1[r],p1[r+1]);b=max3f(b,p1[r+2],p1[r+3]);}
  const float m=max2f(a,b);
  auto rr=__builtin_amdgcn_permlane32_swap(__float_as_uint(m),__float_as_uint(m),false,false);
  return max2f(__uint_as_float(rr[0]),__uint_as_float(rr[1]));
}
__device__ __forceinline__ void pv(f32x16*o,int vb,bf16x8 pa0,bf16x8 pa1,bf16x8 pa2,bf16x8 pa3){
  #pragma unroll
  for(int d0=0;d0<2;++d0){s16x4 lo[4],hi[4];
    #pragma unroll
    for(int ks=0;ks<4;++ks){
      asm volatile("ds_read_b64_tr_b16 %0,%1 offset:%c2":"=&v"(lo[ks]):"v"(vb),"i"(d0*4096+ks*1024):"memory");
      asm volatile("ds_read_b64_tr_b16 %0,%1 offset:%c2":"=&v"(hi[ks]):"v"(vb),"i"(d0*4096+ks*1024+512):"memory");}
    asm volatile("s_waitcnt lgkmcnt(0)":::"memory");SBAR();
    #define PK(k) (bf16x8){lo[k][0],lo[k][1],lo[k][2],lo[k][3],hi[k][0],hi[k][1],hi[k][2],hi[k][3]}
    o[d0]=__builtin_amdgcn_mfma_f32_32x32x16_bf16(pa0,PK(0),o[d0],0,0,0);
    o[d0]=__builtin_amdgcn_mfma_f32_32x32x16_bf16(pa1,PK(1),o[d0],0,0,0);
    o[d0]=__builtin_amdgcn_mfma_f32_32x32x16_bf16(pa2,PK(2),o[d0],0,0,0);
    o[d0]=__builtin_amdgcn_mfma_f32_32x32x16_bf16(pa3,PK(3),o[d0],0,0,0);
    #undef PK
  }
}

#ifndef ATTN_STORE16
#define ATTN_STORE16(p,v) (*(u32x4*)(p)=(v))
#endif
template<int THRL> __device__ __forceinline__ void attn_unit(int b,int h,int qb,const bf16*Q,const bf16*__restrict__ K,const bf16*__restrict__ V,bf16*O,const unsigned short*__restrict__ ALLOW,const float sig2,char*shm){
  int tid_l=threadIdx.x; asm volatile("":"+v"(tid_l)); const int tid=tid_l,lane=tid&63,r32=lane&31,hi=lane>>5; const int wid=__builtin_amdgcn_readfirstlane(tid>>6);
  const long rowbase=(long)b*SEQ; const int q0=qb*QB;
  const bf16*Qw=Q+(rowbase+q0+wid*QBLK)*PQ+h*D;
  const bf16*Kh=K+rowbase*PQ+h*D,*Vh=V+rowbase*PQ+h*D;
  const unsigned lds0=(unsigned)(uintptr_t)shm;
  float*wsf=(float*)(shm+LDS_WS)+wid*64;
  const bf16*ksrc=Kh+(long)lane*PQ+wid*8;
  const bf16*vsrc=Vh+(long)(16*(wid&3)+(lane>>2))*PQ+(wid>>2)*32+(lane&3)*8;
  const unsigned kdst=lds0+LDS_K+wid*1024, vdst=lds0+LDS_V+wid*1024;
  #define DMA_K(t,slot) glds16(ksrc+(long)(t)*KVBLK*PQ,(unsigned)__builtin_amdgcn_readfirstlane(kdst+(slot)))
  #define DMA_V(t,slot) glds16(vsrc+(long)(t)*KVBLK*PQ,(unsigned)__builtin_amdgcn_readfirstlane(vdst+(slot)))
  const int vb0=(int)(lds0+LDS_V)+((lane>>4)&1)*32+(lane&3)*8+(4*hi+((lane&15)>>2))*64;
  const char*Kbase=shm+LDS_K; bf16x8 kf[8];
  const lds_cptr shm3=(lds_cptr)shm; const lds_cptr kp0=shm3+LDS_K+hi*1024+r32*16; const lds_cptr vp0=shm3+LDS_V+((lane>>4)&1)*32+(lane&3)*8+(4*hi+((lane&15)>>2))*64;
  const int NT=(q0+QB)/KVBLK;
  DMA_K(0,0);DMA_V(0,0);DMA_K(1,SLOTB);
  bf16x8 qr[4];
  #pragma unroll
  for(int d0=0;d0<4;++d0)qr[d0]=*reinterpret_cast<const bf16x8*>(&Qw[(long)r32*PQ+d0*16+hi*8]);
  float mhat=0.f,l_reg=0.f;f32x16 o[2];o[0]=f32x16{};o[1]=f32x16{};
  const int qrel=wid*QBLK+r32; const int qpos=q0+qrel;
  const unsigned allow=ALLOW[(rowbase+qpos)*16+h]; const float bq=sig2*(float)(4*hi-qpos);
  {
    float ss=0.f;
    _Pragma("unroll") for(int d0=0;d0<4;++d0){ const bf16x8 kk=*reinterpret_cast<const bf16x8*>(&Kh[(long)qpos*PQ+d0*16+hi*8]);
      _Pragma("unroll") for(int j=0;j<8;++j) ss+=__uint_as_float(((unsigned)(unsigned short)qr[d0][j])<<16)*__uint_as_float(((unsigned)(unsigned short)kk[j])<<16); }
    ss+=__shfl_xor(ss,32); mhat=ss; }
  const f32x16 negm=f32x16{};
  #define BIAS(P0,P1,t) do{ const bool al_=((allow>>((t)>>2))&1u)!=0u; const float tb_=sig2*(float)(64*(t)); float s0_=al_?((bq-mhat)+tb_):-INFINITY; \
    _Pragma("unroll") for(int r=0;r<16;++r){ const float kc_=__builtin_bit_cast(float,__builtin_amdgcn_readfirstlane(__builtin_bit_cast(int,sig2*(float)((r&3)+8*(r>>2))))); P0[r]=P0[r]+(s0_+kc_); } \
    s0_+=32.f*sig2; \
    _Pragma("unroll") for(int r=0;r<16;++r){ const float kc_=__builtin_bit_cast(float,__builtin_amdgcn_readfirstlane(__builtin_bit_cast(int,sig2*(float)((r&3)+8*(r>>2))))); P1[r]=P1[r]+(s0_+kc_); } }while(0)
  #define CMASK(P0,P1,t) do{int jb_=(t)-(NT-4); if(jb_>=0)cmask(P0,P1,jb_,qrel,hi);}while(0)
  bool resc=false;
  #define DECIDE(C0,C1) do{ float a=max3f(C0[0],C0[1],C1[0]),b=max3f(C0[2],C0[3],C1[1]); a=max3f(a,C1[2],C1[3]); \
      _Pragma("unroll") for(int r=4;r<16;r+=4){a=max3f(a,C0[r],C0[r+1]);b=max3f(b,C0[r+2],C0[r+3]);a=max3f(a,C1[r],C1[r+1]);b=max3f(b,C1[r+2],C1[r+3]);} \
      float rm=__builtin_fmaxf(a,b); { auto rr=__builtin_amdgcn_permlane32_swap(__float_as_uint(rm),__float_as_uint(rm),false,false); rm=__builtin_fmaxf(__uint_as_float(rr[0]),__uint_as_float(rr[1])); } \
      resc=false; \
      if(__builtin_expect(__any(rm>(float)THRL),0)){ const float dl=__builtin_fmaxf(rm,0.f); mhat+=dl; \
        _Pragma("unroll") for(int r=0;r<16;++r){C0[r]-=dl;C1[r]-=dl;} \
        const float f=__builtin_amdgcn_exp2f(-dl); l_reg*=f; if(hi==0)wsf[r32]=f; resc=true; } }while(0)
  #define RESC() do{ if(resc){ asm volatile("s_waitcnt lgkmcnt(0)":::"memory"); \
      _Pragma("unroll") for(int d_=0;d_<2;++d_) _Pragma("unroll") for(int r=0;r<16;++r)o[d_][r]*=wsf[crow(r,hi)]; } }while(0)
  f32x16 pA0,pA1,pB0,pB1;
  int sl_prev=0,sl_cur=0,sl_next=SLOTB;
  #define ROT() do{sl_prev=sl_cur;sl_cur=sl_next;sl_next=(sl_next==(NSLOT-1)*SLOTB)?0:sl_next+SLOTB;}while(0)
  DMA_K(2,2*SLOTB);
  WAIT_BAR(3);
  qkt(pA0,pA1,Kbase,qr,r32,hi);asm volatile("s_nop 15\n\ts_nop 7":"+v"(pA0),"+v"(pA1));BIAS(pA0,pA1,0);CMASK(pA0,pA1,0);
  DECIDE(pA0,pA1); resc=false;
  _Pragma("unroll") for(int r=0;r<16;++r){pA0[r]=__builtin_amdgcn_exp2f(pA0[r]);pA1[r]=__builtin_amdgcn_exp2f(pA1[r]);}
  WAIT_BAR(0);
  DMA_K(3,0);DMA_V(1,SLOTB);
  ROT();
  kload8(kf,kp0+sl_cur);
  WAIT_BAR(2);
  s16x4 vlo[8],vhi[8]; u32x4 pw0,pw1,pw2,pw3;
  #define PKW(P,B) cvtpk_s(P[B],P[B+1])
  #define PAF(k) __builtin_bit_cast(bf16x8,pw##k)
  #define VFR(i) (bf16x8){vlo[i][0],vlo[i][1],vlo[i][2],vlo[i][3],vhi[i][0],vhi[i][1],vhi[i][2],vhi[i][3]}
  #define PIN(x) asm volatile("":"+v"(x))
  #define MX3(a,b,c) __builtin_fmaxf(__builtin_fmaxf((a),(b)),(c))
  #define GAPA(MF,A0,A1,A2,A3,W0,W1,PW) do{ MF; sacc+=A0; sacc+=A1; sacc+=A2; sacc+=A3; PIN(sacc); W0; W1; PIN(PW); SBAR(); }while(0)
  #define EX(v) __builtin_amdgcn_exp2f(v)
  #define GAPB(MF,X,B) do{ MF; X[B]=EX(X[B]); X[B+1]=EX(X[B+1]); X[B+2]=EX(X[B+2]); X[B+3]=EX(X[B+3]); PIN(X); SBAR(); }while(0)
  #define VRD(i) do{ vlo[i]=vtr(vp_+(((i)>>2)*4096+((i)&3)*1024)); vhi[i]=vtr(vp_+(((i)>>2)*4096+((i)&3)*1024+512)); }while(0)
  #define KRD(G,j) do{ if(G){ kload2(kf,kp0+sl_next,j); SBAR(); } }while(0)
  #define STEP(C0,C1,P0,P1,t,GK,GV,GL) do{ SBAR(); \
    const lds_cptr vp_=vp0+sl_prev; \
    VRD(0); SBAR(); float sacc=(P0[0]+P0[1]); \
    GAPA(C0=__builtin_amdgcn_mfma_f32_32x32x16_bf16(kf[0],qr[0],negm,0,0,0), P0[2],P0[3],P0[4],P0[5],     pw0[0]=PKW(P0,0), pw0[1]=PKW(P0,2), pw0); \
    GAPA(C1=__builtin_amdgcn_mfma_f32_32x32x16_bf16(kf[1],qr[0],negm,0,0,0), P0[6],P0[7],P0[8],P0[9],     pw0[2]=PKW(P0,4), pw0[3]=PKW(P0,6), pw0); \
    VRD(1); SBAR(); GAPA(C0=__builtin_amdgcn_mfma_f32_32x32x16_bf16(kf[2],qr[1],C0,0,0,0),   P0[10],P0[11],P0[12],P0[13], pw1[0]=PKW(P0,8), pw1[1]=PKW(P0,10), pw1); \
    GAPA(C1=__builtin_amdgcn_mfma_f32_32x32x16_bf16(kf[3],qr[1],C1,0,0,0),   P0[14],P0[15],P1[0],P1[1],   pw1[2]=PKW(P0,12),pw1[3]=PKW(P0,14), pw1); \
    VRD(2); SBAR(); GAPA(C0=__builtin_amdgcn_mfma_f32_32x32x16_bf16(kf[4],qr[2],C0,0,0,0),   P1[2],P1[3],P1[4],P1[5],     pw2[0]=PKW(P1,0), pw2[1]=PKW(P1,2), pw2); \
    GAPA(C1=__builtin_amdgcn_mfma_f32_32x32x16_bf16(kf[5],qr[2],C1,0,0,0),   P1[6],P1[7],P1[8],P1[9],     pw2[2]=PKW(P1,4), pw2[3]=PKW(P1,6), pw2); \
    VRD(3); SBAR(); GAPA(C0=__builtin_amdgcn_mfma_f32_32x32x16_bf16(kf[6],qr[3],C0,0,0,0),   P1[10],P1[11],P1[12],P1[13], pw3[0]=PKW(P1,8), pw3[1]=PKW(P1,10), pw3); \
    GAPA(C1=__builtin_amdgcn_mfma_f32_32x32x16_bf16(kf[7],qr[3],C1,0,0,0),   P1[14],P1[15],0.f,0.f,       pw3[2]=PKW(P1,12),pw3[3]=PKW(P1,14), pw3); \
    l_reg+=sacc; \
    if(GK){DMA_K((t)+3,sl_cur);} if(GV){DMA_V((t)+1,sl_next);} \
    BIAS(C0,C1,t); CMASK(C0,C1,t); \
    DECIDE(C0,C1); \
    SBAR(); VRD(4); VRD(5); VRD(6); VRD(7); SBAR(); \
    GAPB(o[0]=__builtin_amdgcn_mfma_f32_32x32x16_bf16(PAF(0),VFR(0),o[0],0,0,0), C0,0); \
    GAPB(o[1]=__builtin_amdgcn_mfma_f32_32x32x16_bf16(PAF(0),VFR(4),o[1],0,0,0), C0,4); \
    KRD(GL,0); GAPB(o[0]=__builtin_amdgcn_mfma_f32_32x32x16_bf16(PAF(1),VFR(1),o[0],0,0,0), C0,8); \
    KRD(GL,1); GAPB(o[1]=__builtin_amdgcn_mfma_f32_32x32x16_bf16(PAF(1),VFR(5),o[1],0,0,0), C0,12); \
    KRD(GL,2); GAPB(o[0]=__builtin_amdgcn_mfma_f32_32x32x16_bf16(PAF(2),VFR(2),o[0],0,0,0), C1,0); \
    KRD(GL,3); GAPB(o[1]=__builtin_amdgcn_mfma_f32_32x32x16_bf16(PAF(2),VFR(6),o[1],0,0,0), C1,4); \
    GAPB(o[0]=__builtin_amdgcn_mfma_f32_32x32x16_bf16(PAF(3),VFR(3),o[0],0,0,0), C1,8); \
    GAPB(o[1]=__builtin_amdgcn_mfma_f32_32x32x16_bf16(PAF(3),VFR(7),o[1],0,0,0), C1,12); \
    }while(0)
  int t=1;
  #undef CMASK
  #define CMASK(P0,P1,t) do{}while(0)
  for(;t+5<NT;t+=2){
    STEP(pB0,pB1,pA0,pA1,t,true,true,true);     WAIT_BAR(2); RESC(); ROT();
    STEP(pA0,pA1,pB0,pB1,t+1,true,true,true);   WAIT_BAR(2); RESC(); ROT();
  }
  #undef CMASK
  #define CMASK(P0,P1,t) do{int jb_=(t)-(NT-4); if(jb_>=0)cmask(P0,P1,jb_,qrel,hi);}while(0)
  #define ENDW(tt) do{ if((tt)+3<NT){WAIT_BAR(2);} else if((tt)+2<NT){WAIT_BAR(1);} else {WAIT_BAR(0);} }while(0)
  for(;t+1<NT;t+=2){
    STEP(pB0,pB1,pA0,pA1,t,(t+3<NT),(t+1<NT),(t+1<NT));       ENDW(t);   RESC(); ROT();
    STEP(pA0,pA1,pB0,pB1,t+1,(t+4<NT),(t+2<NT),(t+2<NT));     ENDW(t+1); RESC(); ROT();
  }
  STEP(pB0,pB1,pA0,pA1,NT-1,false,false,false); RESC();
  { float sacc=pB0[0]+pB0[1]; _Pragma("unroll") for(int r=2;r<16;++r)sacc+=pB0[r]; _Pragma("unroll") for(int r=0;r<16;++r)sacc+=pB1[r]; l_reg+=sacc;
    pw0=(u32x4){PKW(pB0,0),PKW(pB0,2),PKW(pB0,4),PKW(pB0,6)};pw1=(u32x4){PKW(pB0,8),PKW(pB0,10),PKW(pB0,12),PKW(pB0,14)};pw2=(u32x4){PKW(pB1,0),PKW(pB1,2),PKW(pB1,4),PKW(pB1,6)};pw3=(u32x4){PKW(pB1,8),PKW(pB1,10),PKW(pB1,12),PKW(pB1,14)};
    SBAR(); pv(o,vb0+sl_cur,PAF(0),PAF(1),PAF(2),PAF(3)); }
  #undef PKW
  #undef PAF
  #undef VFR
  #undef PIN
  #undef MX3
  #undef GAPA
  #undef GAPB
  #undef EX
  #undef VRD
  #undef KRD
  #undef STEP
  #undef ENDW
  {auto rr=__builtin_amdgcn_permlane32_swap(__float_as_uint(l_reg),__float_as_uint(l_reg),false,false);l_reg=__uint_as_float(rr[0])+__uint_as_float(rr[1]);}
  if(hi==0)wsf[32+r32]=l_reg;asm volatile("s_waitcnt lgkmcnt(0)":::"memory");
  float rli[16];
  #pragma unroll
  for(int r=0;r<16;++r)rli[r]=__builtin_amdgcn_rcpf(wsf[32+crow(r,hi)]);
  bf16*Ow=O+(rowbase+q0+wid*QBLK)*PO+h*D;
  { bf16*stg=(bf16*)(shm+LDS_OST)+wid*2048;
    #pragma unroll
    for(int r=0;r<16;++r){const int orow=crow(r,hi);
      #pragma unroll
      for(int d0=0;d0<2;++d0)stg[orow*64+d0*32+r32]=__float2bfloat16(o[d0][r]*rli[r]);}
    asm volatile("s_waitcnt lgkmcnt(0)":::"memory");
    #pragma unroll
    for(int i=0;i<4;++i){const int row=i*8+(lane>>3),ch=lane&7; const u32x4 v=*(const u32x4*)(stg+row*64+ch*8); ATTN_STORE16(Ow+(long)row*PO+ch*8,v);} }
  asm volatile("s_waitcnt lgkmcnt(0)\n\ts_barrier":::"memory");
  #undef DMA_K
  #undef DMA_V
  #undef CMASK
  #undef DECIDE
  #undef BIAS
  #undef RESC
  #undef ROT
}
constexpr int ATTN_LDS_BYTES=LDS_BYTES;
#undef SBAR
#undef WAIT_BAR
}
struct Args { const float* in[15]; float* out; unsigned char* ws; int ph_lo, ph_hi; };
enum { I_X = 0, I_EWIN, I_EKVN, I_EWUK, I_EWUV, I_EWOUT, I_OWIN, I_OWOUT, I_LNMG, I_LNMB, I_FG, I_FU, I_FD, I_LNFG, I_LNFB };
constexpr int NPHASE = 18;

__global__ void __launch_bounds__(NTHR, 2) mega_fwd(Args args) {
    extern __shared__ __attribute__((aligned(16))) unsigned char lds_raw[];
    LAS unsigned char* lds = (LAS unsigned char*)lds_raw;
    cg::grid_group grid = cg::this_grid();
    volatile LAS unsigned* MISC = (volatile LAS unsigned*)(lds + LDS_BYTES - 64);
    if (threadIdx.x < 16) ((LAS unsigned*)(lds + LDS_BYTES - 64))[threadIdx.x] = 0u;
    __syncthreads();
    const int G = gridDim.x; const int bx = blockIdx.x; const int vcu = (G % 8 == 0) ? (bx % 8) * (G / 8) + bx / 8 : bx;
    const int NGW = G * NWAVES;
#define PHASE_IDS() int tid = threadIdx.x; asm volatile("" : "+v"(tid)); const int lane = tid & 63, wave = __builtin_amdgcn_readfirstlane(tid >> 6), gw = vcu * NWAVES + wave; (void)gw; (void)lane;
    unsigned char* ws = args.ws;
    bf16* W0IN = (bf16*)(ws + WS_W0IN); bf16* W0OUT = (bf16*)(ws + WS_W0OUT); bf16* WGU0 = (bf16*)(ws + WS_WGU0); bf16* WGU1 = (bf16*)(ws + WS_WGU1);
    bf16* WDN0 = (bf16*)(ws + WS_WDN0); bf16* WDN1 = (bf16*)(ws + WS_WDN1); bf16* W1IN = (bf16*)(ws + WS_W1IN); bf16* W1OUT = (bf16*)(ws + WS_W1OUT);
    float* KMEAN = (float*)(ws + WS_KMEAN); unsigned short* ALLOW = (unsigned short*)(ws + WS_ALLOW); bf16* CKVN = (bf16*)(ws + WS_CKVN);
    bf16* X = (bf16*)(ws + WS_X); bf16* R1 = (bf16*)(ws + WS_R1); bf16* OCAT = (bf16*)(ws + WS_OCAT);
    const int lo = args.ph_lo, hi = args.ph_hi;
#ifdef ONLY_PHASE
#define IN(k) ((k) == ONLY_PHASE && lo <= (k) && (k) < hi)
#else
#define IN(k) (lo <= (k) && (k) < hi)
#endif
    XcdBarrier bar; bar.bar = (unsigned*)args.ws + 4096; bar.x = 0; bar.st = nullptr;
    if (hi - lo > 1) bar = xcd_barrier_post((unsigned*)args.ws + 4096, MISC);
#define SEAM(k) do { if (IN(k) && IN((k) + 1)) { if ((k) == 0) grid.sync(); else xcd_barrier(bar); } } while (0)

    if (IN(0)) { PHASE_IDS();
        LAS float* scr = (LAS float*)(lds + wave * 16384);
        int rot = 0;
        const float* ewin = args.in[I_EWIN];
        tr_job(ewin, 2500, 1024, 512, 128, 128, W0IN, 1024, C_CKV, 0, 1.f, 0, scr, lane, gw, NGW, rot);
        tr_job(ewin, 2500, 1024, 640, 256, 256, W0IN, 1024, C_QIDX, 0, 1.f, 0, scr, lane, gw, NGW, rot);
        tr_job(ewin, 2500, 1024, 896, 64, 64, W0IN, 1024, C_KIDX, 0, 1.f, 0, scr, lane, gw, NGW, rot);
        tr_job(ewin, 2500, 1024, 964, 512, 512, W0IN, 1024, C_QB, 0, C2, 0, scr, lane, gw, NGW, rot);
        tr_job(ewin, 2500, 1024, 1476, 512, 512, W0IN, 1024, C_KB, 0, 1.f, 0, scr, lane, gw, NGW, rot);
        tr_job(ewin, 2500, 1024, 1988, 512, 512, W0IN, 1024, C_VB, 0, 1.f, 0, scr, lane, gw, NGW, rot);
        tr_job(ewin, 2500, 1024, 960, 64, 4, W0IN, 1024, C_WIDX, 0, 1.f, 0, scr, lane, gw, NGW, rot);
        tr_job(args.in[I_EWOUT] + 512 * 1024, 1024, 512, 0, 1024, 1024, W0OUT, KO0, 0, 1024, 1.f, 0, scr, lane, gw, NGW, rot);
        for (int l = 0; l < 2; ++l) {
            tr_job(args.in[I_FG] + (size_t)l * 1024 * DFF, DFF, 1024, 0, DFF, DFF, l ? WGU1 : WGU0, 1024, 0, 0, 1.f, 1, scr, lane, gw, NGW, rot);
            tr_job(args.in[I_FU] + (size_t)l * 1024 * DFF, DFF, 1024, 0, DFF, DFF, l ? WGU1 : WGU0, 1024, 0, 0, 1.f, 2, scr, lane, gw, NGW, rot);
            tr_job(args.in[I_FD] + (size_t)l * DFF * 1024, 1024, DFF, 0, 1024, 1024, l ? WDN1 : WDN0, DFF, 0, 0, 1.f, 0, scr, lane, gw, NGW, rot);
        }
        tr_job(args.in[I_OWIN], 3072, 1024, 0, 1024, 1024, W1IN, 1024, 0, 0, C2, 0, scr, lane, gw, NGW, rot);
        tr_job(args.in[I_OWIN], 3072, 1024, 1024, 2048, 2048, W1IN, 1024, 1024, 0, 1.f, 0, scr, lane, gw, NGW, rot);
        tr_job(args.in[I_OWOUT], 1024, 1024, 0, 1024, 1024, W1OUT, 1024, 0, 0, 1.f, 0, scr, lane, gw, NGW, rot);
        { const float* wuk = args.in[I_EWUK];
          int start = gw - rot; if (start < 0) start += NGW;
          for (int it = start; it < 2048; it += NGW) { const int h = it >> 8, k = 64 * ((it >> 4) & 15) + lane, r0 = 8 * (it & 15);
              float acc[8];
#pragma unroll
              for (int rr = 0; rr < 8; ++rr) acc[rr] = 0.f;
              const float* ap = ewin + (size_t)k * 2500 + h * 64; const float* wp = wuk + (size_t)h * 64 * 128 + r0;
#pragma unroll 4
              for (int d = 0; d < 64; ++d) { const float av = ap[d];
#pragma unroll
                  for (int rr = 0; rr < 8; ++rr) acc[rr] = __builtin_fmaf(av, wp[d * 128 + rr], acc[rr]); }
#pragma unroll
              for (int rr = 0; rr < 8; ++rr) W0IN[(size_t)(h * 128 + r0 + rr) * 1024 + k] = (bf16)f2bf(acc[rr] * C2); }
          rot = (rot + 2048) % NGW; }
        { const float* wuv = args.in[I_EWUV]; const float* wout = args.in[I_EWOUT];
          int start = gw - rot; if (start < 0) start += NGW;
          for (int it = start; it < 2048; it += NGW) { const int h = it >> 8, n = 64 * ((it >> 4) & 15) + lane, r0 = 8 * (it & 15);
              float acc[8];
#pragma unroll
              for (int rr = 0; rr < 8; ++rr) acc[rr] = 0.f;
              const float* ap = wout + (size_t)(h * 64) * 1024 + n; const float* wp = wuv + (size_t)(h * 128 + r0) * 64;
#pragma unroll 4
              for (int d = 0; d < 64; ++d) { const float av = ap[(size_t)d * 1024];
#pragma unroll
                  for (int rr = 0; rr < 8; ++rr) acc[rr] = __builtin_fmaf(av, wp[rr * 64 + d], acc[rr]); }
              v4u o; o.x = pk2(acc[0], acc[1]); o.y = pk2(acc[2], acc[3]); o.z = pk2(acc[4], acc[5]); o.w = pk2(acc[6], acc[7]);
              *(v4u*)(W0OUT + (size_t)n * KO0 + h * 128 + r0) = o; }
          rot = (rot + 2048) % NGW; }
        { const float* x = args.in[I_X]; const size_t nchunk = (size_t)M * DM / 8;
          for (size_t i = (size_t)bx * NTHR + tid; i < nchunk; i += (size_t)G * NTHR) { const f32x4 a = *(const f32x4*)(x + 8 * i), b = *(const f32x4*)(x + 8 * i + 4);
              v4u o; o.x = pk2(a[0], a[1]); o.y = pk2(a[2], a[3]); o.z = pk2(b[0], b[1]); o.w = pk2(b[2], b[3]); *(v4u*)(X + 8 * i) = o; } }
    }
    SEAM(0);
    if (IN(1)) { PHASE_IDS(); pg8::Gemm g{X, W0IN, M, NQ0, DM}; pg8::StaticOrder S; S.init(M, NQ0, G, bx); pg8::EpiBf16<0> E{R1, NQ0, nullptr, 0, 0, 1.f};
        pg8::gemm_phase<pg8::EpiBf16<0>, pg8::StaticOrder, true, true>(lds, g, S, E); }
    SEAM(1);
    if (IN(2)) { PHASE_IDS();
        const float* kvn = args.in[I_EKVN];
        for (int m = gw; m < M; m += NGW) { const unsigned wv = *(const unsigned*)(R1 + (size_t)m * NQ0 + C_CKV + 2 * lane); const float a = bflo(wv), b = bfhi(wv);
            const float r = 1.f / sqrtf(wave_sum(a * a + b * b) * (1.f / 128.f) + 1e-6f);
            *(unsigned*)(CKVN + (size_t)m * 128 + 2 * lane) = pk2(a * r * kvn[2 * lane], b * r * kvn[2 * lane + 1]); }
        for (int u = gw; u < BATCH * 8 * (SEQ / 32); u += NGW) { const int qt = (SEQ / 32 - 1) - (u / (BATCH * 8)), bh = u % (BATCH * 8); stick_unit(R1, OCAT, bh >> 3, bh & 7, qt, lane); }
    }
    SEAM(2);
    if (IN(3)) { PHASE_IDS();
        if (G == 256) { const int b = vcu >> 5, j = vcu & 31;
            for (int i = 0; i < 4; ++i) { const int qt = (i == 0) ? 127 - j : (i == 1) ? 64 + j : (i == 2) ? 63 - j : j; dsa_unit(R1, CKVN, OCAT, b, qt, lds, tid, wave, lane); } }
        else for (int u = bx; u < BATCH * 128; u += G) dsa_unit(R1, CKVN, OCAT, u >> 7, u & 127, lds, tid, wave, lane);
    }
    SEAM(3);
    if (IN(4)) { PHASE_IDS(); pg8::Gemm g{OCAT, W0OUT, M, DM, KO0}; pg8::StaticOrder S; S.init(M, DM, G, bx); pg8::EpiResid E{X, DM, ALPHA};
        pg8::gemm_phase<pg8::EpiResid, pg8::StaticOrder, true, true>(lds, g, S, E); }
    SEAM(4);
    if (IN(5)) { PHASE_IDS(); for (int m = gw; m < M; m += NGW) ln_row<false>(X + (size_t)m * DM, args.in[I_LNMG], args.in[I_LNMB], nullptr, lane); }
    SEAM(5);
    if (IN(6)) { PHASE_IDS(); pg8::Gemm g{X, WGU0, M, NGU, DM}; pg8::StaticOrder S; S.init(M, NGU, G, bx); pg8::EpiSwiGLU E{R1, DFF};
        pg8::gemm_phase<pg8::EpiSwiGLU, pg8::StaticOrder, true, true>(lds, g, S, E); }
    SEAM(6);
    if (IN(7)) { PHASE_IDS(); pg8::Gemm g{R1, WDN0, M, DM, DFF}; pg8::StaticOrder S; S.init(M, DM, G, bx); pg8::EpiResid E{X, DM, ALPHA};
        pg8::gemm_phase<pg8::EpiResid, pg8::StaticOrder, true, true>(lds, g, S, E); }
    SEAM(7);
    if (IN(8)) { PHASE_IDS(); for (int m = gw; m < M; m += NGW) ln_row<false>(X + (size_t)m * DM, args.in[I_LNFG], args.in[I_LNFB], nullptr, lane); }
    SEAM(8);
    if (IN(9)) { PHASE_IDS(); pg8::Gemm g{X, W1IN, M, NQ1, DM}; pg8::StaticOrder S; S.init(M, NQ1, G, bx); pg8::EpiBf16<0> E{R1, NQ1, nullptr, 0, 0, 1.f};
        pg8::gemm_phase<pg8::EpiBf16<0>, pg8::StaticOrder, true, true>(lds, g, S, E); }
    SEAM(9);
    if (IN(10)) { PHASE_IDS();
        for (int u = gw; u < BATCH * 16 * 16; u += NGW) { const int b = u >> 8, h = (u >> 4) & 15, n = u & 15;
            const bf16* kp = R1 + ((size_t)b * SEQ + 256 * n + (lane >> 5)) * NQ1 + 1024 + h * 64 + 2 * (lane & 31);
            float s0 = 0.f, s1 = 0.f;
#pragma unroll 8
            for (int i = 0; i < 128; ++i) { const unsigned wv = *(const unsigned*)(kp + (size_t)(2 * i) * NQ1); s0 += bflo(wv); s1 += bfhi(wv); }
            s0 += __shfl_xor(s0, 32); s1 += __shfl_xor(s1, 32);
            if (lane < 32) { float* o = KMEAN + (size_t)u * 64 + 2 * lane; o[0] = s0 * (1.f / 256.f); o[1] = s1 * (1.f / 256.f); } }
    }
    SEAM(10);
    if (IN(11)) { PHASE_IDS();
        for (size_t e = (size_t)bx * NTHR + tid; e < (size_t)M * 16; e += (size_t)G * NTHR) {
            const int h = (int)(e / M); const int m = (int)(e % M); const int b = m / SEQ, t = m % SEQ, cur = t >> 8;
            float q[64];
            { const bf16* qp = R1 + (size_t)m * NQ1 + h * 64;
#pragma unroll
              for (int i = 0; i < 8; ++i) { const v4u wv = *(const v4u*)(qp + 8 * i); q[8 * i] = bflo(wv.x); q[8 * i + 1] = bfhi(wv.x); q[8 * i + 2] = bflo(wv.y); q[8 * i + 3] = bfhi(wv.y);
                  q[8 * i + 4] = bflo(wv.z); q[8 * i + 5] = bfhi(wv.z); q[8 * i + 6] = bflo(wv.w); q[8 * i + 7] = bfhi(wv.w); } }
            float g0 = -INFINITY, g1 = -INFINITY, g2 = -INFINITY; int i0 = -1, i1 = -1, i2 = -1;
            for (int n = 0; n < cur; ++n) { const float* km = KMEAN + ((size_t)(b * 16 + h) * 16 + n) * 64; float s = 0.f;
#pragma unroll
                for (int d4 = 0; d4 < 16; ++d4) { const f32x4 kv = *(const f32x4*)(km + 4 * d4); s = __builtin_fmaf(q[4 * d4], kv[0], s); s = __builtin_fmaf(q[4 * d4 + 1], kv[1], s); s = __builtin_fmaf(q[4 * d4 + 2], kv[2], s); s = __builtin_fmaf(q[4 * d4 + 3], kv[3], s); }
                if (s > g0) { g2 = g1; i2 = i1; g1 = g0; i1 = i0; g0 = s; i0 = n; } else if (s > g1) { g2 = g1; i2 = i1; g1 = s; i1 = n; } else if (s > g2) { g2 = s; i2 = n; } }
            unsigned mask = 1u << cur; if (i0 >= 0) mask |= 1u << i0; if (i1 >= 0) mask |= 1u << i1; if (i2 >= 0) mask |= 1u << i2;
            ALLOW[(size_t)m * 16 + h] = (unsigned short)mask; }
    }
    SEAM(11);
    if (IN(12)) { PHASE_IDS();
        const int bh = vcu >> 1, par = vcu & 1;
        if (G == 256) {
            for (int i = 0; i < 8; ++i) { const int s = 2 * (i >> 1) + par; const int qb = (i & 1) ? s : 15 - s; const int h = bh & 15;
                moba::attn_unit<8>(bh >> 4, h, qb, (const moba::bf16*)R1, (const moba::bf16*)(R1 + 1024), (const moba::bf16*)(R1 + 2048), (moba::bf16*)OCAT, ALLOW,
                                   LOG2E * __builtin_amdgcn_exp2f(-0.5f * (float)(h + 1)), (char*)lds_raw); } }
        else for (int u = bx; u < BATCH * 16 * 16; u += G) { const int h = (u >> 4) & 15;
                moba::attn_unit<8>(u >> 8, h, 15 - (u & 15), (const moba::bf16*)R1, (const moba::bf16*)(R1 + 1024), (const moba::bf16*)(R1 + 2048), (moba::bf16*)OCAT, ALLOW,
                                   LOG2E * __builtin_amdgcn_exp2f(-0.5f * (float)(h + 1)), (char*)lds_raw); }
    }
    SEAM(12);
    if (IN(13)) { PHASE_IDS(); pg8::Gemm g{OCAT, W1OUT, M, DM, DM}; pg8::StaticOrder S; S.init(M, DM, G, bx); pg8::EpiResid E{X, DM, ALPHA};
        pg8::gemm_phase<pg8::EpiResid, pg8::StaticOrder, true, true>(lds, g, S, E); }
    SEAM(13);
    if (IN(14)) { PHASE_IDS(); for (int m = gw; m < M; m += NGW) ln_row<false>(X + (size_t)m * DM, args.in[I_LNMG] + DM, args.in[I_LNMB] + DM, nullptr, lane); }
    SEAM(14);
    if (IN(15)) { PHASE_IDS(); pg8::Gemm g{X, WGU1, M, NGU, DM}; pg8::StaticOrder S; S.init(M, NGU, G, bx); pg8::EpiSwiGLU E{R1, DFF};
        pg8::gemm_phase<pg8::EpiSwiGLU, pg8::StaticOrder, true, true>(lds, g, S, E); }
    SEAM(15);
    if (IN(16)) { PHASE_IDS(); pg8::Gemm g{R1, WDN1, M, DM, DFF}; pg8::StaticOrder S; S.init(M, DM, G, bx); pg8::EpiResid E{X, DM, ALPHA};
        pg8::gemm_phase<pg8::EpiResid, pg8::StaticOrder, true, true>(lds, g, S, E); }
    SEAM(16);
    if (IN(17)) { PHASE_IDS(); for (int m = gw; m < M; m += NGW) ln_row<true>(X + (size_t)m * DM, args.in[I_LNFG] + DM, args.in[I_LNFB] + DM, args.out + (size_t)m * DM, lane); }
#undef IN
#undef SEAM
}

#ifndef MK_N_LAUNCHES
#define MK_N_LAUNCHES 1
#endif
extern "C" void kernel_launch(void* const* d_in, const int* in_sizes, int n_in, void* d_out, int out_size, void* d_ws, size_t ws_size, hipStream_t stream) {
    static int grid = 0;
    if (grid == 0) {
        if (n_in != 15 || in_sizes[0] != M * DM || out_size != M * DM || ws_size < WS_END) { fprintf(stderr, "kernel_launch: unexpected shapes (n_in %d, in0 %d, out %d, ws %zu); nothing launched\n", n_in, n_in > 0 ? in_sizes[0] : -1, out_size, ws_size); grid = -1; return; }
        int dev = 0, cus = 0, per_cu = 0;
        if (hipGetDevice(&dev) != hipSuccess || hipDeviceGetAttribute(&cus, hipDeviceAttributeMultiprocessorCount, dev) != hipSuccess) { grid = -1; return; }
        if (hipFuncSetAttribute((const void*)mega_fwd, hipFuncAttributeMaxDynamicSharedMemorySize, LDS_BYTES) != hipSuccess) { fprintf(stderr, "kernel_launch: hipFuncSetAttribute failed\n"); grid = -1; return; }
        if (hipOccupancyMaxActiveBlocksPerMultiprocessor(&per_cu, (const void*)mega_fwd, NTHR, LDS_BYTES) != hipSuccess || per_cu < 1) { fprintf(stderr, "kernel_launch: occupancy query reports %d\n", per_cu); per_cu = 1; }
        (void)hipGetLastError();
        grid = cus;
    }
    if (grid < 0) return;
    if (hipMemsetAsync(d_ws, 0, 65536, stream) != hipSuccess) { fprintf(stderr, "kernel_launch: hipMemsetAsync failed\n"); return; }
    Args a{};
    for (int i = 0; i < 15; ++i) a.in[i] = (const float*)d_in[i];
    a.out = (float*)d_out; a.ws = (unsigned char*)d_ws;
    if (MK_N_LAUNCHES == 1) {
        a.ph_lo = 0; a.ph_hi = NPHASE;
        void* kargs[] = {&a};
        hipError_t e = hipLaunchCooperativeKernel((const void*)mega_fwd, dim3(grid), dim3(NTHR), kargs, LDS_BYTES, stream);
        if (e != hipSuccess) fprintf(stderr, "kernel_launch: cooperative launch failed: %s (grid %d)\n", hipGetErrorString(e), grid);
    } else {
        for (int p = 0; p < NPHASE; ++p) { a.ph_lo = p; a.ph_hi = p + 1; hipLaunchKernelGGL(mega_fwd, dim3(grid), dim3(NTHR), LDS_BYTES, stream, a); }
    }
}
```

```cpp
#include <hip/hip_runtime.h>
#include <hip/hip_cooperative_groups.h>
#include <hip/hip_bf16.h>
#include <cstdio>
#include <cstdint>
#include <cmath>
namespace cg = cooperative_groups;
namespace pg8 {
#define PG8_LAS __attribute__((address_space(3)))
typedef unsigned short bf16_t;
typedef short bf16x8 __attribute__((ext_vector_type(8)));
typedef float f32x4 __attribute__((ext_vector_type(4)));
typedef unsigned u32x4 __attribute__((ext_vector_type(4)));
constexpr int BM = 256, BK = 64, HALF = 128, HTB = HALF * BK * 2  , STAGE_BYTES = 8 * HTB, NXCD = 8, WGM = 8;

__host__ __device__ __forceinline__ int lds_byte(int r, int c) { const int st = (r >> 4) * 2 + (c >> 5), rr = r & 15, cc = c & 31, ob = rr * 64 + cc * 2; return st * 1024 + (ob ^ (((ob >> 9) & 1) << 5)); }
__host__ __device__ __forceinline__ void stage_rc(int b, int& R, int& C) { const int st = b / 1024, sb = b % 1024, swz = sb ^ (((sb >> 9) & 1) << 5); R = (st >> 1) * 16 + swz / 64; C = (st & 1) * 32 + (swz % 64) / 2; }
__host__ __device__ __forceinline__ int perm32(int rho) { const int n = rho >> 4, i = rho & 15; return 8 * (i >> 2) + 4 * n + (i & 3); }

struct Unit { int pm, pn; };
struct Gemm { const bf16_t* A; const bf16_t* Bt; int M, N, K; };

struct StaticOrder {
    int nM, nN, nwg, G, c;
    __host__ __device__ void init(int M, int N, int G_, int c_) { nM = M / BM; nN = N / BM; nwg = nM * nN; G = G_; c = c_; }
    __host__ __device__ bool next(int i, Unit& u) const {
        const long L = (long)i * G + c; if (L >= nwg) return false;
        int wgid = (int)L; { const int q = nwg / NXCD, r = nwg % NXCD, xcd = wgid % NXCD, off = wgid / NXCD; wgid = (xcd < r ? xcd * (q + 1) : r * (q + 1) + (xcd - r) * q) + off; }
        const int nig = WGM * nN, gid = wgid / nig, fm = gid * WGM, gsz = (nM - fm) < WGM ? (nM - fm) : WGM;
        u.pm = fm + ((wgid % nig) % gsz); u.pn = (wgid % nig) / gsz; return true;
    }
    __device__ __forceinline__ void a_ready(const Unit&) const {}
    __device__ __forceinline__ void done(const Unit&) const {}
};

__device__ __forceinline__ unsigned cvt_pk_bf16(float lo, float hi) { unsigned r; asm volatile("v_cvt_pk_bf16_f32 %0, %1, %2" : "=v"(r) : "v"(lo), "v"(hi)); return r; }
typedef float f32x2 __attribute__((ext_vector_type(2)));
__device__ __forceinline__ f32x2 gelu_pk(f32x2 v) {
    const f32x2 av = __builtin_elementwise_abs(v), d = av * 0.2316418882f + 1.0f;
    f32x2 t; t.x = __builtin_amdgcn_rcpf(d.x); t.y = __builtin_amdgcn_rcpf(d.y);
    f32x2 q = t * 0.5307027145f + (-0.7265760135f); q = q * t + 0.7107068705f; q = q * t + (-0.142248368f); q = q * t + 0.127414796f; q = q * t;
    const f32x2 s = (v * v) * (-0.72134752044f);
    f32x2 e; e.x = __builtin_amdgcn_exp2f(s.x); e.y = __builtin_amdgcn_exp2f(s.y);
    const f32x2 m = v * (q * e), r = v - m;
    f32x2 o; o.x = v.x < 0.f ? m.x : r.x; o.y = v.y < 0.f ? m.y : r.y; return o;
}

template <int ACT  > struct EpiBf16 {
    static constexpr bool PERM = true, AFTER_DRAIN = false; static_assert(ACT == 0 || ACT == 1, "EpiBf16: ACT is 0 (none) or 1 (gelu_pk)");
    bf16_t* O; int ldc; const float* bias; int split_cols; size_t split_stride; float scale0;
    __device__ __forceinline__ void operator()(const f32x4 (&acc)[2][2][4][2], const Unit& u, int wr, int wc, int fr, int fq) const {
        const int row0 = u.pm * BM + wr * 64 + fr; int colt = u.pn * BM; bf16_t* base = O;
        float sc = 1.f; if (split_cols) { const int t = colt / split_cols; base += (size_t)t * split_stride; colt -= t * split_cols; if (t == 0) sc = scale0; }
        const int col0 = colt + wc * 32 + 8 * fq, bcol0 = u.pn * BM + wc * 32 + 8 * fq;
        f32x4 bv[2][2];
#pragma unroll
        for (int bj = 0; bj < 2; ++bj)
#pragma unroll
            for (int n = 0; n < 2; ++n) bv[bj][n] = bias ? *(const f32x4*)(bias + bcol0 + bj * HALF + 4 * n) : (f32x4){0.f, 0.f, 0.f, 0.f};
#pragma unroll
        for (int ai = 0; ai < 2; ++ai)
#pragma unroll
            for (int m = 0; m < 4; ++m) { bf16_t* rowp = base + (size_t)(row0 + ai * HALF + m * 16) * ldc + col0;
#pragma unroll
                for (int bj = 0; bj < 2; ++bj) { f32x4 v0 = acc[ai][bj][m][0] + bv[bj][0], v1 = acc[ai][bj][m][1] + bv[bj][1];
                    if (ACT == 1) { f32x2 a = gelu_pk((f32x2){v0[0], v0[1]}), b = gelu_pk((f32x2){v0[2], v0[3]}), c = gelu_pk((f32x2){v1[0], v1[1]}), d = gelu_pk((f32x2){v1[2], v1[3]});
                        v0 = (f32x4){a.x, a.y, b.x, b.y}; v1 = (f32x4){c.x, c.y, d.x, d.y}; }
                    v0 = v0 * sc; v1 = v1 * sc; u32x4 w; w.x = cvt_pk_bf16(v0[0], v0[1]); w.y = cvt_pk_bf16(v0[2], v0[3]); w.z = cvt_pk_bf16(v1[0], v1[1]); w.w = cvt_pk_bf16(v1[2], v1[3]);
                    __builtin_nontemporal_store(w, (u32x4*)(rowp + bj * HALF)); } }
    }
};

struct PanelStats {
    unsigned* xbuf;
    unsigned* cnt;
    unsigned* tmo;
    int ntn; float eps;
    unsigned code;
    __device__ __forceinline__ bool run(const f32x4 (&v)[2][2][4][2], const Unit& u, int wr, int wc, int fr, int fq, PG8_LAS unsigned char* lds, int wid, int lane) const {
        typedef float f32x2v __attribute__((ext_vector_type(2)));
        PG8_LAS f32x2v* P = (PG8_LAS f32x2v*)lds;
        PG8_LAS f32x2v* S = (PG8_LAS f32x2v*)(lds + 8192);
        PG8_LAS unsigned* flag = (PG8_LAS unsigned*)(lds + 8192 + 2048);
#pragma unroll
        for (int ai = 0; ai < 2; ++ai)
#pragma unroll
            for (int m = 0; m < 4; ++m) {
                float s = 0.f;
#pragma unroll
                for (int bj = 0; bj < 2; ++bj)
#pragma unroll
                    for (int n = 0; n < 2; ++n) { const f32x4 x = v[ai][bj][m][n]; s += (x[0] + x[1]) + (x[2] + x[3]); }
                s += __shfl_xor(s, 16); s += __shfl_xor(s, 32);
                const float mw = s * (1.0f / 64.0f); float q = 0.f;
#pragma unroll
                for (int bj = 0; bj < 2; ++bj)
#pragma unroll
                    for (int n = 0; n < 2; ++n) { const f32x4 d = v[ai][bj][m][n] - mw; q += (d[0] * d[0] + d[1] * d[1]) + (d[2] * d[2] + d[3] * d[3]); }
                q += __shfl_xor(q, 16); q += __shfl_xor(q, 32);
                if (fq == 0) P[(ai * HALF + wr * 64 + m * 16 + fr) * 4 + wc] = (f32x2v){mw, q};
            }
        asm volatile("s_waitcnt lgkmcnt(0)" ::: "memory"); __builtin_amdgcn_s_barrier(); asm volatile("" ::: "memory");
#if defined(BROKEN_EXCHANGE_NO_WAIT)
#warning BROKEN CONTROL BUILD: the row-statistics exchange does not wait; results are wrong by design
        if (blockIdx.x >= 64) { const long long t0_ = clock64(); while (clock64() - t0_ < 60000) __builtin_amdgcn_s_sleep(8); }
#endif
        const int row = wid * 32 + (lane & 31);
        if (lane < 32) {
            const f32x2v a = P[row * 4 + 0], b = P[row * 4 + 1], c = P[row * 4 + 2], d = P[row * 4 + 3];
            const float mt = (a.x + b.x + c.x + d.x) * 0.25f;
            const float da = a.x - mt, db = b.x - mt, dc = c.x - mt, dd = d.x - mt;
            const float m2 = (a.y + b.y) + (c.y + d.y) + 64.0f * ((da * da + db * db) + (dc * dc + dd * dd));
            unsigned long long* slot = (unsigned long long*)xbuf + ((size_t)(u.pm * BM + row) * 4 + u.pn);
            __hip_atomic_store(slot, ((unsigned long long)__float_as_uint(m2) << 32) | __float_as_uint(mt), __ATOMIC_RELAXED, __HIP_MEMORY_SCOPE_AGENT);
        }
        asm volatile("s_waitcnt vmcnt(0)" ::: "memory");
        if (lane == 0) __hip_atomic_fetch_add(cnt + 64 * u.pm, 1u, __ATOMIC_RELAXED, __HIP_MEMORY_SCOPE_AGENT);
        if (wid == 0) {
            bool dead = false; const unsigned long long t0 = __builtin_amdgcn_s_memrealtime(); const unsigned want = 8u * (unsigned)ntn;
            for (;;) {
#if defined(BROKEN_EXCHANGE_NO_WAIT)
                break;
#endif
                if ((unsigned)__builtin_amdgcn_readfirstlane(__hip_atomic_load(cnt + 64 * u.pm, __ATOMIC_RELAXED, __HIP_MEMORY_SCOPE_AGENT)) >= want) break;
                if (__builtin_amdgcn_s_memrealtime() - t0 > 2000000ull) {
                    if (lane == 0) { unsigned expect = 0u; __hip_atomic_compare_exchange_strong(tmo + 1, &expect, code | (unsigned)(u.pm & 0xff), __ATOMIC_RELAXED, __ATOMIC_RELAXED, __HIP_MEMORY_SCOPE_AGENT);
                                     __hip_atomic_store(tmo, 1u, __ATOMIC_RELAXED, __HIP_MEMORY_SCOPE_AGENT); }
                    dead = true; break; }
                __builtin_amdgcn_s_sleep(2);
            }
            __builtin_amdgcn_fence(__ATOMIC_ACQUIRE, "agent");
            if (lane == 0) flag[0] = dead ? 1u : 0u;
        }
        asm volatile("s_waitcnt vmcnt(0) lgkmcnt(0)" ::: "memory"); __builtin_amdgcn_s_barrier(); asm volatile("" ::: "memory");
        const bool bad = flag[0] != 0u;
        if (lane < 32) {
            const unsigned long long* slot = (const unsigned long long*)xbuf + (size_t)(u.pm * BM + row) * 4; float mt[4], m2[4]; float ms = 0.f;
#pragma unroll
            for (int t = 0; t < 4; ++t) { if (t < ntn) { const unsigned long long w = __hip_atomic_load(slot + t, __ATOMIC_RELAXED, __HIP_MEMORY_SCOPE_AGENT); mt[t] = __uint_as_float((unsigned)w); m2[t] = __uint_as_float((unsigned)(w >> 32)); } else { mt[t] = 0.f; m2[t] = 0.f; } ms += mt[t]; }
            const float mean = ms / (float)ntn; float q = 0.f;
#pragma unroll
            for (int t = 0; t < 4; ++t) if (t < ntn) { const float dm = mt[t] - mean; q += m2[t] + 256.0f * dm * dm; }
            S[row] = (f32x2v){mean, 1.0f / sqrtf(q / (256.0f * (float)ntn) + eps)};
        }
        asm volatile("s_waitcnt lgkmcnt(0)" ::: "memory"); __builtin_amdgcn_s_barrier(); asm volatile("" ::: "memory");
        return bad;
    }
};
struct EpiLnRes {
    static constexpr bool PERM = false, AFTER_DRAIN = true;
    const float* base; float* out; int ldc; const float* bias; PanelStats st; unsigned poison;
    __device__ __forceinline__ void fused(f32x4 (&acc)[2][2][4][2], const Unit& u, int wr, int wc, int fr, int fq, PG8_LAS unsigned char* lds, int wid, int lane) const {
        typedef float f32x2v __attribute__((ext_vector_type(2)));
        const PG8_LAS f32x2v* S = (const PG8_LAS f32x2v*)(lds + 8192);
        const int col0 = u.pn * BM + wc * 32 + 4 * fq;
#pragma unroll
        for (int bj = 0; bj < 2; ++bj)
#pragma unroll
            for (int n = 0; n < 2; ++n) { const f32x4 bv = bias ? *(const f32x4*)(bias + col0 + bj * HALF + n * 16) : (f32x4){0.f, 0.f, 0.f, 0.f};
#pragma unroll
                for (int ai = 0; ai < 2; ++ai)
#pragma unroll
                    for (int m = 0; m < 4; ++m) acc[ai][bj][m][n] += bv; }
        f32x4 pre[4][2][2];
#pragma unroll
        for (int m = 0; m < 4; ++m) { const size_t off = (size_t)(u.pm * BM + wr * 64 + m * 16 + fr) * ldc + col0;
#pragma unroll
            for (int bj = 0; bj < 2; ++bj)
#pragma unroll
                for (int n = 0; n < 2; ++n) pre[m][bj][n] = *(const f32x4*)(base + off + bj * HALF + n * 16); }
        const bool bad = st.run(acc, u, wr, wc, fr, fq, lds, wid, lane) || poison != 0u;
        const float qnan = __builtin_nanf("");
#pragma unroll
        for (int ai = 0; ai < 2; ++ai)
#pragma unroll
            for (int m = 0; m < 4; ++m) { const int r = ai * HALF + wr * 64 + m * 16 + fr; const f32x2v sr = S[r]; const size_t off = (size_t)(u.pm * BM + r) * ldc + col0;
#pragma unroll
                for (int bj = 0; bj < 2; ++bj)
#pragma unroll
                    for (int n = 0; n < 2; ++n) { const f32x4 bs = ai == 0 ? pre[m][bj][n] : *(const f32x4*)(base + off + bj * HALF + n * 16); f32x4 o = bs + (acc[ai][bj][m][n] - sr.x) * sr.y;
                        if (bad) o = (f32x4){qnan, qnan, qnan, qnan}; *(f32x4*)(out + off + bj * HALF + n * 16) = o; }
                if (m & 1) asm volatile("" ::: "memory"); }
    }
};
struct EpiLnResLn {
    static constexpr bool PERM = false, AFTER_DRAIN = true;
    const float* base; float* out; bf16_t* xn; int ldc; const float* bias; PanelStats st1, st2; unsigned poison;
    __device__ __forceinline__ void fused(f32x4 (&acc)[2][2][4][2], const Unit& u, int wr, int wc, int fr, int fq, PG8_LAS unsigned char* lds, int wid, int lane) const {
        typedef float f32x2v __attribute__((ext_vector_type(2))); typedef unsigned u32x2v __attribute__((ext_vector_type(2)));
        const PG8_LAS f32x2v* S = (const PG8_LAS f32x2v*)(lds + 8192);
        const int col0 = u.pn * BM + wc * 32 + 4 * fq;
#pragma unroll
        for (int bj = 0; bj < 2; ++bj)
#pragma unroll
            for (int n = 0; n < 2; ++n) { const f32x4 bv = bias ? *(const f32x4*)(bias + col0 + bj * HALF + n * 16) : (f32x4){0.f, 0.f, 0.f, 0.f};
#pragma unroll
                for (int ai = 0; ai < 2; ++ai)
#pragma unroll
                    for (int m = 0; m < 4; ++m) acc[ai][bj][m][n] += bv; }
        bool bad = st1.run(acc, u, wr, wc, fr, fq, lds, wid, lane) || poison != 0u;
        const float qnan = __builtin_nanf("");
#pragma unroll
        for (int ai = 0; ai < 2; ++ai)
#pragma unroll
            for (int m = 0; m < 4; ++m) { const int r = ai * HALF + wr * 64 + m * 16 + fr; const f32x2v sr = S[r]; const size_t off = (size_t)(u.pm * BM + r) * ldc + col0;
#pragma unroll
                for (int bj = 0; bj < 2; ++bj)
#pragma unroll
                    for (int n = 0; n < 2; ++n) { const f32x4 bs = *(const f32x4*)(base + off + bj * HALF + n * 16); acc[ai][bj][m][n] = bs + (acc[ai][bj][m][n] - sr.x) * sr.y; }
                asm volatile("" : "+v"(acc[ai][0][m][0]), "+v"(acc[ai][0][m][1]), "+v"(acc[ai][1][m][0]), "+v"(acc[ai][1][m][1]));
                if (m & 1) asm volatile("" ::: "memory"); }
        const bool bad1 = bad;
        bad = st2.run(acc, u, wr, wc, fr, fq, lds, wid, lane) || bad;
#pragma unroll
        for (int ai = 0; ai < 2; ++ai)
#pragma unroll
            for (int m = 0; m < 4; ++m) { const int r = ai * HALF + wr * 64 + m * 16 + fr; const f32x2v sr = S[r]; const size_t off = (size_t)(u.pm * BM + r) * ldc + col0;
#pragma unroll
                for (int bj = 0; bj < 2; ++bj)
#pragma unroll
                    for (int n = 0; n < 2; ++n) { const f32x4 x1 = acc[ai][bj][m][n]; *(f32x4*)(out + off + bj * HALF + n * 16) = bad1 ? (f32x4){qnan, qnan, qnan, qnan} : x1;
                        const f32x4 o = (x1 - sr.x) * sr.y; u32x2v w; w.x = cvt_pk_bf16(o[0], o[1]); w.y = cvt_pk_bf16(o[2], o[3]);
                        if (bad) { w.x = 0x7fc07fc0u; w.y = 0x7fc07fc0u; } *(u32x2v*)(xn + off + bj * HALF + n * 16) = w; }
                asm volatile("" ::: "memory"); }
    }
};

template <class Epi, class Sched, bool ALIGN_EPI = false, bool SP2 = false>
__device__ __forceinline__ void gemm_phase(PG8_LAS unsigned char* lds, const Gemm g, const Sched& S, const Epi& E) {
    int tid_l = threadIdx.x; asm volatile("" : "+v"(tid_l));
    const int tid = tid_l, wid = __builtin_amdgcn_readfirstlane(tid >> 6), lane = tid & 63, wr = wid >> 2, wc = wid & 3, fr = lane & 15, fq = lane >> 4;
    const int K = g.K, nt = K / BK;
    unsigned voffA[2], voffB[2];
#pragma unroll
    for (int i = 0; i < 2; ++i) { int R, C; stage_rc(tid * 16 + i * 8192, R, C); const int Rb = Epi::PERM ? ((R & ~31) + perm32(R & 31)) : R;
        voffA[i] = (unsigned)(R * K + C) * 2u; voffB[i] = (unsigned)(Rb * K + C) * 2u; }
    const size_t kstep = (size_t)(BK * 2);
    const size_t hstep = (size_t)HALF * K * 2;
    const size_t tstep = 2 * hstep;
    const unsigned ldsw = (unsigned)wid * 1024u;
    const int aoff = lds_byte(wr * 64 + fr, fq * 8), boff = lds_byte(wc * 32 + fr, fq * 8);
#define PG8_SA(b, h) (((b) * 2 + (h)) * HTB)
#define PG8_SB(b, h) ((4 + (b) * 2 + (h)) * HTB)
#define PG8_STAGE(bufoff, gbase, voff) do { _Pragma("unroll") for (int _i = 0; _i < 2; ++_i) \
        __builtin_amdgcn_global_load_lds((const unsigned*)((const char*)(gbase) + (voff)[_i]), (PG8_LAS unsigned*)(lds + (bufoff) + ldsw + _i * 8192), 16, 0, 0); } while (0)
#define PG8_LDA(dst, b, h) do { _Pragma("unroll") for (int m = 0; m < 4; ++m) _Pragma("unroll") for (int k = 0; k < 2; ++k) dst[m][k] = *(const PG8_LAS bf16x8*)(lds + PG8_SA(b, h) + aoff + m * 2048 + k * 1024); } while (0)
#define PG8_LDB(dst, b, h) do { _Pragma("unroll") for (int n = 0; n < 2; ++n) _Pragma("unroll") for (int k = 0; k < 2; ++k) dst[n][k] = *(const PG8_LAS bf16x8*)(lds + PG8_SB(b, h) + boff + n * 2048 + k * 1024); } while (0)
#define PG8_MMA(ai, bj, At, Bt) do { __builtin_amdgcn_s_setprio(1); _Pragma("unroll") for (int m = 0; m < 4; ++m) _Pragma("unroll") for (int n = 0; n < 2; ++n) _Pragma("unroll") for (int k = 0; k < 2; ++k) \
        acc[ai][bj][m][n] = __builtin_amdgcn_mfma_f32_16x16x32_bf16(Bt[n][k], At[m][k], acc[ai][bj][m][n], 0, 0, 0); __builtin_amdgcn_s_setprio(0); } while (0)
#define PG8_WAIT_V(n) asm volatile("s_waitcnt vmcnt(" #n ")" ::: "memory")
#define PG8_WAIT_L(n) asm volatile("s_waitcnt lgkmcnt(" #n ")" ::: "memory")
#define PG8_BAR __builtin_amdgcn_s_barrier()
#define PG8_SCHED __builtin_amdgcn_sched_barrier(0)
    Unit cur, nxt; int ui = 0;
    if (!S.next(0, cur)) return;
    f32x4 acc[2][2][4][2];
#pragma unroll
    for (int a = 0; a < 2; ++a)
#pragma unroll
        for (int b = 0; b < 2; ++b)
#pragma unroll
            for (int m = 0; m < 4; ++m)
#pragma unroll
                for (int n = 0; n < 2; ++n) acc[a][b][m][n] = (f32x4){0.f, 0.f, 0.f, 0.f};
    bf16x8 At[4][2], B0[2][2], B1[2][2];
    const char* cA = (const char*)g.A + (size_t)cur.pm * tstep; const char* cB = (const char*)g.Bt + (size_t)cur.pn * tstep;
    S.a_ready(cur);
    if constexpr (SP2) {
        PG8_STAGE(PG8_SB(0, 0), cB, voffB); PG8_STAGE(PG8_SB(0, 1), cB + hstep, voffB); PG8_STAGE(PG8_SA(0, 0), cA, voffA); PG8_STAGE(PG8_SA(0, 1), cA + hstep, voffA);
        if (wr == 1) PG8_BAR;
        PG8_WAIT_V(2); PG8_BAR;
        PG8_STAGE(PG8_SB(1, 0), cB + kstep, voffB); PG8_STAGE(PG8_SA(1, 0), cA + kstep, voffA); PG8_STAGE(PG8_SB(1, 1), cB + hstep + kstep, voffB);
        PG8_WAIT_V(6); PG8_BAR;
    } else {
        PG8_STAGE(PG8_SB(0, 0), cB, voffB); PG8_STAGE(PG8_SA(0, 0), cA, voffA); PG8_STAGE(PG8_SB(0, 1), cB + hstep, voffB); PG8_STAGE(PG8_SA(0, 1), cA + hstep, voffA);
        if (wr == 1) PG8_BAR;
        PG8_WAIT_V(4); PG8_BAR;
        PG8_STAGE(PG8_SB(1, 0), cB + kstep, voffB); PG8_STAGE(PG8_SA(1, 0), cA + kstep, voffA); PG8_STAGE(PG8_SB(1, 1), cB + hstep + kstep, voffB);
        PG8_WAIT_V(6); PG8_BAR;
    }
    for (;;) {
        const bool has_next = S.next(ui + 1, nxt);
        const char* nA = has_next ? (const char*)g.A + (size_t)nxt.pm * tstep : cA; const char* nB = has_next ? (const char*)g.Bt + (size_t)nxt.pn * tstep : cB;
        for (int t = 0; t < nt; t += 2) {
            const bool last = (t == nt - 2);
            const char* a1 = cA + (size_t)(t + 1) * kstep;
            const char* a2 = last ? nA : cA + (size_t)(t + 2) * kstep; const char* b2 = last ? nB : cB + (size_t)(t + 2) * kstep;
            const char* a3 = a2 + kstep; const char* b3 = b2 + kstep;
            if (last && has_next) S.a_ready(nxt);
            if constexpr (SP2) {
            PG8_LDB(B0, 0, 0); PG8_LDB(B1, 0, 1); PG8_SCHED; PG8_LDA(At, 0, 0); PG8_STAGE(PG8_SA(1, 1), a1 + hstep, voffA);
            PG8_WAIT_V(8); PG8_WAIT_L(0); PG8_BAR; PG8_MMA(0, 0, At, B0); PG8_MMA(0, 1, At, B1); PG8_BAR; PG8_SCHED;
            PG8_LDA(At, 0, 1); PG8_STAGE(PG8_SB(0, 0), b2, voffB); PG8_STAGE(PG8_SB(0, 1), b2 + hstep, voffB); PG8_STAGE(PG8_SA(0, 0), a2, voffA);
            PG8_WAIT_V(8); PG8_WAIT_L(0); PG8_BAR; PG8_MMA(1, 0, At, B0); PG8_MMA(1, 1, At, B1); PG8_BAR; PG8_SCHED;
            PG8_LDB(B0, 1, 0); PG8_LDB(B1, 1, 1); PG8_SCHED; PG8_LDA(At, 1, 0); PG8_STAGE(PG8_SA(0, 1), a2 + hstep, voffA);
            PG8_WAIT_V(8); PG8_WAIT_L(0); PG8_BAR; PG8_MMA(0, 0, At, B0); PG8_MMA(0, 1, At, B1); PG8_BAR; PG8_SCHED;
            PG8_LDA(At, 1, 1); PG8_STAGE(PG8_SB(1, 0), b3, voffB); PG8_STAGE(PG8_SB(1, 1), b3 + hstep, voffB); PG8_STAGE(PG8_SA(1, 0), a3, voffA);
            PG8_WAIT_V(8); PG8_WAIT_L(0); PG8_BAR; PG8_MMA(1, 0, At, B0); PG8_MMA(1, 1, At, B1); PG8_BAR; PG8_SCHED;
            } else {
            PG8_LDB(B0, 0, 0); PG8_SCHED; PG8_LDA(At, 0, 0); PG8_STAGE(PG8_SA(1, 1), a1 + hstep, voffA);
            PG8_WAIT_L(8); PG8_BAR; PG8_WAIT_L(0); PG8_MMA(0, 0, At, B0); PG8_BAR; PG8_SCHED;
            PG8_LDB(B1, 0, 1); PG8_STAGE(PG8_SB(0, 0), b2, voffB);
            PG8_BAR; PG8_WAIT_L(0); PG8_MMA(0, 1, At, B1); PG8_BAR;
            PG8_LDA(At, 0, 1); PG8_STAGE(PG8_SA(0, 0), a2, voffA);
            PG8_BAR; PG8_WAIT_L(0); PG8_MMA(1, 0, At, B0); PG8_BAR; PG8_SCHED;
            PG8_STAGE(PG8_SB(0, 1), b2 + hstep, voffB);
            PG8_WAIT_V(6); PG8_BAR; PG8_MMA(1, 1, At, B1); PG8_BAR;
            PG8_LDB(B0, 1, 0); PG8_SCHED; PG8_LDA(At, 1, 0); PG8_STAGE(PG8_SA(0, 1), a2 + hstep, voffA);
            PG8_WAIT_L(8); PG8_BAR; PG8_WAIT_L(0); PG8_MMA(0, 0, At, B0); PG8_BAR; PG8_SCHED;
            PG8_LDB(B1, 1, 1); PG8_STAGE(PG8_SB(1, 0), b3, voffB);
            PG8_BAR; PG8_WAIT_L(0); PG8_MMA(0, 1, At, B1); PG8_BAR;
            PG8_LDA(At, 1, 1); PG8_STAGE(PG8_SA(1, 0), a3, voffA);
            PG8_BAR; PG8_WAIT_L(0); PG8_MMA(1, 0, At, B0); PG8_BAR; PG8_SCHED;
            PG8_STAGE(PG8_SB(1, 1), b3 + hstep, voffB);
            PG8_WAIT_V(6); PG8_BAR; PG8_MMA(1, 1, At, B1); PG8_BAR;
            }
        }
        if constexpr (ALIGN_EPI) { if (wr == 0) PG8_BAR; }
        if constexpr (!Epi::AFTER_DRAIN) { E(acc, cur, wr, wc, fr, fq); S.done(cur); }
        if (!has_next) break;
#pragma unroll
        for (int a = 0; a < 2; ++a)
#pragma unroll
            for (int b = 0; b < 2; ++b)
#pragma unroll
                for (int m = 0; m < 4; ++m)
#pragma unroll
                    for (int n = 0; n < 2; ++n) acc[a][b][m][n] = (f32x4){0.f, 0.f, 0.f, 0.f};
        cur = nxt; cA = nA; cB = nB; ++ui;
        if constexpr (ALIGN_EPI) { if (wr == 1) PG8_BAR; }
    }
    PG8_WAIT_V(0);
    if constexpr (!ALIGN_EPI) { if (wr == 0) PG8_BAR; }
    PG8_BAR;
    if constexpr (Epi::AFTER_DRAIN) { E.fused(acc, cur, wr, wc, fr, fq, lds, wid, lane); S.done(cur); }
#undef PG8_SA
#undef PG8_SB
#undef PG8_STAGE
#undef PG8_LDA
#undef PG8_LDB
#undef PG8_MMA
#undef PG8_WAIT_V
#undef PG8_WAIT_L
#undef PG8_BAR
#undef PG8_SCHED
}
}
namespace pg8 {
struct EpiSwiGLU {
    static constexpr bool PERM = true, AFTER_DRAIN = false;
    bf16_t* O; int ldc;
    __device__ __forceinline__ void operator()(const f32x4 (&acc)[2][2][4][2], const Unit& u, int wr, int wc, int fr, int fq) const {
        const int row0 = u.pm * BM + wr * 64 + fr, col0 = u.pn * HALF + wc * 32 + 8 * fq;
#pragma unroll
        for (int ai = 0; ai < 2; ++ai)
#pragma unroll
            for (int m = 0; m < 4; ++m) { bf16_t* rowp = O + (size_t)(row0 + ai * HALF + m * 16) * ldc + col0;
                float v[8];
#pragma unroll
                for (int n = 0; n < 2; ++n)
#pragma unroll
                    for (int j = 0; j < 4; ++j) { const float g = acc[ai][0][m][n][j], up = acc[ai][1][m][n][j];
                        const float e = __builtin_amdgcn_exp2f(g * -1.4426950408889634f); v[4 * n + j] = g * __builtin_amdgcn_rcpf(1.0f + e) * up; }
                u32x4 w; w.x = cvt_pk_bf16(v[0], v[1]); w.y = cvt_pk_bf16(v[2], v[3]); w.z = cvt_pk_bf16(v[4], v[5]); w.w = cvt_pk_bf16(v[6], v[7]);
                __builtin_nontemporal_store(w, (u32x4*)rowp); }
    }
};
struct EpiResid {
    static constexpr bool PERM = true, AFTER_DRAIN = false;
    bf16_t* X; int ldc; float alpha;
    __device__ __forceinline__ void operator()(const f32x4 (&acc)[2][2][4][2], const Unit& u, int wr, int wc, int fr, int fq) const {
        const int row0 = u.pm * BM + wr * 64 + fr, col0 = u.pn * BM + wc * 32 + 8 * fq;
#pragma unroll
        for (int ai = 0; ai < 2; ++ai)
#pragma unroll
            for (int m = 0; m < 4; ++m) { bf16_t* rowp = X + (size_t)(row0 + ai * HALF + m * 16) * ldc + col0;
#pragma unroll
                for (int bj = 0; bj < 2; ++bj) { const u32x4 x = *(const u32x4*)(rowp + bj * HALF);
                    const f32x4 a0 = acc[ai][bj][m][0], a1 = acc[ai][bj][m][1];
                    float r[8];
                    r[0] = alpha * __uint_as_float(x.x << 16) + a0[0]; r[1] = alpha * __uint_as_float(x.x & 0xffff0000u) + a0[1];
                    r[2] = alpha * __uint_as_float(x.y << 16) + a0[2]; r[3] = alpha * __uint_as_float(x.y & 0xffff0000u) + a0[3];
                    r[4] = alpha * __uint_as_float(x.z << 16) + a1[0]; r[5] = alpha * __uint_as_float(x.z & 0xffff0000u) + a1[1];
                    r[6] = alpha * __uint_as_float(x.w << 16) + a1[2]; r[7] = alpha * __uint_as_float(x.w & 0xffff0000u) + a1[3];
                    u32x4 w; w.x = cvt_pk_bf16(r[0], r[1]); w.y = cvt_pk_bf16(r[2], r[3]); w.z = cvt_pk_bf16(r[4], r[5]); w.w = cvt_pk_bf16(r[6], r[7]);
                    *(u32x4*)(rowp + bj * HALF) = w; } }
    }
};
}
#define LAS __attribute__((address_space(3)))
typedef unsigned short bf16;
typedef short bf16x8 __attribute__((ext_vector_type(8)));
typedef short s16x4 __attribute__((ext_vector_type(4)));
typedef float f32x4 __attribute__((ext_vector_type(4)));
typedef float f32x16 __attribute__((ext_vector_type(16)));
typedef unsigned v4u __attribute__((ext_vector_type(4)));
typedef unsigned v2u __attribute__((ext_vector_type(2)));

constexpr int NWAVES = 8, NTHR = 512;
constexpr int BATCH = 8, SEQ = 4096, DM = 1024, M = BATCH * SEQ;
constexpr int NQ0 = 2560;
constexpr int C_QA = 0, C_CKV = 512, C_QIDX = 640, C_KIDX = 896, C_QB = 960, C_KB = 1472, C_VB = 1984, C_WIDX = 2496;
constexpr int KO0 = 1024;
constexpr int DFF = 2816, NGU = 2 * DFF;
constexpr int NQ1 = 3072;
constexpr int TOPK = 256;
constexpr float LOG2E = 1.4426950408889634f;
constexpr float C2 = 0.125f * LOG2E;
constexpr float ALPHA = 1.4142135623730951f;

constexpr size_t MiB = 1u << 20;
constexpr size_t WS_W0IN = 1 * MiB, WS_W0OUT = 7 * MiB, WS_WGU0 = 10 * MiB, WS_WGU1 = 21 * MiB, WS_WDN0 = 32 * MiB, WS_WDN1 = 38 * MiB, WS_W1IN = 44 * MiB, WS_W1OUT = 50 * MiB;
constexpr size_t WS_KMEAN = 52 * MiB, WS_ALLOW = 53 * MiB, WS_KN2 = 55 * MiB, WS_WUKT = 55 * MiB + 262144, WS_WUVT = 55 * MiB + 524288, WS_CKVN = 56 * MiB, WS_X = 64 * MiB, WS_R1 = 128 * MiB, WS_OCAT = 320 * MiB, WS_KIDXC = 416 * MiB, WS_END = 420 * MiB;

constexpr int LDS_BYTES = 163840;

__device__ __forceinline__ unsigned f2bf(float f) { unsigned u = __builtin_bit_cast(unsigned, f); return (u + 0x7fffu + ((u >> 16) & 1u)) >> 16; }
__device__ __forceinline__ unsigned pk2(float lo, float hi) { return f2bf(lo) | (f2bf(hi) << 16); }
__device__ __forceinline__ float bflo(unsigned w) { return __uint_as_float(w << 16); }
__device__ __forceinline__ float bfhi(unsigned w) { return __uint_as_float(w & 0xffff0000u); }
__device__ __forceinline__ float bf1(unsigned short h) { return __uint_as_float(((unsigned)h) << 16); }
#define LDS_WAIT() asm volatile("s_waitcnt lgkmcnt(0)" ::: "memory")
__device__ __forceinline__ float wave_sum(float v) {
    v += __builtin_bit_cast(float, __builtin_amdgcn_update_dpp(0, __builtin_bit_cast(int, v), 0xB1, 0xf, 0xf, false));
    v += __builtin_bit_cast(float, __builtin_amdgcn_update_dpp(0, __builtin_bit_cast(int, v), 0x4E, 0xf, 0xf, false));
    v += __builtin_bit_cast(float, __builtin_amdgcn_update_dpp(0, __builtin_bit_cast(int, v), 0x124, 0xf, 0xf, false));
    v += __builtin_bit_cast(float, __builtin_amdgcn_update_dpp(0, __builtin_bit_cast(int, v), 0x128, 0xf, 0xf, false));
    const float a = __builtin_bit_cast(float, __builtin_amdgcn_readlane(__builtin_bit_cast(int, v), 0)), b = __builtin_bit_cast(float, __builtin_amdgcn_readlane(__builtin_bit_cast(int, v), 16));
    const float c = __builtin_bit_cast(float, __builtin_amdgcn_readlane(__builtin_bit_cast(int, v), 32)), d = __builtin_bit_cast(float, __builtin_amdgcn_readlane(__builtin_bit_cast(int, v), 48));
    return (a + b) + (c + d);
}
__device__ __forceinline__ int crow(int r, int hi) { return (r & 3) + 8 * (r >> 2) + 4 * hi; }

__device__ __forceinline__ void tr_item(const float* W, int ldsrc, int k0, int c0, int cvalid, bf16* WT, int lddst, int r0, int dk0, float scale, LAS float* scr, int lane) {
#pragma unroll 8
    for (int i = 0; i < 32; ++i) { const int kk = 2 * i + (lane >> 5), c = lane & 31;
        scr[kk * 33 + c] = (c < cvalid) ? __builtin_nontemporal_load(W + (size_t)(k0 + kk) * ldsrc + c0 + c) * scale : 0.f; }
    LDS_WAIT(); asm volatile("" ::: "memory");
    const int c8 = lane & 7;
#pragma unroll
    for (int j = 0; j < 4; ++j) { const int n = (lane >> 3) + 8 * j; const LAS float* s = scr + (8 * c8) * 33 + n;
        v4u o; o.x = pk2(s[0 * 33], s[1 * 33]); o.y = pk2(s[2 * 33], s[3 * 33]); o.z = pk2(s[4 * 33], s[5 * 33]); o.w = pk2(s[6 * 33], s[7 * 33]);
        *(v4u*)(WT + (size_t)(r0 + n) * lddst + dk0 + k0 + 8 * c8) = o; }
    LDS_WAIT(); asm volatile("" ::: "memory");
}
__device__ __forceinline__ void tr_job(const float* W, int ldsrc, int K, int cs, int ncols, int nvalid, bf16* WT, int lddst, int r0, int dk0, float scale, int mode,
                                       LAS float* scr, int lane, int gw, int NGW, int& rot) {
    const int ncg = ncols / 32, nitems = (K / 64) * ncg;
    int start = gw - rot; if (start < 0) start += NGW;
    for (int it = start; it < nitems; it += NGW) {
        const int kb = it / ncg, cg_ = it % ncg, crel = 32 * cg_;
        const int cv = nvalid - crel < 0 ? 0 : (nvalid - crel > 32 ? 32 : nvalid - crel);
        const int col = cs + crel;
        const int row = mode == 0 ? r0 + crel : 256 * (col / 128) + 128 * (mode - 1) + (col % 128);
        tr_item(W, ldsrc, 64 * kb, col, cv, WT, lddst, row, dk0, scale, scr, lane);
    }
    rot = (rot + nitems) % NGW;
}

template <bool FINAL> __device__ __forceinline__ void ln_row(bf16* xrow, const float* g, const float* bta, float* orow, int lane) {
    const v4u* xp = (const v4u*)xrow; v4u w[2]; float v[16]; float s = 0.f;
#pragma unroll
    for (int j = 0; j < 2; ++j) { w[j] = xp[lane + 64 * j];
        v[8 * j + 0] = bflo(w[j].x); v[8 * j + 1] = bfhi(w[j].x); v[8 * j + 2] = bflo(w[j].y); v[8 * j + 3] = bfhi(w[j].y);
        v[8 * j + 4] = bflo(w[j].z); v[8 * j + 5] = bfhi(w[j].z); v[8 * j + 6] = bflo(w[j].w); v[8 * j + 7] = bfhi(w[j].w); }
#pragma unroll
    for (int i = 0; i < 16; ++i) s += v[i];
    const float mean = wave_sum(s) * (1.f / DM); float s2 = 0.f;
#pragma unroll
    for (int i = 0; i < 16; ++i) { v[i] -= mean; s2 += v[i] * v[i]; }
    const float rstd = 1.f / sqrtf(wave_sum(s2) * (1.f / DM) + 1e-5f);
#pragma unroll
    for (int j = 0; j < 2; ++j) { const int c0 = 8 * (lane + 64 * j);
        const f32x4 g0 = *(const f32x4*)(g + c0), g1 = *(const f32x4*)(g + c0 + 4), b0 = *(const f32x4*)(bta + c0), b1 = *(const f32x4*)(bta + c0 + 4);
        float r[8];
#pragma unroll
        for (int i = 0; i < 4; ++i) { r[i] = v[8 * j + i] * rstd * g0[i] + b0[i]; r[4 + i] = v[8 * j + 4 + i] * rstd * g1[i] + b1[i]; }
        if (FINAL) { __builtin_nontemporal_store((f32x4){r[0], r[1], r[2], r[3]}, (f32x4*)(orow + c0)); __builtin_nontemporal_store((f32x4){r[4], r[5], r[6], r[7]}, (f32x4*)(orow + c0 + 4)); }
        else { v4u o; o.x = pk2(r[0], r[1]); o.y = pk2(r[2], r[3]); o.z = pk2(r[4], r[5]); o.w = pk2(r[6], r[7]); ((v4u*)xrow)[lane + 64 * j] = o; } }
}

__device__ __forceinline__ void stick_unit(const bf16* QKV, bf16* OCAT, int b, int h, int qt, int lane) {
    const int r32 = lane & 31, hi = lane >> 5, q0 = qt * 32, t = q0 + r32; const size_t rowb = (size_t)b * SEQ;
    bf16x8 qf[4];
    { const bf16* qp = QKV + (rowb + q0 + r32) * NQ0 + C_QB + h * 64 + hi * 8;
#pragma unroll
      for (int ks = 0; ks < 4; ++ks) qf[ks] = *(const bf16x8*)(qp + ks * 16); }
    f32x16 o0 = f32x16{}, o1 = f32x16{}; float carry = 0.f;
    for (int kt = qt; kt >= 0; --kt) {
        const int kb = kt * 32;
        const bf16* kp = QKV + (rowb + kb + r32) * NQ0 + C_KB + h * 64 + hi * 8;
        f32x16 z = f32x16{};
#pragma unroll
        for (int ks = 0; ks < 4; ++ks) { const bf16x8 kf = *(const bf16x8*)(kp + ks * 16); z = __builtin_amdgcn_mfma_f32_32x32x16_bf16(kf, qf[ks], z, 0, 0, 0); }
        bf16x8 vf[2][2];
        { const bf16* vp = QKV + (rowb + kb + 4 * hi) * NQ0 + C_VB + h * 64 + r32;
#pragma unroll
          for (int s = 0; s < 2; ++s)
#pragma unroll
            for (int dh = 0; dh < 2; ++dh)
#pragma unroll
              for (int j = 0; j < 8; ++j) vf[s][dh][j] = (short)vp[(size_t)(16 * s + 8 * (j >> 2) + (j & 3)) * NQ0 + 32 * dh]; }
        float l1m[16], L2v[16];
#pragma unroll
        for (int r = 0; r < 16; ++r) { const float zz = z[r], e = __builtin_amdgcn_exp2f(-__builtin_fabsf(zz)), lg = __builtin_amdgcn_logf(1.0f + e);
            const bool strict = (kb + crow(r, hi)) < t;
            L2v[r] = __builtin_fminf(zz, 0.f) - lg;
            l1m[r] = strict ? -(__builtin_fmaxf(zz, 0.f) + lg) : 0.f; }
        float gs[4], ps[4];
#pragma unroll
        for (int j = 0; j < 4; ++j) { gs[j] = (l1m[4 * j] + l1m[4 * j + 1]) + (l1m[4 * j + 2] + l1m[4 * j + 3]);
            auto sw = __builtin_amdgcn_permlane32_swap(__float_as_uint(gs[j]), __float_as_uint(gs[j]), false, false); ps[j] = __uint_as_float(hi ? sw[0] : sw[1]); }
        float a[16]; float above = carry;
#pragma unroll
        for (int j = 3; j >= 0; --j) {
            float rem = above + (hi == 0 ? ps[j] : 0.f);
#pragma unroll
            for (int i = 3; i >= 0; --i) { const int r = 4 * j + i; const bool strict = (kb + crow(r, hi)) < t;
                a[r] = strict ? __builtin_amdgcn_exp2f(L2v[r] + rem) : 0.f; rem += l1m[r]; }
            above += gs[j] + ps[j]; }
        carry = above;
        bf16x8 pa0, pa1;
#pragma unroll
        for (int j = 0; j < 8; ++j) { pa0[j] = (short)f2bf(a[j]); pa1[j] = (short)f2bf(a[8 + j]); }
        o0 = __builtin_amdgcn_mfma_f32_32x32x16_bf16(pa0, vf[0][0], o0, 0, 0, 0); o1 = __builtin_amdgcn_mfma_f32_32x32x16_bf16(pa0, vf[0][1], o1, 0, 0, 0);
        o0 = __builtin_amdgcn_mfma_f32_32x32x16_bf16(pa1, vf[1][0], o0, 0, 0, 0); o1 = __builtin_amdgcn_mfma_f32_32x32x16_bf16(pa1, vf[1][1], o1, 0, 0, 0);
        if (kt > 0 && __all(carry < -48.f)) break;
    }
    bf16* op = OCAT + (rowb + q0) * KO0 + 512 + h * 64 + r32;
#pragma unroll
    for (int r = 0; r < 16; ++r) { op[(size_t)crow(r, hi) * KO0] = (bf16)f2bf(o0[r]); op[(size_t)crow(r, hi) * KO0 + 32] = (bf16)f2bf(o1[r]); }
}

constexpr int IX_HIST = 0, IX_HSTRIDE = 513;
constexpr int IX_STAGE = 0, IX_SROW = 272, IX_SBYTES = 32 * IX_SROW;
#ifndef DSA_RL
#define DSA_RL 96u
#endif
constexpr int IX_CAP = 640;
constexpr int IX_CU = 0;
constexpr int IX_CK = IX_CU + 32 * IX_CAP * 4;
constexpr int IX_MASK = IX_CK + 32 * IX_CAP * 2;
constexpr int IX_ST = IX_MASK + 16384;
constexpr int IX_SEL = IX_ST + 2048;
constexpr int IX_SELSTRIDE = 256;
constexpr int IX_END = IX_SEL + 16384;
constexpr int IX_QL = NWAVES * IX_SBYTES;
static_assert(IX_QL + 65536 <= IX_ST && 32 * IX_HSTRIDE * 4 <= IX_MASK && IX_END <= LDS_BYTES - 64, "indexer LDS map");
enum { ST_LO = 0, ST_HI = 1, ST_NEED = 2, ST_MODE = 3, ST_TGE = 4, ST_TEQ = 5, ST_TI = 6, ST_ILO = 7, ST_IHI = 8, ST_NSEL = 9, ST_BSTAR = 10, ST_CCNT = 11 };

struct IdxTile { float v[16]; };
__device__ __forceinline__ void idx_load(const bf16* KIDXC, size_t rowb, int kt, int r32, int hi, bf16x8 (&kf)[4]) {
    const bf16* kp = KIDXC + (rowb + 32 * kt + r32) * 64 + hi * 8;
#pragma unroll
    for (int ks = 0; ks < 4; ++ks) kf[ks] = *(const bf16x8*)(kp + ks * 16);
}
__device__ __forceinline__ void idx_comp(const bf16x8 (&kf)[4], const bf16x8 (&qf)[4][4], const float (&w)[4], float (&v)[16]) {
#pragma unroll
    for (int r = 0; r < 16; ++r) v[r] = 0.f;
#pragma unroll
    for (int hd = 0; hd < 4; ++hd) { f32x16 d = f32x16{};
#pragma unroll
        for (int ks = 0; ks < 4; ++ks) d = __builtin_amdgcn_mfma_f32_32x32x16_bf16(kf[ks], qf[hd][ks], d, 0, 0, 0);
#pragma unroll
        for (int r = 0; r < 16; ++r) v[r] = __builtin_fmaf(w[hd], __builtin_fmaxf(d[r], 0.f), v[r]);
        }
}
#define IDX_TILE_LOOP_BEGIN() bf16x8 kfn[4]; if (wave <= qt) idx_load(KIDXC, rowb, wave, r32, hi, kfn); \
    _Pragma("unroll 1") for (int kt = wave; kt <= qt; kt += NWAVES) { bf16x8 kfc[4]; \
        _Pragma("unroll") for (int ks_ = 0; ks_ < 4; ++ks_) kfc[ks_] = kfn[ks_]; \
        if (kt + NWAVES <= qt) idx_load(KIDXC, rowb, kt + NWAVES, r32, hi, kfn); \
        float v[16]; idx_comp(kfc, qf, w, v);
__device__ __forceinline__ unsigned okey(float v) {
    unsigned b = __float_as_uint(v); if ((b << 1) == 0u) b = 0u;
    return b ^ ((unsigned)((int)b >> 31) | 0x80000000u);
}
__device__ __forceinline__ unsigned wave_sum_u32(unsigned x) {
    x += (unsigned)__builtin_amdgcn_update_dpp(0, (int)x, 0xB1, 0xf, 0xf, false);
    x += (unsigned)__builtin_amdgcn_update_dpp(0, (int)x, 0x4E, 0xf, 0xf, false);
    x += (unsigned)__builtin_amdgcn_update_dpp(0, (int)x, 0x124, 0xf, 0xf, false);
    x += (unsigned)__builtin_amdgcn_update_dpp(0, (int)x, 0x128, 0xf, 0xf, false);
    return (unsigned)__builtin_amdgcn_readlane((int)x, 0) + (unsigned)__builtin_amdgcn_readlane((int)x, 16) + (unsigned)__builtin_amdgcn_readlane((int)x, 32) + (unsigned)__builtin_amdgcn_readlane((int)x, 48);
}
__device__ __forceinline__ unsigned row_scan_u32(unsigned x) {
    x += (unsigned)__builtin_amdgcn_update_dpp(0, (int)x, 0x111, 0xf, 0xf, false);
    x += (unsigned)__builtin_amdgcn_update_dpp(0, (int)x, 0x112, 0xf, 0xf, false);
    x += (unsigned)__builtin_amdgcn_update_dpp(0, (int)x, 0x114, 0xf, 0xf, false);
    x += (unsigned)__builtin_amdgcn_update_dpp(0, (int)x, 0x118, 0xf, 0xf, false);
    return x;
}
__device__ __forceinline__ unsigned wave_scan_u32(unsigned x, int lane) {
    x = row_scan_u32(x);
    const unsigned t0 = (unsigned)__builtin_amdgcn_readlane((int)x, 15), t1 = (unsigned)__builtin_amdgcn_readlane((int)x, 31), t2 = (unsigned)__builtin_amdgcn_readlane((int)x, 47); const int row = lane >> 4;
    return x + (row >= 1 ? t0 : 0u) + (row >= 2 ? t1 : 0u) + (row >= 3 ? t2 : 0u);
}
__device__ __forceinline__ unsigned cbin(float v, int key) {
    const unsigned b = __float_as_uint(v), a = b & 0x7fffffffu; const unsigned A0 = 107u << 23, A0n = 111u << 23, A1 = (139u << 23) - 1u;
    const unsigned kp = ((a < A0 ? A0 : (a > A1 ? A1 : a)) - A0) >> 19, kn = ((a < A0n ? A0n : (a > A1 ? A1 : a)) - A0n) >> 19;
    const unsigned nz = ((int)b < 0) ? 447u - kn : 512u + kp;
    return a == 0u ? 448u + (63u - ((unsigned)key >> 6)) : nz;
}
__device__ __forceinline__ float cbin_edge(unsigned bin) {
    const unsigned A0 = 107u << 23, A0n = 111u << 23;
    if (bin >= 1024u) return INFINITY;
    if (bin >= 512u) { const unsigned kp = bin - 512u; return kp == 0u ? __uint_as_float(1u) : __uint_as_float(A0 + (kp << 19)); }
    if (bin >= 448u) return __uint_as_float(1u);
    const unsigned kn = 447u - bin; if (kn >= 447u) return -INFINITY;
    return -__uint_as_float(A0n + ((kn + 1u) << 19) - 1u);
}
__device__ __forceinline__ int range_shift(unsigned span) {
    const int bits = 32 - __builtin_clz(span | 1u); return bits > 10 ? bits - 10 : 0;
}

__device__ __forceinline__ void dsa_unit(const bf16* QKV, const bf16* KIDXC, const bf16* CKVN, const bf16* WUKT, const bf16* WUVT, bf16* OCAT, int b, int qt, LAS unsigned char* lds, int tid, int wave, int lane, bool do_att, int secs, unsigned long long& pacc) {
    asm volatile("" : "+v"(tid)); lane = tid & 63;
#ifdef DSA_TSEC
    unsigned long long tprev_ = __builtin_amdgcn_s_memrealtime();
#define TS(k) do { const unsigned long long now_ = __builtin_amdgcn_s_memrealtime(); if ((k) == DSA_TSEC || DSA_TSEC == 9) pacc += now_ - tprev_; tprev_ = now_; } while (0)
#else
#define TS(k) do { } while (0)
#endif
    const int r32 = lane & 31, hi = lane >> 5, q0 = qt * 32, t = q0 + r32; const size_t rowb = (size_t)b * SEQ;
    LAS unsigned* HIST = (LAS unsigned*)(lds + IX_HIST); LAS unsigned* MASK = (LAS unsigned*)(lds + IX_MASK);
    LAS unsigned short* SEL = (LAS unsigned short*)(lds + IX_SEL); LAS unsigned* ST = (LAS unsigned*)(lds + IX_ST);
    LAS unsigned* CU = (LAS unsigned*)(lds + IX_CU); LAS unsigned short* CK = (LAS unsigned short*)(lds + IX_CK);
#define LOAD_QF() bf16x8 qf[4][4]; float w[4]; \
    { const bf16* qp = QKV + (rowb + t) * NQ0; \
      _Pragma("unroll") for (int hd = 0; hd < 4; ++hd) { w[hd] = bf1(qp[C_WIDX + hd]); \
        _Pragma("unroll") for (int ks = 0; ks < 4; ++ks) qf[hd][ks] = *(const bf16x8*)(qp + C_QIDX + hd * 64 + ks * 16 + hi * 8); } }
    const bool select_all = (q0 + 32 <= TOPK);
    bool need_generic = false;
    if (select_all) {
        for (int i = tid; i < 32 * (qt + 1); i += NTHR) { const int q = i / (qt + 1), wd = i % (qt + 1); const int nb = (q0 + q) - 32 * wd + 1;
            MASK[q * 128 + wd] = nb >= 32 ? 0xffffffffu : (nb <= 0 ? 0u : ((1u << nb) - 1u)); }
    } else {
        for (int i = tid; i < 32 * IX_HSTRIDE; i += NTHR) HIST[i] = 0u;
        for (int i = tid; i < 32 * (qt + 1); i += NTHR) MASK[(i / (qt + 1)) * 128 + (i % (qt + 1))] = 0u;
        if (tid < 32) ST[tid * 16 + ST_CCNT] = 0u;
        __syncthreads();
        if (secs & 1) { LOAD_QF();
          _Pragma("unroll 1") for (int kt = 4 * wave; kt <= qt; kt += 4 * NWAVES) { bf16x8 kfc[4]; idx_load(KIDXC, rowb, kt, r32, hi, kfc);
              float v[16]; idx_comp(kfc, qf, w, v);
#pragma unroll
              for (int r = 0; r < 16; ++r) { const int key = 32 * kt + crow(r, hi); const unsigned bin = cbin(v[r], key);
                  if (key <= t) __hip_atomic_fetch_add(HIST + r32 * IX_HSTRIDE + (bin >> 1), (bin & 1u) ? 0x10000u : 1u, __ATOMIC_RELAXED, __HIP_MEMORY_SCOPE_WORKGROUP); }
          } }
        __syncthreads(); TS(1);
        { const int q = tid >> 4, sub = tid & 15; LAS unsigned* s = ST + q * 16;
          const LAS unsigned* hq = HIST + q * IX_HSTRIDE + sub * 32; unsigned csum = 0;
#pragma unroll 8
          for (int i = 0; i < 32; ++i) { const unsigned x = hq[i]; csum += (x & 0xffffu) + (x >> 16); }
          const unsigned incl = row_scan_u32(csum);
          const unsigned total = __shfl(incl, 15, 16); const unsigned sufx = total - incl, need = DSA_RL;
          const bool isf = (total >= need) && (sufx < need) && (need <= sufx + csum);
          const unsigned long long fm = __ballot(isf); const unsigned rowbits = (unsigned)(fm >> (16 * (lane >> 4))) & 0xffffu;
          if (total < need) { if (sub == 0) s[ST_BSTAR] = 0u; }
          else { const int f = __builtin_ctz(rowbits | 0x10000u);
              const unsigned base = __shfl(sufx, f, 16);
              const LAS unsigned* hf = HIST + q * IX_HSTRIDE + f * 32 + (30 - 2 * sub);
              const unsigned x1 = hf[1], x0 = hf[0]; const unsigned c3 = x1 >> 16, c2 = x1 & 0xffffu, c1 = x0 >> 16, c0 = x0 & 0xffffu;
              const unsigned s4 = (c3 + c2) + (c1 + c0); const unsigned in4 = row_scan_u32(s4); const unsigned above = base + in4 - s4;
              if (above < need && need <= above + s4) { int bsel = 60 - 4 * sub; unsigned cum = above;
                  if (cum + c3 >= need) bsel += 3; else { cum += c3; if (cum + c2 >= need) bsel += 2; else { cum += c2; if (cum + c1 >= need) bsel += 1; } }
                  s[ST_BSTAR] = (unsigned)(f * 64 + bsel); } } }
        __syncthreads(); TS(2);
        if (secs & 2) { const unsigned lbin = ST[r32 * 16 + ST_BSTAR]; const float thL = cbin_edge(lbin);
          LOAD_QF();
          IDX_TILE_LOOP_BEGIN() unsigned flags = 0u;
              const bool zc = (448u + (63u - ((unsigned)kt >> 1))) >= lbin; const int lim = (kt == qt) ? t : 0x7fffffff;
#pragma unroll
              for (int r = 0; r < 16; ++r) { const int key = 32 * kt + crow(r, hi); const float x = v[r]; flags |= (key <= lim && (x == 0.f ? zc : x >= thL)) ? (1u << r) : 0u; }
              const unsigned cnt = (unsigned)__builtin_popcount(flags);
              unsigned pos = 0u; if (cnt) pos = __hip_atomic_fetch_add(ST + r32 * 16 + ST_CCNT, cnt, __ATOMIC_RELAXED, __HIP_MEMORY_SCOPE_WORKGROUP);
#pragma unroll
              for (int r = 0; r < 16; ++r) { if ((flags >> r) & 1u) { if (pos < (unsigned)IX_CAP) { CU[r32 * IX_CAP + pos] = __float_as_uint(v[r]); CK[r32 * IX_CAP + pos] = (unsigned short)(32 * kt + crow(r, hi)); } ++pos; } }
          } }
        __syncthreads(); TS(3);
        { bool bad = false;
#pragma unroll 4
          for (int q = 0; q < 32; ++q) { const unsigned c = ST[q * 16 + ST_CCNT]; bad = bad || (c > (unsigned)IX_CAP) || (c < (unsigned)TOPK); }
#ifdef DSA_NO_FALLBACK
          need_generic = false; (void)bad; }
#else
          need_generic = bad; }
#endif
        if (!need_generic && (secs & 4)) {
            int cmax = 0;
#pragma unroll
            for (int qq = 0; qq < 4; ++qq) { const int C = (int)ST[(wave * 4 + qq) * 16 + ST_CCNT]; cmax = C > cmax ? C : cmax; }
#define DSA_SELECT(NR) do { unsigned u[4][NR], k[4][NR]; \
            _Pragma("unroll") for (int qq = 0; qq < 4; ++qq) { const int q = wave * 4 + qq; const int C = (int)ST[q * 16 + ST_CCNT]; \
                _Pragma("unroll") for (int i = 0; i < NR; ++i) { const int idx = lane + 64 * i; const bool ok = idx < C; u[qq][i] = ok ? okey(__uint_as_float(CU[q * IX_CAP + idx])) : 0u; k[qq][i] = ok ? (unsigned)CK[q * IX_CAP + idx] : 0xffffu; } } \
            unsigned T0 = 0u, T1 = 0u, T2 = 0u, T3 = 0u; \
            for (int bit = 31; bit >= 0; --bit) { const unsigned c0 = T0 | (1u << bit), c1 = T1 | (1u << bit), c2 = T2 | (1u << bit), c3 = T3 | (1u << bit); unsigned n01 = 0u, n23 = 0u; \
                _Pragma("unroll") for (int i = 0; i < NR; ++i) { n01 += (u[0][i] >= c0 ? 1u : 0u) + (u[1][i] >= c1 ? 0x10000u : 0u); n23 += (u[2][i] >= c2 ? 1u : 0u) + (u[3][i] >= c3 ? 0x10000u : 0u); } \
                n01 = wave_sum_u32(n01); n23 = wave_sum_u32(n23); \
                if ((n01 & 0xffffu) >= (unsigned)TOPK) T0 = c0; if ((n01 >> 16) >= (unsigned)TOPK) T1 = c1; if ((n23 & 0xffffu) >= (unsigned)TOPK) T2 = c2; if ((n23 >> 16) >= (unsigned)TOPK) T3 = c3; } \
            _Pragma("unroll") for (int qq = 0; qq < 4; ++qq) { const int q = wave * 4 + qq; const unsigned T = qq == 0 ? T0 : qq == 1 ? T1 : qq == 2 ? T2 : T3; unsigned ng = 0u; \
                _Pragma("unroll") for (int i = 0; i < NR; ++i) ng += (u[qq][i] > T ? 1u : 0u) + (u[qq][i] == T ? 0x10000u : 0u); \
                ng = wave_sum_u32(ng); \
                const int needt = TOPK - (int)(ng & 0xffffu), ceq = (int)(ng >> 16); unsigned Kth = 0xffffu; \
                if (ceq != needt) { Kth = 0u;                     \
                    for (int bit = 11; bit >= 0; --bit) { const unsigned cand = Kth | (1u << bit); unsigned c = 0u; \
                        _Pragma("unroll") for (int i = 0; i < NR; ++i) c += (u[qq][i] == T && k[qq][i] < cand) ? 1u : 0u; \
                        c = wave_sum_u32(c); \
                        if ((int)c < needt) Kth = cand; } } \
                _Pragma("unroll") for (int i = 0; i < NR; ++i) { if (u[qq][i] > T || (u[qq][i] == T && k[qq][i] <= Kth && u[qq][i] != 0u)) \
                        __hip_atomic_fetch_or(MASK + q * 128 + (k[qq][i] >> 5), 1u << (k[qq][i] & 31u), __ATOMIC_RELAXED, __HIP_MEMORY_SCOPE_WORKGROUP); } \
            } } while (0)
            if (cmax <= 448) DSA_SELECT(7); else DSA_SELECT(10);
#undef DSA_SELECT
        }
    }
    if (need_generic) {
        __syncthreads();
    if (tid < 32) { LAS unsigned* s = ST + tid * 16;
        unsigned z_ = 0u; asm volatile("" : "+v"(z_));
        s[ST_LO] = z_; s[ST_HI] = ~z_; s[ST_NEED] = z_ + TOPK; s[ST_MODE] = z_; s[ST_TGE] = z_; s[ST_TEQ] = z_; s[ST_TI] = z_ + 0xffffu; s[ST_ILO] = z_; s[ST_IHI] = (unsigned)(q0 + tid); }
    __syncthreads();
    for (int pass = 0; pass < 12; ++pass) {
        bool alldone = true;
#pragma unroll 4
        for (int q = 0; q < 32; ++q) alldone = alldone && (ST[q * 16 + ST_MODE] == 2u);
        if (alldone) break;
        for (int i = tid; i < 32 * IX_HSTRIDE; i += NTHR) HIST[i] = 0u;
        const unsigned mode = ST[r32 * 16 + ST_MODE], lo = ST[r32 * 16 + ST_LO], hi_u = ST[r32 * 16 + ST_HI], ilo = ST[r32 * 16 + ST_ILO], ihi = ST[r32 * 16 + ST_IHI];
        const bool usek = (mode == 1u); const unsigned ulo = lo, uspan = (mode == 0u) ? hi_u - lo : 0u, klo = (mode == 2u) ? 0xffffffffu : (usek ? ilo : 0u), kspan = usek ? ihi - ilo : ((mode == 2u) ? 0u : 0xffffffffu);
        const int bsh = usek ? range_shift(ihi - ilo) : range_shift(hi_u - lo);
        __syncthreads();
        { LOAD_QF();
        IDX_TILE_LOOP_BEGIN()
#pragma unroll
            for (int r = 0; r < 16; ++r) { const unsigned key = (unsigned)(32 * kt + crow(r, hi)); const unsigned u = okey(v[r]);
                const unsigned du = u - ulo, dk = key - klo; const bool hit = (du <= uspan) && (dk <= kspan) && ((int)key <= t);
                const unsigned bin = (usek ? dk : du) >> bsh;
                if (hit) __hip_atomic_fetch_add(HIST + r32 * IX_HSTRIDE + (bin >> 1), (bin & 1u) ? 0x10000u : 1u, __ATOMIC_RELAXED, __HIP_MEMORY_SCOPE_WORKGROUP); }
        } }
        __syncthreads();
        { const int q = tid >> 4, sub = tid & 15; LAS unsigned* s = ST + q * 16; const unsigned md = s[ST_MODE];
          const LAS unsigned* hq = HIST + q * IX_HSTRIDE + sub * 32; unsigned csum = 0;
#pragma unroll 8
          for (int i = 0; i < 32; ++i) { const unsigned x = hq[i]; csum += (x & 0xffffu) + (x >> 16); }
          unsigned incl = csum;
#pragma unroll
          for (int o = 1; o < 16; o <<= 1) { const unsigned y = __shfl_up(incl, o, 16); if (sub >= o) incl += y; }
          const unsigned total = __shfl(incl, 15, 16);
          const unsigned need = s[ST_NEED];
          if (md == 0u) {
              const unsigned sufx = total - incl;
              if (sufx < need && need <= sufx + csum) {
                  const unsigned lo_ = s[ST_LO], hi_ = s[ST_HI]; const int sh_ = range_shift(hi_ - lo_);
                  unsigned cum = sufx; int bsel = 0; unsigned cb = 0;
                  for (int bn = 63; bn >= 0; --bn) { const unsigned x = hq[bn >> 1]; const unsigned c = (bn & 1) ? (x >> 16) : (x & 0xffffu);
                      if (cum + c >= need) { bsel = bn; cb = c; break; } cum += c; }
                  const unsigned bglob = (unsigned)(sub * 64 + bsel); const unsigned nlo = lo_ + (bglob << sh_); const unsigned wdt = (sh_ >= 32) ? 0xffffffffu : ((1u << sh_) - 1u);
                  const unsigned nhi = (hi_ - nlo < wdt) ? hi_ : nlo + wdt; const unsigned nneed = need - cum;
                  s[ST_LO] = nlo; s[ST_HI] = nhi; s[ST_NEED] = nneed;
                  if (cb == nneed) { s[ST_TGE] = nlo; s[ST_TEQ] = 0u; s[ST_TI] = 0xffffu; s[ST_MODE] = 2u; }
                  else if (nlo == nhi) { s[ST_MODE] = 1u; }
              }
          } else if (md == 1u) {
              const unsigned prefx = incl - csum;
              if (prefx < need && need <= prefx + csum) {
                  const unsigned ilo_ = s[ST_ILO], ihi_ = s[ST_IHI]; const int ish_ = range_shift(ihi_ - ilo_);
                  unsigned cum = prefx; int bsel = 0; unsigned cb = 0;
                  for (int bn = 0; bn < 64; ++bn) { const unsigned x = hq[bn >> 1]; const unsigned c = (bn & 1) ? (x >> 16) : (x & 0xffffu);
                      if (cum + c >= need) { bsel = bn; cb = c; break; } cum += c; }
                  const unsigned bglob = (unsigned)(sub * 64 + bsel); const unsigned nilo = ilo_ + (bglob << ish_); const unsigned wdt = (1u << ish_) - 1u;
                  const unsigned nihi = (ihi_ - nilo < wdt) ? ihi_ : nilo + wdt; const unsigned nneed = need - cum;
                  s[ST_ILO] = nilo; s[ST_IHI] = nihi; s[ST_NEED] = nneed;
                  if (cb == nneed || nilo == nihi) { s[ST_TGE] = s[ST_LO]; s[ST_TEQ] = s[ST_LO]; s[ST_TI] = nihi; s[ST_MODE] = 2u; }
              }
          } }
        __syncthreads();
    }
    { const unsigned tge = ST[r32 * 16 + ST_TGE], teq = ST[r32 * 16 + ST_TEQ], ti = ST[r32 * 16 + ST_TI]; const bool tie = (ti != 0xffffu);
      LOAD_QF();
      IDX_TILE_LOOP_BEGIN() unsigned bits = 0u;
#pragma unroll
          for (int r = 0; r < 16; ++r) { const int key = 32 * kt + crow(r, hi); const unsigned u = okey(v[r]);
              const bool sel = (key <= t) && (u >= tge) && !(tie && u == teq && (unsigned)key > ti);
              bits |= sel ? (1u << crow(r, hi)) : 0u; }
          bits |= __shfl_xor(bits, 32);
          if (hi == 0) MASK[r32 * 128 + kt] = bits; } }
    }
    __syncthreads(); TS(4);
    if (secs & 8) {
        const int w0i = 2 * lane, w1i = 2 * lane + 1; unsigned m0[4], m1[4], cn[4];
#pragma unroll
        for (int qq = 0; qq < 4; ++qq) { const int q = wave * 4 + qq; m0[qq] = (w0i <= qt) ? MASK[q * 128 + w0i] : 0u; m1[qq] = (w1i <= qt) ? MASK[q * 128 + w1i] : 0u;
            cn[qq] = (unsigned)(__builtin_popcount(m0[qq]) + __builtin_popcount(m1[qq])); }
        const unsigned s01 = wave_scan_u32(cn[0] | (cn[1] << 16), lane), s23 = wave_scan_u32(cn[2] | (cn[3] << 16), lane);
        const unsigned tot01 = (unsigned)__builtin_amdgcn_readlane((int)s01, 63), tot23 = (unsigned)__builtin_amdgcn_readlane((int)s23, 63);
#pragma unroll
        for (int qq = 0; qq < 4; ++qq) { const int q = wave * 4 + qq; const unsigned inc = (qq == 0 ? s01 & 0xffffu : qq == 1 ? s01 >> 16 : qq == 2 ? s23 & 0xffffu : s23 >> 16);
            int pos = (int)(inc - cn[qq]); unsigned a0 = m0[qq], a1 = m1[qq];
            while (a0) { const int bpos = __builtin_ctz(a0); a0 &= a0 - 1u; if (pos < TOPK) SEL[q * IX_SELSTRIDE + pos] = (unsigned short)(64 * lane + bpos); ++pos; }
            while (a1) { const int bpos = __builtin_ctz(a1); a1 &= a1 - 1u; if (pos < TOPK) SEL[q * IX_SELSTRIDE + pos] = (unsigned short)(64 * lane + 32 + bpos); ++pos; }
            const unsigned total = (qq == 0 ? tot01 & 0xffffu : qq == 1 ? tot01 >> 16 : qq == 2 ? tot23 & 0xffffu : tot23 >> 16);
            if (lane == 0) ST[q * 16 + ST_NSEL] = total < (unsigned)TOPK ? total : (unsigned)TOPK; } }
    __syncthreads(); TS(5);
    LAS unsigned char* QLb = lds + IX_QL;
    if (do_att) { bf16x8 qb_[4];
      { const bf16* qa = QKV + (rowb + q0 + r32) * NQ0 + C_QA + wave * 64 + hi * 8;
#pragma unroll
        for (int ks = 0; ks < 4; ++ks) qb_[ks] = *(const bf16x8*)(qa + 16 * ks); }
#pragma unroll
      for (int nt = 0; nt < 4; ++nt) { f32x16 d = f32x16{}; const bf16* wp = WUKT + ((size_t)wave * 128 + 32 * nt + r32) * 64 + hi * 8;
#pragma unroll
          for (int ks = 0; ks < 4; ++ks) d = __builtin_amdgcn_mfma_f32_32x32x16_bf16(*(const bf16x8*)(wp + 16 * ks), qb_[ks], d, 0, 0, 0);
#pragma unroll
          for (int j = 0; j < 4; ++j) { v2u wv; wv.x = pk2(d[4 * j], d[4 * j + 1]); wv.y = pk2(d[4 * j + 2], d[4 * j + 3]);
              *(LAS v2u*)(QLb + ((size_t)r32 * 1024 + wave * 128 + 32 * nt + 8 * j + 4 * hi) * 2) = wv; } } }
    __syncthreads(); TS(6);
    if (do_att) { const int c = lane & 15, g = lane >> 4;
      LAS unsigned char* stg = lds + IX_STAGE + wave * IX_SBYTES;
      const float slope2 = (c < 8) ? LOG2E * __builtin_amdgcn_exp2f(-(float)(c + 1)) : 0.f;
      for (int qi = 0; qi < 4; ++qi) { const int q = wave * 4 + qi, tq = q0 + q; const size_t mrow = rowb + tq;
          const int nsel = (int)ST[q * 16 + ST_NSEL]; const int nsteps = (nsel + 31) >> 5;
          bf16x8 ql[4];
#pragma unroll
          for (int ks = 0; ks < 4; ++ks) { ql[ks] = bf16x8{}; if (c < 8) ql[ks] = *(const LAS bf16x8*)(QLb + ((size_t)q * 1024 + c * 128 + 32 * ks + 8 * g) * 2); }
          float mrun = -INFINITY, lrun = 0.f; f32x4 o[8];
#pragma unroll
          for (int dt = 0; dt < 8; ++dt) o[dt] = f32x4{};
          v4u rvA[8], rvB[8], rvC[8];
          {
#pragma unroll
            for (int i = 0; i < 8; ++i) { const int j = 32 * (0) + 4 * i + g; const int key = (j < nsel) ? (int)SEL[q * IX_SELSTRIDE + j] : 0;
                rvA[i] = *(const v4u*)(CKVN + (rowb + key) * 128 + c * 8); }
            if (nsteps > 1) {
#pragma unroll
            for (int i = 0; i < 8; ++i) { const int j = 32 * (1) + 4 * i + g; const int key = (j < nsel) ? (int)SEL[q * IX_SELSTRIDE + j] : 0;
                rvB[i] = *(const v4u*)(CKVN + (rowb + key) * 128 + c * 8); }
            }
            if (nsteps > 2) {
#pragma unroll
            for (int i = 0; i < 8; ++i) { const int j = 32 * (2) + 4 * i + g; const int key = (j < nsel) ? (int)SEL[q * IX_SELSTRIDE + j] : 0;
                rvC[i] = *(const v4u*)(CKVN + (rowb + key) * 128 + c * 8); }
            } }
          for (int st = 0; st < nsteps; st += 3) {
              {
#pragma unroll
              for (int i = 0; i < 8; ++i) *(LAS v4u*)(stg + (4 * i + g) * IX_SROW + c * 16) = rvA[i];
              if (st + 3 < nsteps) {
#pragma unroll
                  for (int i = 0; i < 8; ++i) { const int j = 32 * (st + 3) + 4 * i + g; const int key = (j < nsel) ? (int)SEL[q * IX_SELSTRIDE + j] : 0;
                      rvA[i] = *(const v4u*)(CKVN + (rowb + key) * 128 + c * 8); } }
              float sc[8];
              { const LAS unsigned short* sp = SEL + q * IX_SELSTRIDE + 32 * (st) + 4 * g;
                f32x4 sa = f32x4{}, sb = f32x4{};
#pragma unroll
                for (int ks = 0; ks < 4; ++ks) { const bf16x8 ka = *(const LAS bf16x8*)(stg + c * IX_SROW + (32 * ks + 8 * g) * 2), kb2 = *(const LAS bf16x8*)(stg + (16 + c) * IX_SROW + (32 * ks + 8 * g) * 2);
                    sa = __builtin_amdgcn_mfma_f32_16x16x32_bf16(ka, ql[ks], sa, 0, 0, 0); sb = __builtin_amdgcn_mfma_f32_16x16x32_bf16(kb2, ql[ks], sb, 0, 0, 0); }
#pragma unroll
                for (int jj = 0; jj < 8; ++jj) { const int li = (jj < 4) ? jj : 12 + jj; const int j = 32 * (st) + 4 * g + li;
                    const float raw = (jj < 4) ? sa[jj] : sb[jj - 4]; const float dist = (float)(tq - (int)sp[li]);
                    sc[jj] = (j < nsel) ? raw - slope2 * dist : -INFINITY; } }
              float smax = __builtin_fmaxf(__builtin_fmaxf(__builtin_fmaxf(sc[0], sc[1]), __builtin_fmaxf(sc[2], sc[3])), __builtin_fmaxf(__builtin_fmaxf(sc[4], sc[5]), __builtin_fmaxf(sc[6], sc[7])));
              { auto r16 = __builtin_amdgcn_permlane16_swap(__float_as_uint(smax), __float_as_uint(smax), false, false); smax = __builtin_fmaxf(__uint_as_float(r16[0]), __uint_as_float(r16[1]));
                auto r32_ = __builtin_amdgcn_permlane32_swap(__float_as_uint(smax), __float_as_uint(smax), false, false); smax = __builtin_fmaxf(__uint_as_float(r32_[0]), __uint_as_float(r32_[1])); }
              const float mnew = __builtin_fmaxf(mrun, smax); const float alpha = __builtin_amdgcn_exp2f(mrun - mnew); mrun = mnew;
              bf16x8 pb; float psum = 0.f;
              { float p[8];
#pragma unroll
                for (int jj = 0; jj < 8; ++jj) { p[jj] = __builtin_amdgcn_exp2f(sc[jj] - mnew); psum += p[jj]; }
                typedef float f32x2_t __attribute__((ext_vector_type(2))); typedef __bf16 bf16x2_t __attribute__((ext_vector_type(2)));
#pragma unroll
                for (int jj = 0; jj < 8; jj += 2) { const f32x2_t pv = {p[jj], p[jj + 1]}; const unsigned pk = __builtin_bit_cast(unsigned, __builtin_convertvector(pv, bf16x2_t)); pb[jj] = (short)(pk & 0xffffu); pb[jj + 1] = (short)(pk >> 16); } }
              lrun = lrun * alpha + psum;
              const bool resc = !__all(alpha == 1.0f);
#pragma unroll
              for (int dt = 0; dt < 8; ++dt) { if (resc) o[dt] = o[dt] * alpha;
                  const LAS unsigned char* a0 = stg + (4 * g + (c >> 2)) * IX_SROW + (16 * dt + 4 * (c & 3)) * 2;
                  const s16x4 lo4 = __builtin_bit_cast(s16x4, __builtin_amdgcn_ds_read_tr16_b64_v4i16((LAS s16x4*)a0));
                  const s16x4 hi4 = __builtin_bit_cast(s16x4, __builtin_amdgcn_ds_read_tr16_b64_v4i16((LAS s16x4*)(a0 + 16 * IX_SROW)));
                  const bf16x8 ca = (bf16x8){lo4[0], lo4[1], lo4[2], lo4[3], hi4[0], hi4[1], hi4[2], hi4[3]};
                  o[dt] = __builtin_amdgcn_mfma_f32_16x16x32_bf16(ca, pb, o[dt], 0, 0, 0); }
              LDS_WAIT(); asm volatile("" ::: "memory");
              }
              if (st + 1 < nsteps)
              {
#pragma unroll
              for (int i = 0; i < 8; ++i) *(LAS v4u*)(stg + (4 * i + g) * IX_SROW + c * 16) = rvB[i];
              if (st + 4 < nsteps) {
#pragma unroll
                  for (int i = 0; i < 8; ++i) { const int j = 32 * (st + 4) + 4 * i + g; const int key = (j < nsel) ? (int)SEL[q * IX_SELSTRIDE + j] : 0;
                      rvB[i] = *(const v4u*)(CKVN + (rowb + key) * 128 + c * 8); } }
              float sc[8];
              { const LAS unsigned short* sp = SEL + q * IX_SELSTRIDE + 32 * (st + 1) + 4 * g;
                f32x4 sa = f32x4{}, sb = f32x4{};
#pragma unroll
                for (int ks = 0; ks < 4; ++ks) { const bf16x8 ka = *(const LAS bf16x8*)(stg + c * IX_SROW + (32 * ks + 8 * g) * 2), kb2 = *(const LAS bf16x8*)(stg + (16 + c) * IX_SROW + (32 * ks + 8 * g) * 2);
                    sa = __builtin_amdgcn_mfma_f32_16x16x32_bf16(ka, ql[ks], sa, 0, 0, 0); sb = __builtin_amdgcn_mfma_f32_16x16x32_bf16(kb2, ql[ks], sb, 0, 0, 0); }
#pragma unroll
                for (int jj = 0; jj < 8; ++jj) { const int li = (jj < 4) ? jj : 12 + jj; const int j = 32 * (st + 1) + 4 * g + li;
                    const float raw = (jj < 4) ? sa[jj] : sb[jj - 4]; const float dist = (float)(tq - (int)sp[li]);
                    sc[jj] = (j < nsel) ? raw - slope2 * dist : -INFINITY; } }
              float smax = __builtin_fmaxf(__builtin_fmaxf(__builtin_fmaxf(sc[0], sc[1]), __builtin_fmaxf(sc[2], sc[3])), __builtin_fmaxf(__builtin_fmaxf(sc[4], sc[5]), __builtin_fmaxf(sc[6], sc[7])));
              { auto r16 = __builtin_amdgcn_permlane16_swap(__float_as_uint(smax), __float_as_uint(smax), false, false); smax = __builtin_fmaxf(__uint_as_float(r16[0]), __uint_as_float(r16[1]));
                auto r32_ = __builtin_amdgcn_permlane32_swap(__float_as_uint(smax), __float_as_uint(smax), false, false); smax = __builtin_fmaxf(__uint_as_float(r32_[0]), __uint_as_float(r32_[1])); }
              const float mnew = __builtin_fmaxf(mrun, smax); const float alpha = __builtin_amdgcn_exp2f(mrun - mnew); mrun = mnew;
              bf16x8 pb; float psum = 0.f;
              { float p[8];
#pragma unroll
                for (int jj = 0; jj < 8; ++jj) { p[jj] = __builtin_amdgcn_exp2f(sc[jj] - mnew); psum += p[jj]; }
                typedef float f32x2_t __attribute__((ext_vector_type(2))); typedef __bf16 bf16x2_t __attribute__((ext_vector_type(2)));
#pragma unroll
                for (int jj = 0; jj < 8; jj += 2) { const f32x2_t pv = {p[jj], p[jj + 1]}; const unsigned pk = __builtin_bit_cast(unsigned, __builtin_convertvector(pv, bf16x2_t)); pb[jj] = (short)(pk & 0xffffu); pb[jj + 1] = (short)(pk >> 16); } }
              lrun = lrun * alpha + psum;
              const bool resc = !__all(alpha == 1.0f);
#pragma unroll
              for (int dt = 0; dt < 8; ++dt) { if (resc) o[dt] = o[dt] * alpha;
                  const LAS unsigned char* a0 = stg + (4 * g + (c >> 2)) * IX_SROW + (16 * dt + 4 * (c & 3)) * 2;
                  const s16x4 lo4 = __builtin_bit_cast(s16x4, __builtin_amdgcn_ds_read_tr16_b64_v4i16((LAS s16x4*)a0));
                  const s16x4 hi4 = __builtin_bit_cast(s16x4, __builtin_amdgcn_ds_read_tr16_b64_v4i16((LAS s16x4*)(a0 + 16 * IX_SROW)));
                  const bf16x8 ca = (bf16x8){lo4[0], lo4[1], lo4[2], lo4[3], hi4[0], hi4[1], hi4[2], hi4[3]};
                  o[dt] = __builtin_amdgcn_mfma_f32_16x16x32_bf16(ca, pb, o[dt], 0, 0, 0); }
              LDS_WAIT(); asm volatile("" ::: "memory");
              }
              if (st + 2 < nsteps)
              {
#pragma unroll
              for (int i = 0; i < 8; ++i) *(LAS v4u*)(stg + (4 * i + g) * IX_SROW + c * 16) = rvC[i];
              if (st + 5 < nsteps) {
#pragma unroll
                  for (int i = 0; i < 8; ++i) { const int j = 32 * (st + 5) + 4 * i + g; const int key = (j < nsel) ? (int)SEL[q * IX_SELSTRIDE + j] : 0;
                      rvC[i] = *(const v4u*)(CKVN + (rowb + key) * 128 + c * 8); } }
              float sc[8];
              { const LAS unsigned short* sp = SEL + q * IX_SELSTRIDE + 32 * (st + 2) + 4 * g;
                f32x4 sa = f32x4{}, sb = f32x4{};
#pragma unroll
                for (int ks = 0; ks < 4; ++ks) { const bf16x8 ka = *(const LAS bf16x8*)(stg + c * IX_SROW + (32 * ks + 8 * g) * 2), kb2 = *(const LAS bf16x8*)(stg + (16 + c) * IX_SROW + (32 * ks + 8 * g) * 2);
                    sa = __builtin_amdgcn_mfma_f32_16x16x32_bf16(ka, ql[ks], sa, 0, 0, 0); sb = __builtin_amdgcn_mfma_f32_16x16x32_bf16(kb2, ql[ks], sb, 0, 0, 0); }
#pragma unroll
                for (int jj = 0; jj < 8; ++jj) { const int li = (jj < 4) ? jj : 12 + jj; const int j = 32 * (st + 2) + 4 * g + li;
                    const float raw = (jj < 4) ? sa[jj] : sb[jj - 4]; const float dist = (float)(tq - (int)sp[li]);
                    sc[jj] = (j < nsel) ? raw - slope2 * dist : -INFINITY; } }
              float smax = __builtin_fmaxf(__builtin_fmaxf(__builtin_fmaxf(sc[0], sc[1]), __builtin_fmaxf(sc[2], sc[3])), __builtin_fmaxf(__builtin_fmaxf(sc[4], sc[5]), __builtin_fmaxf(sc[6], sc[7])));
              { auto r16 = __builtin_amdgcn_permlane16_swap(__float_as_uint(smax), __float_as_uint(smax), false, false); smax = __builtin_fmaxf(__uint_as_float(r16[0]), __uint_as_float(r16[1]));
                auto r32_ = __builtin_amdgcn_permlane32_swap(__float_as_uint(smax), __float_as_uint(smax), false, false); smax = __builtin_fmaxf(__uint_as_float(r32_[0]), __uint_as_float(r32_[1])); }
              const float mnew = __builtin_fmaxf(mrun, smax); const float alpha = __builtin_amdgcn_exp2f(mrun - mnew); mrun = mnew;
              bf16x8 pb; float psum = 0.f;
              { float p[8];
#pragma unroll
                for (int jj = 0; jj < 8; ++jj) { p[jj] = __builtin_amdgcn_exp2f(sc[jj] - mnew); psum += p[jj]; }
                typedef float f32x2_t __attribute__((ext_vector_type(2))); typedef __bf16 bf16x2_t __attribute__((ext_vector_type(2)));
#pragma unroll
                for (int jj = 0; jj < 8; jj += 2) { const f32x2_t pv = {p[jj], p[jj + 1]}; const unsigned pk = __builtin_bit_cast(unsigned, __builtin_convertvector(pv, bf16x2_t)); pb[jj] = (short)(pk & 0xffffu); pb[jj + 1] = (short)(pk >> 16); } }
              lrun = lrun * alpha + psum;
              const bool resc = !__all(alpha == 1.0f);
#pragma unroll
              for (int dt = 0; dt < 8; ++dt) { if (resc) o[dt] = o[dt] * alpha;
                  const LAS unsigned char* a0 = stg + (4 * g + (c >> 2)) * IX_SROW + (16 * dt + 4 * (c & 3)) * 2;
                  const s16x4 lo4 = __builtin_bit_cast(s16x4, __builtin_amdgcn_ds_read_tr16_b64_v4i16((LAS s16x4*)a0));
                  const s16x4 hi4 = __builtin_bit_cast(s16x4, __builtin_amdgcn_ds_read_tr16_b64_v4i16((LAS s16x4*)(a0 + 16 * IX_SROW)));
                  const bf16x8 ca = (bf16x8){lo4[0], lo4[1], lo4[2], lo4[3], hi4[0], hi4[1], hi4[2], hi4[3]};
                  o[dt] = __builtin_amdgcn_mfma_f32_16x16x32_bf16(ca, pb, o[dt], 0, 0, 0); }
              LDS_WAIT(); asm volatile("" ::: "memory");
              }
          }
          { auto r16 = __builtin_amdgcn_permlane16_swap(__float_as_uint(lrun), __float_as_uint(lrun), false, false); lrun = __uint_as_float(r16[0]) + __uint_as_float(r16[1]);
            auto r32_ = __builtin_amdgcn_permlane32_swap(__float_as_uint(lrun), __float_as_uint(lrun), false, false); lrun = __uint_as_float(r32_[0]) + __uint_as_float(r32_[1]); }
          const float rl = 1.0f / lrun;
          if (c < 8) { LAS unsigned char* op = QLb + ((size_t)q * 1024 + c * 128 + 4 * g) * 2;
#pragma unroll
              for (int dt = 0; dt < 8; ++dt) { v2u wv; wv.x = pk2(o[dt][0] * rl, o[dt][1] * rl); wv.y = pk2(o[dt][2] * rl, o[dt][3] * rl); *(LAS v2u*)(op + 32 * dt) = wv; } }
      } }
    __syncthreads(); TS(7);
    if (do_att) {
#pragma unroll
      for (int dt = 0; dt < 2; ++dt) { f32x16 d = f32x16{}; const bf16* wp = WUVT + ((size_t)wave * 64 + 32 * dt + r32) * 128 + hi * 8;
#pragma unroll
          for (int ks = 0; ks < 8; ++ks) { const bf16x8 ob = *(const LAS bf16x8*)(QLb + ((size_t)r32 * 1024 + wave * 128 + 16 * ks + 8 * hi) * 2);
              d = __builtin_amdgcn_mfma_f32_32x32x16_bf16(*(const bf16x8*)(wp + 16 * ks), ob, d, 0, 0, 0); }
          bf16* op = OCAT + (rowb + q0 + r32) * KO0 + wave * 64 + 32 * dt + 4 * hi;
#pragma unroll
          for (int j = 0; j < 4; ++j) { v2u wv; wv.x = pk2(d[4 * j], d[4 * j + 1]); wv.y = pk2(d[4 * j + 2], d[4 * j + 3]); *(v2u*)(op + 8 * j) = wv; } } }
    __syncthreads(); TS(8);
#undef LOAD_QF
#undef TS
}
#define XB_TMO      128
#define XB_XCNT(j)  (256  + 64 * (j))
#define XB_XSUB(j)  (1280 + 64 * (j))
#define XB_XGEN(j)  (2304 + 64 * (j))
#define XB_TOP      3328
#define XB_TOPGEN   3392
#define XCD_BAR_WORDS 3456
#define XB_SPIN_CAP (1u << 18)

__device__ __forceinline__ unsigned xb_ld(unsigned* p)              { return __hip_atomic_load(p, __ATOMIC_RELAXED, __HIP_MEMORY_SCOPE_AGENT); }
__device__ __forceinline__ unsigned xb_add(unsigned* p, unsigned v) { return __hip_atomic_fetch_add(p, v, __ATOMIC_RELAXED, __HIP_MEMORY_SCOPE_AGENT); }
__device__ __forceinline__ unsigned xb_xcc_id() { return (unsigned)__builtin_amdgcn_s_getreg((3 << 11) | 20) & 0xFu; }
#define XB_SPIN(cond, bar) do { unsigned _sp = 0; while (cond) { __builtin_amdgcn_s_sleep(1); \
    if ((++_sp & 255u) == 0u) { if (xb_ld(&(bar)[XB_TMO])) break; if (_sp > XB_SPIN_CAP) { atomicAdd(&(bar)[XB_TMO], 1u); break; } } } } while (0)

struct XcdBarrier {
    unsigned* bar; unsigned x;
    volatile LAS unsigned* st;
};

__device__ __forceinline__ XcdBarrier xcd_barrier_post(unsigned* bar, volatile LAS unsigned* st) {
    XcdBarrier b; b.bar = bar; b.x = xb_xcc_id(); b.st = st;
    if (threadIdx.x == 0) (void)xb_add(&bar[XB_XCNT(b.x)], 1u);
    return b;
}
__device__ __forceinline__ void xcd_barrier_complete(unsigned* bar, unsigned x, unsigned& nloc, unsigned& nx) {
    const unsigned G = gridDim.x * gridDim.y * gridDim.z;
    unsigned sum, cnt, mine, sp = 0u;
    for (;;) {
        sum = 0u; cnt = 0u; mine = 0u;
#pragma unroll
        for (unsigned j = 0; j < 16; ++j) { const unsigned c = xb_ld(&bar[XB_XCNT(j)]); sum += c; cnt += (c > 0u) ? 1u : 0u; mine = (j == x) ? c : mine; }
        if (sum == G) break;
        __builtin_amdgcn_s_sleep(1);
        if ((++sp & 255u) == 0u) { if (xb_ld(&bar[XB_TMO])) break; if (sp > XB_SPIN_CAP) { atomicAdd(&bar[XB_TMO], 1u); break; } }
    }
    nloc = mine > 0u ? mine : 1u; nx = cnt > 0u ? cnt : 1u;
}

__device__ __forceinline__ void xcd_barrier(const XcdBarrier& b) {
    asm volatile("s_waitcnt vmcnt(0)" ::: "memory");
    __syncthreads();
    if (threadIdx.x == 0) {
        unsigned* bar = b.bar;
        __builtin_amdgcn_s_waitcnt(0);
        unsigned nloc = b.st[0], nx = b.st[1];
        if (nloc == 0u) { xcd_barrier_complete(bar, b.x, nloc, nx); b.st[0] = nloc; b.st[1] = nx; }
        const unsigned old = xb_add(&bar[XB_XSUB(b.x)], 1u);
        const unsigned gen = old / nloc;
        if (old + 1u == (gen + 1u) * nloc) {
            __builtin_amdgcn_fence(__ATOMIC_RELEASE, "agent");
            asm volatile("s_waitcnt vmcnt(0)" ::: "memory");
            const unsigned og = xb_add(&bar[XB_TOP], 1u);
            const unsigned tg = og / nx;
            if (og + 1u == (tg + 1u) * nx) xb_add(&bar[XB_TOPGEN], 1u);
            else XB_SPIN(xb_ld(&bar[XB_TOPGEN]) == tg, bar);
            __builtin_amdgcn_fence(__ATOMIC_ACQUIRE, "agent");
            xb_add(&bar[XB_XGEN(b.x)], 1u);
            asm volatile("s_waitcnt vmcnt(0)" ::: "memory");
        } else {
            XB_SPIN(xb_ld(&bar[XB_XGEN(b.x)]) == gen, bar);
            __builtin_amdgcn_fence(__ATOMIC_ACQUIRE, "agent");
            asm volatile("s_waitcnt vmcnt(0)" ::: "memory");
        }
    }
    __syncthreads();
}
namespace moba {
using bf16=__hip_bfloat16;
using bf16x8=__attribute__((ext_vector_type(8)))short;
using s16x4=__attribute__((ext_vector_type(4)))short;
using f32x16=__attribute__((ext_vector_type(16)))float;
using u32x4=__attribute__((ext_vector_type(4)))unsigned;
constexpr int SEQ=4096,D=64,PQ=3072,PO=1024;
constexpr int NW=8,QBLK=32,QB=QBLK*NW,KVBLK=64,NQB=SEQ/QB;
constexpr int ATTN_UNIT_ROWS=QB;
__device__ __forceinline__ int crow(int r,int hi){return (r&3)+8*(r>>2)+4*hi;}
#define SBAR() __builtin_amdgcn_sched_barrier(0)
__device__ __forceinline__ void cmask(f32x16&p0,f32x16&p1,int jb,int qrel,int hi){
  const float NEG=-INFINITY; int kb=64*jb+4*hi;
  #pragma unroll
  for(int r=0;r<16;++r){int kv=kb+(r&3)+8*(r>>2); if(kv>qrel)p0[r]=NEG; if(kv+32>qrel)p1[r]=NEG;}
}

constexpr int NSLOT=3, SLOTB=8192;
constexpr int LDS_K=0, LDS_V=NSLOT*SLOTB, LDS_WS=2*NSLOT*SLOTB, LDS_OST=LDS_WS+NW*64*4, LDS_BYTES=LDS_OST+NW*4096;
constexpr float C2=0.125f*1.4426950408889634f;
__device__ __forceinline__ void glds16(const void*gsrc,unsigned lds_dst){unsigned keep;
  asm volatile("s_mov_b32 %0, m0\n\ts_mov_b32 m0, %2\n\ts_nop 0\n\tglobal_load_lds_dwordx4 %1, off\n\ts_mov_b32 m0, %0":"=&s"(keep):"v"(gsrc),"s"(lds_dst):"memory");}
__device__ __forceinline__ float max3f(float a,float b,float c){float r;asm("v_max3_f32 %0, %1, %2, %3":"=v"(r):"v"(a),"v"(b),"v"(c));return r;}
__device__ __forceinline__ float max2f(float a,float b){float r;asm("v_max_f32_e32 %0, %1, %2":"=v"(r):"v"(a),"v"(b));return r;}
__device__ __forceinline__ float fadd_s(float a,float b){float r;asm("v_add_f32_e32 %0, %1, %2":"=v"(r):"v"(a),"v"(b));return r;}
__device__ __forceinline__ float fsub_s(float a,float b){float r;asm("v_sub_f32_e32 %0, %1, %2":"=v"(r):"v"(a),"v"(b));return r;}
typedef float f32x2_t __attribute__((ext_vector_type(2))); typedef __bf16 bf16x2_t __attribute__((ext_vector_type(2)));
__device__ __forceinline__ unsigned cvtpk_s(float lo,float hi){f32x2_t v={lo,hi};bf16x2_t b=__builtin_convertvector(v,bf16x2_t);return __builtin_bit_cast(unsigned,b);}
#define WAIT_BAR(N) asm volatile("s_waitcnt vmcnt(" #N ") lgkmcnt(0)\n\ts_barrier":::"memory")

__device__ __forceinline__ void qkt(f32x16&p0,f32x16&p1,const char*Kslot,const bf16x8*qr,int r32,int hi){ const f32x16 negm=f32x16{};
  const char*kb=Kslot+hi*1024+r32*16;
  #pragma unroll
  for(int d0=0;d0<4;++d0){
    const bf16x8 b0=*reinterpret_cast<const bf16x8*>(kb+d0*2048);
    const bf16x8 b1=*reinterpret_cast<const bf16x8*>(kb+d0*2048+512);
    if(d0==0){p0=__builtin_amdgcn_mfma_f32_32x32x16_bf16(b0,qr[0],negm,0,0,0);p1=__builtin_amdgcn_mfma_f32_32x32x16_bf16(b1,qr[0],negm,0,0,0);}
    else{p0=__builtin_amdgcn_mfma_f32_32x32x16_bf16(b0,qr[d0],p0,0,0,0);p1=__builtin_amdgcn_mfma_f32_32x32x16_bf16(b1,qr[d0],p1,0,0,0);}}
}
typedef __attribute__((address_space(3))) const char* lds_cptr;
typedef short v4i16_t __attribute__((ext_vector_type(4)));
__device__ __forceinline__ void kload8(bf16x8*kf,lds_cptr kp){
  kf[0]=*(const __attribute__((address_space(3))) bf16x8*)(kp);      kf[1]=*(const __attribute__((address_space(3))) bf16x8*)(kp+512);
  kf[2]=*(const __attribute__((address_space(3))) bf16x8*)(kp+2048); kf[3]=*(const __attribute__((address_space(3))) bf16x8*)(kp+2560);
  kf[4]=*(const __attribute__((address_space(3))) bf16x8*)(kp+4096); kf[5]=*(const __attribute__((address_space(3))) bf16x8*)(kp+4608);
  kf[6]=*(const __attribute__((address_space(3))) bf16x8*)(kp+6144); kf[7]=*(const __attribute__((address_space(3))) bf16x8*)(kp+6656);
}
__device__ __forceinline__ void kload2(bf16x8*kf,lds_cptr kp,int j){ kf[2*j]=*(const __attribute__((address_space(3))) bf16x8*)(kp+j*2048); kf[2*j+1]=*(const __attribute__((address_space(3))) bf16x8*)(kp+j*2048+512); }
__device__ __forceinline__ s16x4 vtr(lds_cptr p){ return __builtin_bit_cast(s16x4,__builtin_amdgcn_ds_read_tr16_b64_v4i16((__attribute__((address_space(3))) v4i16_t*)p)); }
__device__ __forceinline__ float rowmax(const f32x16&p0,const f32x16&p1){
  float a=max3f(p0[0],p0[1],p1[0]),b=max3f(p0[2],p0[3],p1[1]);a=max3f(a,p1[2],p1[3]);
  #pragma unroll
  for(int r=4;r<16;r+=4){a=max3f(a,p0[r],p0[r+1]);b=max3f(b,p0[r+2],p0[r+3]);a=max3f(a,p1[r],p1[r+1]);b=max3f(b,p1[r+2],p1[r+3]);}
  const float m=max2f(a,b);
  auto rr=__builtin_amdgcn_permlane32_swap(__float_as_uint(m),__float_as_uint(m),false,false);
  return max2f(__uint_as_float(rr[0]),__uint_as_float(rr[1]));
}
__device__ __forceinline__ void pv(f32x16*o,int vb,bf16x8 pa0,bf16x8 pa1,bf16x8 pa2,bf16x8 pa3){
  #pragma unroll
  for(int d0=0;d0<2;++d0){s16x4 lo[4],hi[4];
    #pragma unroll
    for(int ks=0;ks<4;++ks){
      asm volatile("ds_read_b64_tr_b16 %0,%1 offset:%c2":"=&v"(lo[ks]):"v"(vb),"i"(d0*4096+ks*1024):"memory");
      asm volatile("ds_read_b64_tr_b16 %0,%1 offset:%c2":"=&v"(hi[ks]):"v"(vb),"i"(d0*4096+ks*1024+512):"memory");}
    asm volatile("s_waitcnt lgkmcnt(0)":::"memory");SBAR();
    #define PK(k) (bf16x8){lo[k][0],lo[k][1],lo[k][2],lo[k][3],hi[k][0],hi[k][1],hi[k][2],hi[k][3]}
    o[d0]=__builtin_amdgcn_mfma_f32_32x32x16_bf16(pa0,PK(0),o[d0],0,0,0);
    o[d0]=__builtin_amdgcn_mfma_f32_32x32x16_bf16(pa1,PK(1),o[d0],0,0,0);
    o[d0]=__builtin_amdgcn_mfma_f32_32x32x16_bf16(pa2,PK(2),o[d0],0,0,0);
    o[d0]=__builtin_amdgcn_mfma_f32_32x32x16_bf16(pa3,PK(3),o[d0],0,0,0);
    #undef PK
  }
}

#ifndef ATTN_STORE16
#define ATTN_STORE16(p,v) (*(u32x4*)(p)=(v))
#endif
template<int THRL,bool WITH_BIAS=true> __device__ __forceinline__ void attn_unit(int b,int h,int qb,const bf16*Q,const bf16*__restrict__ K,const bf16*__restrict__ V,bf16*O,const unsigned short*__restrict__ ALLOW,const float*__restrict__ KN2,const float sig2,char*shm){
  int tid_l=threadIdx.x; asm volatile("":"+v"(tid_l)); const int tid=tid_l,lane=tid&63,r32=lane&31,hi=lane>>5; const int wid=__builtin_amdgcn_readfirstlane(tid>>6);
  const long rowbase=(long)b*SEQ; const int q0=qb*QB;
  const bf16*Qw=Q+(rowbase+q0+wid*QBLK)*PQ+h*D;
  const bf16*Kh=K+rowbase*PQ+h*D,*Vh=V+rowbase*PQ+h*D;
  const unsigned lds0=(unsigned)(uintptr_t)shm;
  float*wsf=(float*)(shm+LDS_WS)+wid*64;
  const int NT0=(q0+QB)/KVBLK;
  bf16x8 qr[4];
  #pragma unroll
  for(int d0=0;d0<4;++d0)qr[d0]=*reinterpret_cast<const bf16x8*>(&Qw[(long)r32*PQ+d0*16+hi*8]);
  float mhat=0.f,l_reg=0.f;f32x16 o[2];o[0]=f32x16{};o[1]=f32x16{};
  const int qrel=wid*QBLK+r32; const int qpos=q0+qrel;
  const unsigned allow=ALLOW[(rowbase+qpos)*16+h];
  float qn2=0.f;
  {
    float ss=0.f;
    _Pragma("unroll") for(int d0=0;d0<4;++d0){ const bf16x8 kk=*reinterpret_cast<const bf16x8*>(&Kh[(long)qpos*PQ+d0*16+hi*8]);
      _Pragma("unroll") for(int j=0;j<8;++j){ const float qv=__uint_as_float(((unsigned)(unsigned short)qr[d0][j])<<16); ss+=qv*__uint_as_float(((unsigned)(unsigned short)kk[j])<<16); qn2+=qv*qv; } }
    ss+=__shfl_xor(ss,32); qn2+=__shfl_xor(qn2,32); mhat=ss; }
  int t0=0;
  { float qm=qn2, mm=mhat;
    _Pragma("unroll") for(int off=1;off<32;off<<=1){ qm=__builtin_fmaxf(qm,__shfl_xor(qm,off)); mm=__builtin_fminf(mm,__shfl_xor(mm,off)); }
    float*exch=(float*)(shm+LDS_OST);
    if(lane==0){ exch[2*wid]=qm; exch[2*wid+1]=mm; }
    __syncthreads();
    float Qn2=exch[0], Mmin=exch[1];
    _Pragma("unroll") for(int w=1;w<NW;++w){ Qn2=__builtin_fmaxf(Qn2,exch[2*w]); Mmin=__builtin_fminf(Mmin,exch[2*w+1]); }
    const float kn=KN2[lane];
    const float bound=sqrtf(Qn2*kn)-sig2*(float)(q0-(64*lane+63))-Mmin;
    const unsigned long long nosk=__ballot(!(bound<-40.f)||lane>=NT0-4);
    t0=nosk?(int)__builtin_ctzll(nosk):0; t0&=~1; if(t0>NT0-4)t0=NT0-4; }
  const int NT=NT0-t0;
  const bf16*ksrc=Kh+(long)(lane+t0*KVBLK)*PQ+wid*8;
  const bf16*vsrc=Vh+(long)(16*(wid&3)+(lane>>2)+t0*KVBLK)*PQ+(wid>>2)*32+(lane&3)*8;
  const unsigned kdst=lds0+LDS_K+wid*1024, vdst=lds0+LDS_V+wid*1024;
  #define DMA_K(t,slot) glds16(ksrc+(long)(t)*KVBLK*PQ,(unsigned)__builtin_amdgcn_readfirstlane(kdst+(slot)))
  #define DMA_V(t,slot) glds16(vsrc+(long)(t)*KVBLK*PQ,(unsigned)__builtin_amdgcn_readfirstlane(vdst+(slot)))
  const int vb0=(int)(lds0+LDS_V)+((lane>>4)&1)*32+(lane&3)*8+(4*hi+((lane&15)>>2))*64;
  const char*Kbase=shm+LDS_K; bf16x8 kf[8];
  const lds_cptr shm3=(lds_cptr)shm; const lds_cptr kp0=shm3+LDS_K+hi*1024+r32*16; const lds_cptr vp0=shm3+LDS_V+((lane>>4)&1)*32+(lane&3)*8+(4*hi+((lane&15)>>2))*64;
  DMA_K(0,0);DMA_V(0,0);DMA_K(1,SLOTB);
  const f32x16 negm=f32x16{};
  bf16x8 kx0=bf16x8{}, kx1=bf16x8{};
  if(hi==0){ const short one=(short)0x3F80; const short k0_=(short)(cvtpk_s((float)r32,0.f)&0xffffu), k1_=(short)(cvtpk_s((float)(32+r32),0.f)&0xffffu);
    kx0[0]=one;kx0[1]=one;kx0[2]=one;kx0[3]=k0_;kx0[4]=k0_; kx1[0]=one;kx1[1]=one;kx1[2]=one;kx1[3]=k1_;kx1[4]=k1_; }
  const unsigned sgh_=cvtpk_s(sig2,0.f)&0xffffu, sgl_=cvtpk_s(sig2-__uint_as_float(sgh_<<16),0.f)&0xffffu;
  const float bq=sig2*(float)(-qpos);
  #define BIASM(P0,P1,t) do{ if(!WITH_BIAS)break; const bool al_=((allow>>(((t)+t0)>>2))&1u)!=0u; const float s0_=(bq-mhat)+sig2*(float)(64*((t)+t0)); \
    unsigned h1_=cvtpk_s(s0_,0.f)&0xffffu; const float r1_=s0_-__uint_as_float(h1_<<16); unsigned h2_=cvtpk_s(r1_,0.f)&0xffffu; const float r2_=r1_-__uint_as_float(h2_<<16); unsigned h3_=cvtpk_s(r2_,0.f)&0xffffu; \
    if(!al_){h1_=0xff80u;h2_=0u;h3_=0u;} \
    u32x4 qw_; qw_[0]=hi?0u:(h1_|(h2_<<16)); qw_[1]=hi?0u:(h3_|(sgh_<<16)); qw_[2]=hi?0u:sgl_; qw_[3]=0u; const bf16x8 qx_=__builtin_bit_cast(bf16x8,qw_); \
    P0=__builtin_amdgcn_mfma_f32_32x32x16_bf16(kx0,qx_,P0,0,0,0); P1=__builtin_amdgcn_mfma_f32_32x32x16_bf16(kx1,qx_,P1,0,0,0); }while(0)
  #define CMASK(P0,P1,t) do{int jb_=(t)-(NT-4); if(jb_>=0)cmask(P0,P1,jb_,qrel,hi);}while(0)
  bool resc=false;
  #define MXF3(a,b,c) __builtin_fmaxf(__builtin_fmaxf((a),(b)),(c))
  #define DECIDE(C0,C1) do{ float a=MXF3(C0[0],C0[1],C1[0]),b=MXF3(C0[2],C0[3],C1[1]); a=MXF3(a,C1[2],C1[3]);     \
      _Pragma("unroll") for(int r=4;r<16;r+=4){a=MXF3(a,C0[r],C0[r+1]);b=MXF3(b,C0[r+2],C0[r+3]);a=MXF3(a,C1[r],C1[r+1]);b=MXF3(b,C1[r+2],C1[r+3]);} \
      float rm=__builtin_fmaxf(a,b); { auto rr=__builtin_amdgcn_permlane32_swap(__float_as_uint(rm),__float_as_uint(rm),false,false); rm=__builtin_fmaxf(__uint_as_float(rr[0]),__uint_as_float(rr[1])); } \
      resc=false; \
      if(__builtin_expect(__any(rm>(float)THRL),0)){ const float dl=__builtin_fmaxf(rm,0.f); mhat+=dl; \
        _Pragma("unroll") for(int r=0;r<16;++r){C0[r]-=dl;C1[r]-=dl;} \
        const float f=__builtin_amdgcn_exp2f(-dl); l_reg*=f; if(hi==0)wsf[r32]=f; resc=true; } }while(0)
  #define RESC() do{ if(resc){ asm volatile("s_waitcnt lgkmcnt(0)":::"memory"); \
      _Pragma("unroll") for(int d_=0;d_<2;++d_) _Pragma("unroll") for(int r=0;r<16;++r)o[d_][r]*=wsf[crow(r,hi)]; } }while(0)
  f32x16 pA0,pA1,pB0,pB1;
  int sl_prev=0,sl_cur=0,sl_next=SLOTB;
  #define ROT() do{sl_prev=sl_cur;sl_cur=sl_next;sl_next=(sl_next==(NSLOT-1)*SLOTB)?0:sl_next+SLOTB;}while(0)
  DMA_K(2,2*SLOTB);
  WAIT_BAR(3);
  qkt(pA0,pA1,Kbase,qr,r32,hi);asm volatile("s_nop 15\n\ts_nop 7":"+v"(pA0),"+v"(pA1));BIASM(pA0,pA1,0);CMASK(pA0,pA1,0);
  DECIDE(pA0,pA1); resc=false;
  _Pragma("unroll") for(int r=0;r<16;++r){pA0[r]=__builtin_amdgcn_exp2f(pA0[r]);pA1[r]=__builtin_amdgcn_exp2f(pA1[r]);}
  WAIT_BAR(0);
  DMA_K(3,0);DMA_V(1,SLOTB);
  ROT();
  kload8(kf,kp0+sl_cur);
  WAIT_BAR(2);
  s16x4 vlo[8],vhi[8]; u32x4 pw0,pw1,pw2,pw3;
  #define PKW(P,B) cvtpk_s(P[B],P[B+1])
  #define PAF(k) __builtin_bit_cast(bf16x8,pw##k)
  #define VFR(i) (bf16x8){vlo[i][0],vlo[i][1],vlo[i][2],vlo[i][3],vhi[i][0],vhi[i][1],vhi[i][2],vhi[i][3]}
  #define PIN(x) asm volatile("":"+v"(x))
  #define MX3(a,b,c) __builtin_fmaxf(__builtin_fmaxf((a),(b)),(c))
  #define GAPA(MF,A0,A1,A2,A3,W0,W1,PW) do{ MF; sacc+=A0; sacc+=A1; sacc+=A2; sacc+=A3; PIN(sacc); W0; W1; PIN(PW); SBAR(); }while(0)
  #define EX(v) __builtin_amdgcn_exp2f(v)
  #define GAPB(MF,X,B) do{ MF; X[B]=EX(X[B]); X[B+1]=EX(X[B+1]); X[B+2]=EX(X[B+2]); X[B+3]=EX(X[B+3]); PIN(X); SBAR(); }while(0)
  #define VRD(i) do{ vlo[i]=vtr(vp_+(((i)>>2)*4096+((i)&3)*1024)); vhi[i]=vtr(vp_+(((i)>>2)*4096+((i)&3)*1024+512)); }while(0)
  #define KRD(G,j) do{ if(G){ kload2(kf,kp0+sl_next,j); SBAR(); } }while(0)
  #define STEP(C0,C1,P0,P1,t,GK,GV,GL) do{ SBAR(); \
    const lds_cptr vp_=vp0+sl_prev; \
    VRD(0); SBAR(); float sacc=(P0[0]+P0[1]); \
    GAPA(C0=__builtin_amdgcn_mfma_f32_32x32x16_bf16(kf[0],qr[0],negm,0,0,0), P0[2],P0[3],P0[4],P0[5],     pw0[0]=PKW(P0,0), pw0[1]=PKW(P0,2), pw0); \
    VRD(4); SBAR(); GAPA(C1=__builtin_amdgcn_mfma_f32_32x32x16_bf16(kf[1],qr[0],negm,0,0,0), P0[6],P0[7],P0[8],P0[9],     pw0[2]=PKW(P0,4), pw0[3]=PKW(P0,6), pw0); \
    VRD(1); SBAR(); GAPA(C0=__builtin_amdgcn_mfma_f32_32x32x16_bf16(kf[2],qr[1],C0,0,0,0),   P0[10],P0[11],P0[12],P0[13], pw1[0]=PKW(P0,8), pw1[1]=PKW(P0,10), pw1); \
    VRD(5); SBAR(); GAPA(C1=__builtin_amdgcn_mfma_f32_32x32x16_bf16(kf[3],qr[1],C1,0,0,0),   P0[14],P0[15],P1[0],P1[1],   pw1[2]=PKW(P0,12),pw1[3]=PKW(P0,14), pw1); \
    VRD(2); SBAR(); GAPA(C0=__builtin_amdgcn_mfma_f32_32x32x16_bf16(kf[4],qr[2],C0,0,0,0),   P1[2],P1[3],P1[4],P1[5],     pw2[0]=PKW(P1,0), pw2[1]=PKW(P1,2), pw2); \
    VRD(6); SBAR(); GAPA(C1=__builtin_amdgcn_mfma_f32_32x32x16_bf16(kf[5],qr[2],C1,0,0,0),   P1[6],P1[7],P1[8],P1[9],     pw2[2]=PKW(P1,4), pw2[3]=PKW(P1,6), pw2); \
    VRD(3); SBAR(); GAPA(C0=__builtin_amdgcn_mfma_f32_32x32x16_bf16(kf[6],qr[3],C0,0,0,0),   P1[10],P1[11],P1[12],P1[13], pw3[0]=PKW(P1,8), pw3[1]=PKW(P1,10), pw3); \
    VRD(7); SBAR(); GAPA(C1=__builtin_amdgcn_mfma_f32_32x32x16_bf16(kf[7],qr[3],C1,0,0,0),   P1[14],P1[15],0.f,0.f,       pw3[2]=PKW(P1,12),pw3[3]=PKW(P1,14), pw3); \
    l_reg+=sacc; \
    if(GK){DMA_K((t)+3,sl_cur);} if(GV){DMA_V((t)+1,sl_next);} \
    BIASM(C0,C1,t); CMASK(C0,C1,t); \
    DECIDE(C0,C1); \
    SBAR(); \
    GAPB(o[0]=__builtin_amdgcn_mfma_f32_32x32x16_bf16(PAF(0),VFR(0),o[0],0,0,0), C0,0); \
    GAPB(o[1]=__builtin_amdgcn_mfma_f32_32x32x16_bf16(PAF(0),VFR(4),o[1],0,0,0), C0,4); \
    KRD(GL,0); GAPB(o[0]=__builtin_amdgcn_mfma_f32_32x32x16_bf16(PAF(1),VFR(1),o[0],0,0,0), C0,8); \
    KRD(GL,1); GAPB(o[1]=__builtin_amdgcn_mfma_f32_32x32x16_bf16(PAF(1),VFR(5),o[1],0,0,0), C0,12); \
    KRD(GL,2); GAPB(o[0]=__builtin_amdgcn_mfma_f32_32x32x16_bf16(PAF(2),VFR(2),o[0],0,0,0), C1,0); \
    KRD(GL,3); GAPB(o[1]=__builtin_amdgcn_mfma_f32_32x32x16_bf16(PAF(2),VFR(6),o[1],0,0,0), C1,4); \
    GAPB(o[0]=__builtin_amdgcn_mfma_f32_32x32x16_bf16(PAF(3),VFR(3),o[0],0,0,0), C1,8); \
    GAPB(o[1]=__builtin_amdgcn_mfma_f32_32x32x16_bf16(PAF(3),VFR(7),o[1],0,0,0), C1,12); \
    }while(0)
  int t=1;
  #undef CMASK
  #define CMASK(P0,P1,t) do{}while(0)
  for(;t+5<NT;t+=2){
    STEP(pB0,pB1,pA0,pA1,t,true,true,true);     WAIT_BAR(2); RESC(); ROT();
    STEP(pA0,pA1,pB0,pB1,t+1,true,true,true);   WAIT_BAR(2); RESC(); ROT();
  }
  #undef CMASK
  #define CMASK(P0,P1,t) do{int jb_=(t)-(NT-4); if(jb_>=0)cmask(P0,P1,jb_,qrel,hi);}while(0)
  #define ENDW(tt) do{ if((tt)+3<NT){WAIT_BAR(2);} else if((tt)+2<NT){WAIT_BAR(1);} else {WAIT_BAR(0);} }while(0)
  for(;t+1<NT;t+=2){
    STEP(pB0,pB1,pA0,pA1,t,(t+3<NT),(t+1<NT),(t+1<NT));       ENDW(t);   RESC(); ROT();
    STEP(pA0,pA1,pB0,pB1,t+1,(t+4<NT),(t+2<NT),(t+2<NT));     ENDW(t+1); RESC(); ROT();
  }
  STEP(pB0,pB1,pA0,pA1,NT-1,false,false,false); RESC();
  { float sacc=pB0[0]+pB0[1]; _Pragma("unroll") for(int r=2;r<16;++r)sacc+=pB0[r]; _Pragma("unroll") for(int r=0;r<16;++r)sacc+=pB1[r]; l_reg+=sacc;
    pw0=(u32x4){PKW(pB0,0),PKW(pB0,2),PKW(pB0,4),PKW(pB0,6)};pw1=(u32x4){PKW(pB0,8),PKW(pB0,10),PKW(pB0,12),PKW(pB0,14)};pw2=(u32x4){PKW(pB1,0),PKW(pB1,2),PKW(pB1,4),PKW(pB1,6)};pw3=(u32x4){PKW(pB1,8),PKW(pB1,10),PKW(pB1,12),PKW(pB1,14)};
    SBAR(); pv(o,vb0+sl_cur,PAF(0),PAF(1),PAF(2),PAF(3)); }
  #undef PKW
  #undef PAF
  #undef VFR
  #undef PIN
  #undef MX3
  #undef GAPA
  #undef GAPB
  #undef EX
  #undef VRD
  #undef KRD
  #undef STEP
  #undef ENDW
  {auto rr=__builtin_amdgcn_permlane32_swap(__float_as_uint(l_reg),__float_as_uint(l_reg),false,false);l_reg=__uint_as_float(rr[0])+__uint_as_float(rr[1]);}
  if(hi==0)wsf[32+r32]=l_reg;asm volatile("s_waitcnt lgkmcnt(0)":::"memory");
  float rli[16];
  #pragma unroll
  for(int r=0;r<16;++r)rli[r]=__builtin_amdgcn_rcpf(wsf[32+crow(r,hi)]);
  bf16*Ow=O+(rowbase+q0+wid*QBLK)*PO+h*D;
  { bf16*stg=(bf16*)(shm+LDS_OST)+wid*2048;
    #pragma unroll
    for(int r=0;r<16;++r){const int orow=crow(r,hi);
      #pragma unroll
      for(int d0=0;d0<2;++d0)stg[orow*64+d0*32+r32]=__float2bfloat16(o[d0][r]*rli[r]);}
    asm volatile("s_waitcnt lgkmcnt(0)":::"memory");
    #pragma unroll
    for(int i=0;i<4;++i){const int row=i*8+(lane>>3),ch=lane&7; const u32x4 v=*(const u32x4*)(stg+row*64+ch*8); ATTN_STORE16(Ow+(long)row*PO+ch*8,v);} }
  asm volatile("s_waitcnt lgkmcnt(0)\n\ts_barrier":::"memory");
  #undef DMA_K
  #undef DMA_V
  #undef CMASK
  #undef DECIDE
  #undef MXF3
  #undef BIASM
  #undef RESC
  #undef ROT
}
constexpr int ATTN_LDS_BYTES=LDS_BYTES;
#undef SBAR
#undef WAIT_BAR
}
struct Args { const float* in[15]; float* out; unsigned char* ws; int ph_lo, ph_hi; };
enum { I_X = 0, I_EWIN, I_EKVN, I_EWUK, I_EWUV, I_EWOUT, I_OWIN, I_OWOUT, I_LNMG, I_LNMB, I_FG, I_FU, I_FD, I_LNFG, I_LNFB };
constexpr int NPHASE = 18;

__global__ void __launch_bounds__(NTHR, 2) mega_fwd(Args args) {
    extern __shared__ __attribute__((aligned(16))) unsigned char lds_raw[];
    LAS unsigned char* lds = (LAS unsigned char*)lds_raw;
    cg::grid_group grid = cg::this_grid();
    volatile LAS unsigned* MISC = (volatile LAS unsigned*)(lds + LDS_BYTES - 64);
    if (threadIdx.x < 16) ((LAS unsigned*)(lds + LDS_BYTES - 64))[threadIdx.x] = 0u;
    __syncthreads();
    const int G = gridDim.x; const int bx = blockIdx.x; const int vcu = (G % 8 == 0) ? (bx % 8) * (G / 8) + bx / 8 : bx;
    const int NGW = G * NWAVES;
#ifndef DUP_MASK
#define DUP_MASK 0
#endif
#ifdef DOUBLE_BARRIER
#define SEAM_EXTRA xcd_barrier(bar);
#else
#define SEAM_EXTRA
#endif
#define REP(k) for (int rep_ = 0; rep_ <= ((DUP_MASK >> (k)) & 1); ++rep_)
#define PHASE_IDS() int tid = threadIdx.x; asm volatile("" : "+v"(tid)); const int lane = tid & 63, wave = __builtin_amdgcn_readfirstlane(tid >> 6), gw = vcu * NWAVES + wave; (void)gw; (void)lane; \
    size_t zoff_ = 0; asm volatile("" : "+s"(zoff_)); unsigned char* ws = args.ws + zoff_;     \
    bf16* const W0IN = (bf16*)(ws + WS_W0IN); bf16* const W0OUT = (bf16*)(ws + WS_W0OUT); bf16* const WGU0 = (bf16*)(ws + WS_WGU0); bf16* const WGU1 = (bf16*)(ws + WS_WGU1); \
    bf16* const WDN0 = (bf16*)(ws + WS_WDN0); bf16* const WDN1 = (bf16*)(ws + WS_WDN1); bf16* const W1IN = (bf16*)(ws + WS_W1IN); bf16* const W1OUT = (bf16*)(ws + WS_W1OUT); \
    float* const KMEAN = (float*)(ws + WS_KMEAN); unsigned short* const ALLOW = (unsigned short*)(ws + WS_ALLOW); bf16* const CKVN = (bf16*)(ws + WS_CKVN); \
    bf16* const X = (bf16*)(ws + WS_X); bf16* const R1 = (bf16*)(ws + WS_R1); bf16* const OCAT = (bf16*)(ws + WS_OCAT); \
    (void)W0IN; (void)W0OUT; (void)WGU0; (void)WGU1; (void)WDN0; (void)WDN1; (void)W1IN; (void)W1OUT; (void)KMEAN; (void)ALLOW; (void)CKVN; (void)X; (void)R1; (void)OCAT;
    const int lo = args.ph_lo, hi = args.ph_hi;
#ifdef ONLY_PHASE
#define IN(k) ((k) == ONLY_PHASE && lo <= (k) && (k) < hi)
#else
#define IN(k) (lo <= (k) && (k) < hi)
#endif
    XcdBarrier bar; bar.bar = (unsigned*)args.ws + 4096; bar.x = 0; bar.st = nullptr;
    if (hi - lo > 1) bar = xcd_barrier_post((unsigned*)args.ws + 4096, MISC);
#define SEAM(k) do { if (IN(k) && IN((k) + 1)) { if ((k) == 0) grid.sync(); else { xcd_barrier(bar); SEAM_EXTRA } } } while (0)

    if (IN(0)) REP(0) { PHASE_IDS();
        LAS float* scr = (LAS float*)(lds + wave * 16384);
        int rot = 0;
        const float* ewin = args.in[I_EWIN];
        tr_job(ewin, 2500, 1024, 0, 512, 512, W0IN, 1024, C_QA, 0, C2, 0, scr, lane, gw, NGW, rot);
        tr_job(ewin, 2500, 1024, 512, 128, 128, W0IN, 1024, C_CKV, 0, 1.f, 0, scr, lane, gw, NGW, rot);
        tr_job(ewin, 2500, 1024, 640, 256, 256, W0IN, 1024, C_QIDX, 0, 1.f, 0, scr, lane, gw, NGW, rot);
        tr_job(ewin, 2500, 1024, 896, 64, 64, W0IN, 1024, C_KIDX, 0, 1.f, 0, scr, lane, gw, NGW, rot);
        tr_job(ewin, 2500, 1024, 964, 512, 512, W0IN, 1024, C_QB, 0, C2, 0, scr, lane, gw, NGW, rot);
        tr_job(ewin, 2500, 1024, 1476, 512, 512, W0IN, 1024, C_KB, 0, 1.f, 0, scr, lane, gw, NGW, rot);
        tr_job(ewin, 2500, 1024, 1988, 512, 512, W0IN, 1024, C_VB, 0, 1.f, 0, scr, lane, gw, NGW, rot);
        tr_job(ewin, 2500, 1024, 960, 64, 4, W0IN, 1024, C_WIDX, 0, 1.f, 0, scr, lane, gw, NGW, rot);
        tr_job(args.in[I_EWOUT], 1024, 1024, 0, 1024, 1024, W0OUT, KO0, 0, 0, 1.f, 0, scr, lane, gw, NGW, rot);
        { bf16* WUKT = (bf16*)(ws + WS_WUKT); bf16* WUVT = (bf16*)(ws + WS_WUVT); const float* wuk = args.in[I_EWUK]; const float* wuv = args.in[I_EWUV];
          for (int e = bx * NTHR + tid; e < 8 * 128 * 64; e += G * NTHR) { const int h = e >> 13, r = (e >> 6) & 127, d = e & 63;
              WUKT[e] = (bf16)f2bf(wuk[(h * 64 + d) * 128 + r]); WUVT[(h * 64 + d) * 128 + r] = (bf16)f2bf(wuv[(h * 128 + r) * 64 + d]); } }
        for (int l = 0; l < 2; ++l) {
            tr_job(args.in[I_FG] + (size_t)l * 1024 * DFF, DFF, 1024, 0, DFF, DFF, l ? WGU1 : WGU0, 1024, 0, 0, 1.f, 1, scr, lane, gw, NGW, rot);
            tr_job(args.in[I_FU] + (size_t)l * 1024 * DFF, DFF, 1024, 0, DFF, DFF, l ? WGU1 : WGU0, 1024, 0, 0, 1.f, 2, scr, lane, gw, NGW, rot);
            tr_job(args.in[I_FD] + (size_t)l * DFF * 1024, 1024, DFF, 0, 1024, 1024, l ? WDN1 : WDN0, DFF, 0, 0, 1.f, 0, scr, lane, gw, NGW, rot);
        }
        tr_job(args.in[I_OWIN], 3072, 1024, 0, 1024, 1024, W1IN, 1024, 0, 0, C2, 0, scr, lane, gw, NGW, rot);
        tr_job(args.in[I_OWIN], 3072, 1024, 1024, 2048, 2048, W1IN, 1024, 1024, 0, 1.f, 0, scr, lane, gw, NGW, rot);
        tr_job(args.in[I_OWOUT], 1024, 1024, 0, 1024, 1024, W1OUT, 1024, 0, 0, 1.f, 0, scr, lane, gw, NGW, rot);
        { const float* x = args.in[I_X]; const size_t nchunk = (size_t)M * DM / 8;
          for (size_t i = (size_t)bx * NTHR + tid; i < nchunk; i += (size_t)G * NTHR) { const f32x4 a = __builtin_nontemporal_load((const f32x4*)(x + 8 * i)), b = __builtin_nontemporal_load((const f32x4*)(x + 8 * i + 4));
              v4u o; o.x = pk2(a[0], a[1]); o.y = pk2(a[2], a[3]); o.z = pk2(b[0], b[1]); o.w = pk2(b[2], b[3]); *(v4u*)(X + 8 * i) = o; } }
    }
    SEAM(0);
    if (IN(1)) REP(1) { PHASE_IDS(); pg8::Gemm g{X, W0IN, M, NQ0, DM}; pg8::StaticOrder S; S.init(M, NQ0, G, bx); pg8::EpiBf16<0> E{R1, NQ0, nullptr, 0, 0, 1.f};
        pg8::gemm_phase<pg8::EpiBf16<0>, pg8::StaticOrder, true, true>(lds, g, S, E); }
    SEAM(1);
    if (IN(2)) REP(2) { PHASE_IDS();
        const float* kvn = args.in[I_EKVN];
        for (int m = gw; m < M; m += NGW) { const unsigned wv = *(const unsigned*)(R1 + (size_t)m * NQ0 + C_CKV + 2 * lane); const float a = bflo(wv), b = bfhi(wv);
            const float r = 1.f / sqrtf(wave_sum(a * a + b * b) * (1.f / 128.f) + 1e-6f);
            *(unsigned*)(CKVN + (size_t)m * 128 + 2 * lane) = pk2(a * r * kvn[2 * lane], b * r * kvn[2 * lane + 1]);
            if (lane < 32) *(unsigned*)((bf16*)(ws + WS_KIDXC) + (size_t)m * 64 + 2 * lane) = *(const unsigned*)(R1 + (size_t)m * NQ0 + C_KIDX + 2 * lane); }
        for (int u = gw; u < BATCH * 8 * (SEQ / 32); u += NGW) { const int qt = (SEQ / 32 - 1) - (u / (BATCH * 8)), bh = u % (BATCH * 8); stick_unit(R1, OCAT, bh >> 3, bh & 7, qt, lane); }
    }
    SEAM(2);
    if (IN(3)) REP(3) { PHASE_IDS(); unsigned long long pacc = 0ull;
        if (G == 256 && !(DUP_MASK >> 3 & 1)) {
            unsigned* qctr = (unsigned*)ws + 8192 + 2048 + 64 * (bx & 7);
            const int b = bx & 7;
            if (tid == 0) MISC[4] = __hip_atomic_fetch_add(qctr, 1u, __ATOMIC_RELAXED, __HIP_MEMORY_SCOPE_AGENT);
            __syncthreads();
            int L = (int)MISC[4];
            while (L < 128) { unsigned nxt = 0u;
                if (tid == 0) nxt = __hip_atomic_fetch_add(qctr, 1u, __ATOMIC_RELAXED, __HIP_MEMORY_SCOPE_AGENT);
                dsa_unit(R1, (const bf16*)(ws + WS_KIDXC), CKVN, (const bf16*)(ws + WS_WUKT), (const bf16*)(ws + WS_WUVT), OCAT, b, 127 - L, lds, tid, wave, lane, true, 127, pacc);
                if (tid == 0) MISC[4] = nxt;
                __syncthreads();
                L = (int)MISC[4];
                __syncthreads(); }
        } else {
        const int nun = (G == 256) ? 4 : (BATCH * 128 - bx + G - 1) / G;
#ifndef DSA_ORDER
#define DSA_ORDER(i, j) ((i) == 0 ? 127 - (j) : (i) == 1 ? 64 + (j) : (i) == 2 ? 63 - (j) : (j))
#endif
#ifndef DSA_DUMMY_MASK
#define DSA_DUMMY_MASK 15
#endif
#ifdef DSA_DUP_SEARCH
        for (int i2 = 0; i2 < 2 * nun; ++i2) { const int i = i2 >> 1; const bool do_att = (i2 & 1) != 0; int b, qt;
#else
        for (int i = 0; i < nun; ++i) { const bool do_att = true; int b, qt;
#endif
            if (G == 256) { const int j = vcu & 31; b = vcu >> 5; qt = DSA_ORDER(i, j); }
            else { const int u = bx + i * G; b = u >> 7; qt = u & 127; }
            dsa_unit(R1, (const bf16*)(ws + WS_KIDXC), CKVN, (const bf16*)(ws + WS_WUKT), (const bf16*)(ws + WS_WUVT), OCAT, b, qt, lds, tid, wave, lane, do_att, do_att ? 127 : DSA_DUMMY_MASK, pacc); }
        }
#ifdef DSA_TSEC
        { const unsigned long long t0_ = __builtin_amdgcn_s_memrealtime(); while (__builtin_amdgcn_s_memrealtime() - t0_ < 4ull * pacc) __builtin_amdgcn_s_sleep(8); __syncthreads(); }
#endif
    }
#ifdef DSA_TSEC
    if (IN(3)) {   }
#endif
    SEAM(3);
    if (IN(4)) REP(4) { PHASE_IDS(); pg8::Gemm g{OCAT, W0OUT, M, DM, KO0}; pg8::StaticOrder S; S.init(M, DM, G, bx); pg8::EpiResid E{(DUP_MASK >> 4 & 1) && rep_ == 0 ? R1 : X, DM, ALPHA};
        pg8::gemm_phase<pg8::EpiResid, pg8::StaticOrder, true, true>(lds, g, S, E); }
    SEAM(4);
    if (IN(5)) REP(5) { PHASE_IDS(); for (int m = gw; m < M; m += NGW) ln_row<false>(X + (size_t)m * DM, args.in[I_LNMG], args.in[I_LNMB], nullptr, lane); }
    SEAM(5);
    if (IN(6)) REP(6) { PHASE_IDS(); pg8::Gemm g{X, WGU0, M, NGU, DM}; pg8::StaticOrder S; S.init(M, NGU, G, bx); pg8::EpiSwiGLU E{R1, DFF};
        pg8::gemm_phase<pg8::EpiSwiGLU, pg8::StaticOrder, true, true>(lds, g, S, E); }
    SEAM(6);
    if (IN(7)) REP(7) { PHASE_IDS(); pg8::Gemm g{R1, WDN0, M, DM, DFF}; pg8::StaticOrder S; S.init(M, DM, G, bx); pg8::EpiResid E{(DUP_MASK >> 7 & 1) && rep_ == 0 ? OCAT : X, DM, ALPHA};
        pg8::gemm_phase<pg8::EpiResid, pg8::StaticOrder, true, true>(lds, g, S, E); }
    SEAM(7);
    if (IN(8)) REP(8) { PHASE_IDS(); for (int m = gw; m < M; m += NGW) ln_row<false>(X + (size_t)m * DM, args.in[I_LNFG], args.in[I_LNFB], nullptr, lane); }
    SEAM(8);
    if (IN(9)) REP(9) { PHASE_IDS(); pg8::Gemm g{X, W1IN, M, NQ1, DM}; pg8::StaticOrder S; S.init(M, NQ1, G, bx); pg8::EpiBf16<0> E{R1, NQ1, nullptr, 0, 0, 1.f};
        pg8::gemm_phase<pg8::EpiBf16<0>, pg8::StaticOrder, true, true>(lds, g, S, E); }
    SEAM(9);
    if (IN(10)) REP(10) { PHASE_IDS();
        float* KN2 = (float*)(ws + WS_KN2);
        for (int u = gw; u < BATCH * 16 * 16; u += NGW) { const int b = u >> 8, h = (u >> 4) & 15, n = u & 15;
            const bf16* kp = R1 + ((size_t)b * SEQ + 256 * n + (lane >> 5)) * NQ1 + 1024 + h * 64 + 2 * (lane & 31);
            float s0 = 0.f, s1 = 0.f, nmax = 0.f;
#pragma unroll 4
            for (int i = 0; i < 128; ++i) { const unsigned wv = *(const unsigned*)(kp + (size_t)(2 * i) * NQ1); const float k0 = bflo(wv), k1 = bfhi(wv);
                s0 += k0; s1 += k1;
                float n2 = k0 * k0 + k1 * k1;
                n2 += __builtin_bit_cast(float, __builtin_amdgcn_update_dpp(0, __builtin_bit_cast(int, n2), 0xB1, 0xf, 0xf, false));
                n2 += __builtin_bit_cast(float, __builtin_amdgcn_update_dpp(0, __builtin_bit_cast(int, n2), 0x4E, 0xf, 0xf, false));
                n2 += __builtin_bit_cast(float, __builtin_amdgcn_update_dpp(0, __builtin_bit_cast(int, n2), 0x124, 0xf, 0xf, false));
                n2 += __builtin_bit_cast(float, __builtin_amdgcn_update_dpp(0, __builtin_bit_cast(int, n2), 0x128, 0xf, 0xf, false));
                { auto sw = __builtin_amdgcn_permlane16_swap(__float_as_uint(n2), __float_as_uint(n2), false, false); n2 = __uint_as_float(sw[0]) + __uint_as_float(sw[1]); }
                nmax = __builtin_fmaxf(nmax, n2);
                if ((i & 31) == 31) {
                    const float m = __builtin_fmaxf(nmax, __shfl_xor(nmax, 32));
                    if (lane == 0) KN2[(size_t)u * 4 + (i >> 5)] = m; nmax = 0.f; } }
            s0 += __shfl_xor(s0, 32); s1 += __shfl_xor(s1, 32);
            if (lane < 32) { float* o = KMEAN + (size_t)u * 64 + 2 * lane; o[0] = s0 * (1.f / 256.f); o[1] = s1 * (1.f / 256.f); } }
    }
    SEAM(10);
    if (IN(11)) REP(11) { PHASE_IDS();
        for (size_t e = (size_t)bx * NTHR + tid; e < (size_t)M * 16; e += (size_t)G * NTHR) {
            const int h = (int)(e / M); const int m = (int)(e % M); const int b = m / SEQ, t = m % SEQ, cur = t >> 8;
            float q[64];
            { const bf16* qp = R1 + (size_t)m * NQ1 + h * 64;
#pragma unroll
              for (int i = 0; i < 8; ++i) { const v4u wv = *(const v4u*)(qp + 8 * i); q[8 * i] = bflo(wv.x); q[8 * i + 1] = bfhi(wv.x); q[8 * i + 2] = bflo(wv.y); q[8 * i + 3] = bfhi(wv.y);
                  q[8 * i + 4] = bflo(wv.z); q[8 * i + 5] = bfhi(wv.z); q[8 * i + 6] = bflo(wv.w); q[8 * i + 7] = bfhi(wv.w); } }
            float g0 = -INFINITY, g1 = -INFINITY, g2 = -INFINITY; int i0 = -1, i1 = -1, i2 = -1;
            for (int n = 0; n < cur; ++n) { const float* km = KMEAN + ((size_t)(b * 16 + h) * 16 + n) * 64; float s = 0.f;
#pragma unroll
                for (int d4 = 0; d4 < 16; ++d4) { const f32x4 kv = *(const f32x4*)(km + 4 * d4); s = __builtin_fmaf(q[4 * d4], kv[0], s); s = __builtin_fmaf(q[4 * d4 + 1], kv[1], s); s = __builtin_fmaf(q[4 * d4 + 2], kv[2], s); s = __builtin_fmaf(q[4 * d4 + 3], kv[3], s); }
                if (s > g0) { g2 = g1; i2 = i1; g1 = g0; i1 = i0; g0 = s; i0 = n; } else if (s > g1) { g2 = g1; i2 = i1; g1 = s; i1 = n; } else if (s > g2) { g2 = s; i2 = n; } }
            unsigned mask = 1u << cur; if (i0 >= 0) mask |= 1u << i0; if (i1 >= 0) mask |= 1u << i1; if (i2 >= 0) mask |= 1u << i2;
            ALLOW[(size_t)m * 16 + h] = (unsigned short)mask; }
    }
    SEAM(11);
    if (IN(12)) REP(12) { PHASE_IDS();
        const float* KN2 = (const float*)(ws + WS_KN2);
        if (G == 256) {
            unsigned* qctr = (unsigned*)ws + 8192 + 64 * (bx & 7) + 1024 * rep_;
            const int b = bx & 7;
            if (tid == 0) MISC[4] = __hip_atomic_fetch_add(qctr, 1u, __ATOMIC_RELAXED, __HIP_MEMORY_SCOPE_AGENT);
            __syncthreads();
            int L = (int)MISC[4];
            while (L < 256) { unsigned nxt = 0u;
                if (tid == 0) nxt = __hip_atomic_fetch_add(qctr, 1u, __ATOMIC_RELAXED, __HIP_MEMORY_SCOPE_AGENT);
                const int qb = 15 - (L >> 4), h = 15 - (L & 15);
#ifdef MOBA_PROBE_NOBIAS
                if ((DUP_MASK >> 12 & 1) && rep_ == 0) moba::attn_unit<8, false>(b, h, qb, (const moba::bf16*)R1, (const moba::bf16*)(R1 + 1024), (const moba::bf16*)(R1 + 2048), (moba::bf16*)OCAT, ALLOW, KN2 + (size_t)(b * 16 + h) * 64,
                                   LOG2E * __builtin_amdgcn_exp2f(-0.5f * (float)(h + 1)), (char*)lds_raw); else
#endif
                moba::attn_unit<8>(b, h, qb, (const moba::bf16*)R1, (const moba::bf16*)(R1 + 1024), (const moba::bf16*)(R1 + 2048), (moba::bf16*)OCAT, ALLOW, KN2 + (size_t)(b * 16 + h) * 64,
                                   LOG2E * __builtin_amdgcn_exp2f(-0.5f * (float)(h + 1)), (char*)lds_raw);
                if (tid == 0) MISC[4] = nxt;
                __syncthreads();
                L = (int)MISC[4];
                __syncthreads(); }
        } else for (int u = bx; u < BATCH * 256; u += G) { const int b = u >> 8, h = (u >> 4) & 15, qb = 15 - (u & 15);
            moba::attn_unit<8>(b, h, qb, (const moba::bf16*)R1, (const moba::bf16*)(R1 + 1024), (const moba::bf16*)(R1 + 2048), (moba::bf16*)OCAT, ALLOW, KN2 + (size_t)(b * 16 + h) * 64,
                               LOG2E * __builtin_amdgcn_exp2f(-0.5f * (float)(h + 1)), (char*)lds_raw); }
    }
    SEAM(12);
    if (IN(13)) REP(13) { PHASE_IDS(); pg8::Gemm g{OCAT, W1OUT, M, DM, DM}; pg8::StaticOrder S; S.init(M, DM, G, bx); pg8::EpiResid E{X, DM, ALPHA};
        pg8::gemm_phase<pg8::EpiResid, pg8::StaticOrder, true, true>(lds, g, S, E); }
    SEAM(13);
    if (IN(14)) REP(14) { PHASE_IDS(); for (int m = gw; m < M; m += NGW) ln_row<false>(X + (size_t)m * DM, args.in[I_LNMG] + DM, args.in[I_LNMB] + DM, nullptr, lane); }
    SEAM(14);
    if (IN(15)) REP(15) { PHASE_IDS(); pg8::Gemm g{X, WGU1, M, NGU, DM}; pg8::StaticOrder S; S.init(M, NGU, G, bx); pg8::EpiSwiGLU E{R1, DFF};
        pg8::gemm_phase<pg8::EpiSwiGLU, pg8::StaticOrder, true, true>(lds, g, S, E); }
    SEAM(15);
    if (IN(16)) REP(16) { PHASE_IDS(); pg8::Gemm g{R1, WDN1, M, DM, DFF}; pg8::StaticOrder S; S.init(M, DM, G, bx); pg8::EpiResid E{X, DM, ALPHA};
        pg8::gemm_phase<pg8::EpiResid, pg8::StaticOrder, true, true>(lds, g, S, E); }
    SEAM(16);
    if (IN(17)) REP(17) { PHASE_IDS(); for (int m = gw; m < M; m += NGW) ln_row<true>(X + (size_t)m * DM, args.in[I_LNFG] + DM, args.in[I_LNFB] + DM, args.out + (size_t)m * DM, lane); }
#undef IN
#undef SEAM
}

#ifndef MK_N_LAUNCHES
#define MK_N_LAUNCHES 1
#endif
extern "C" void kernel_launch(void* const* d_in, const int* in_sizes, int n_in, void* d_out, int out_size, void* d_ws, size_t ws_size, hipStream_t stream) {
    static int grid = 0;
    if (grid == 0) {
        if (n_in != 15 || in_sizes[0] != M * DM || out_size != M * DM || ws_size < WS_END) { fprintf(stderr, "kernel_launch: unexpected shapes (n_in %d, in0 %d, out %d, ws %zu); nothing launched\n", n_in, n_in > 0 ? in_sizes[0] : -1, out_size, ws_size); grid = -1; return; }
        int dev = 0, cus = 0, per_cu = 0;
        if (hipGetDevice(&dev) != hipSuccess || hipDeviceGetAttribute(&cus, hipDeviceAttributeMultiprocessorCount, dev) != hipSuccess) { grid = -1; return; }
        if (hipFuncSetAttribute((const void*)mega_fwd, hipFuncAttributeMaxDynamicSharedMemorySize, LDS_BYTES) != hipSuccess) { fprintf(stderr, "kernel_launch: hipFuncSetAttribute failed\n"); grid = -1; return; }
        if (hipOccupancyMaxActiveBlocksPerMultiprocessor(&per_cu, (const void*)mega_fwd, NTHR, LDS_BYTES) != hipSuccess || per_cu < 1) { fprintf(stderr, "kernel_launch: occupancy query reports %d\n", per_cu); per_cu = 1; }
        (void)hipGetLastError();
        grid = cus;
    }
    if (grid < 0) return;
    if (hipMemsetAsync(d_ws, 0, 65536, stream) != hipSuccess) { fprintf(stderr, "kernel_launch: hipMemsetAsync failed\n"); return; }
    Args a{};
    for (int i = 0; i < 15; ++i) a.in[i] = (const float*)d_in[i];
    a.out = (float*)d_out; a.ws = (unsigned char*)d_ws;
    if (MK_N_LAUNCHES == 1) {
        a.ph_lo = 0; a.ph_hi = NPHASE;
        void* kargs[] = {&a};
        hipError_t e = hipLaunchCooperativeKernel((const void*)mega_fwd, dim3(grid), dim3(NTHR), kargs, LDS_BYTES, stream);
        if (e != hipSuccess) fprintf(stderr, "kernel_launch: cooperative launch failed: %s (grid %d)\n", hipGetErrorString(e), grid);
    } else {
        for (int p = 0; p < NPHASE; ++p) { a.ph_lo = p; a.ph_hi = p + 1; hipLaunchKernelGGL(mega_fwd, dim3(grid), dim3(NTHR), LDS_BYTES, stream, a); }
    }
}
```

```cpp
#include <hip/hip_runtime.h>
#include <hip/hip_cooperative_groups.h>
#include <hip/hip_bf16.h>
#include <cstdio>
#include <cstdint>
#include <cmath>
namespace cg = cooperative_groups;
namespace pg8 {
#define PG8_LAS __attribute__((address_space(3)))
typedef unsigned short bf16_t;
typedef short bf16x8 __attribute__((ext_vector_type(8)));
typedef float f32x4 __attribute__((ext_vector_type(4)));
typedef unsigned u32x4 __attribute__((ext_vector_type(4)));
constexpr int BM = 256, BK = 64, HALF = 128, HTB = HALF * BK * 2  , STAGE_BYTES = 8 * HTB, NXCD = 8, WGM = 16;

__host__ __device__ __forceinline__ int lds_byte(int r, int c) { const int st = (r >> 4) * 2 + (c >> 5), rr = r & 15, cc = c & 31, ob = rr * 64 + cc * 2; return st * 1024 + (ob ^ (((ob >> 9) & 1) << 5)); }
__host__ __device__ __forceinline__ void stage_rc(int b, int& R, int& C) { const int st = b / 1024, sb = b % 1024, swz = sb ^ (((sb >> 9) & 1) << 5); R = (st >> 1) * 16 + swz / 64; C = (st & 1) * 32 + (swz % 64) / 2; }
__host__ __device__ __forceinline__ int perm32(int rho) { const int n = rho >> 4, i = rho & 15; return 8 * (i >> 2) + 4 * n + (i & 3); }

struct Unit { int pm, pn; };
struct Gemm { const bf16_t* A; const bf16_t* Bt; int M, N, K; };

struct StaticOrder {
    int nM, nN, nwg, G, c;
    __host__ __device__ void init(int M, int N, int G_, int c_) { nM = M / BM; nN = N / BM; nwg = nM * nN; G = G_; c = c_; }
    __host__ __device__ bool next(int i, Unit& u) const {
        const long L = (long)i * G + c; if (L >= nwg) return false;
        int wgid = (int)L; { const int q = nwg / NXCD, r = nwg % NXCD, xcd = wgid % NXCD, off = wgid / NXCD; wgid = (xcd < r ? xcd * (q + 1) : r * (q + 1) + (xcd - r) * q) + off; }
        const int nig = WGM * nN, gid = wgid / nig, fm = gid * WGM, gsz = (nM - fm) < WGM ? (nM - fm) : WGM;
        u.pm = fm + ((wgid % nig) % gsz); u.pn = (wgid % nig) / gsz; return true;
    }
    __device__ __forceinline__ void a_ready(const Unit&) const {}
    __device__ __forceinline__ void done(const Unit&) const {}
};

__device__ __forceinline__ unsigned cvt_pk_bf16(float lo, float hi) { unsigned r; asm volatile("v_cvt_pk_bf16_f32 %0, %1, %2" : "=v"(r) : "v"(lo), "v"(hi)); return r; }
typedef float f32x2 __attribute__((ext_vector_type(2)));
__device__ __forceinline__ f32x2 gelu_pk(f32x2 v) {
    const f32x2 av = __builtin_elementwise_abs(v), d = av * 0.2316418882f + 1.0f;
    f32x2 t; t.x = __builtin_amdgcn_rcpf(d.x); t.y = __builtin_amdgcn_rcpf(d.y);
    f32x2 q = t * 0.5307027145f + (-0.7265760135f); q = q * t + 0.7107068705f; q = q * t + (-0.142248368f); q = q * t + 0.127414796f; q = q * t;
    const f32x2 s = (v * v) * (-0.72134752044f);
    f32x2 e; e.x = __builtin_amdgcn_exp2f(s.x); e.y = __builtin_amdgcn_exp2f(s.y);
    const f32x2 m = v * (q * e), r = v - m;
    f32x2 o; o.x = v.x < 0.f ? m.x : r.x; o.y = v.y < 0.f ? m.y : r.y; return o;
}

template <int ACT  > struct EpiBf16 {
    static constexpr bool PERM = true, AFTER_DRAIN = false; static_assert(ACT == 0 || ACT == 1, "EpiBf16: ACT is 0 (none) or 1 (gelu_pk)");
    bf16_t* O; int ldc; const float* bias; int split_cols; size_t split_stride; float scale0;
    __device__ __forceinline__ void operator()(const f32x4 (&acc)[2][2][4][2], const Unit& u, int wr, int wc, int fr, int fq) const {
        const int row0 = u.pm * BM + wr * 64 + fr; int colt = u.pn * BM; bf16_t* base = O;
        float sc = 1.f; if (split_cols) { const int t = colt / split_cols; base += (size_t)t * split_stride; colt -= t * split_cols; if (t == 0) sc = scale0; }
        const int col0 = colt + wc * 32 + 8 * fq, bcol0 = u.pn * BM + wc * 32 + 8 * fq;
        f32x4 bv[2][2];
#pragma unroll
        for (int bj = 0; bj < 2; ++bj)
#pragma unroll
            for (int n = 0; n < 2; ++n) bv[bj][n] = bias ? *(const f32x4*)(bias + bcol0 + bj * HALF + 4 * n) : (f32x4){0.f, 0.f, 0.f, 0.f};
#pragma unroll
        for (int ai = 0; ai < 2; ++ai)
#pragma unroll
            for (int m = 0; m < 4; ++m) { bf16_t* rowp = base + (size_t)(row0 + ai * HALF + m * 16) * ldc + col0;
#pragma unroll
                for (int bj = 0; bj < 2; ++bj) { f32x4 v0 = acc[ai][bj][m][0] + bv[bj][0], v1 = acc[ai][bj][m][1] + bv[bj][1];
                    if (ACT == 1) { f32x2 a = gelu_pk((f32x2){v0[0], v0[1]}), b = gelu_pk((f32x2){v0[2], v0[3]}), c = gelu_pk((f32x2){v1[0], v1[1]}), d = gelu_pk((f32x2){v1[2], v1[3]});
                        v0 = (f32x4){a.x, a.y, b.x, b.y}; v1 = (f32x4){c.x, c.y, d.x, d.y}; }
                    v0 = v0 * sc; v1 = v1 * sc; u32x4 w; w.x = cvt_pk_bf16(v0[0], v0[1]); w.y = cvt_pk_bf16(v0[2], v0[3]); w.z = cvt_pk_bf16(v1[0], v1[1]); w.w = cvt_pk_bf16(v1[2], v1[3]);
                    *(u32x4*)(rowp + bj * HALF) = w; } }
    }
};

struct PanelStats {
    unsigned* xbuf;
    unsigned* cnt;
    unsigned* tmo;
    int ntn; float eps;
    unsigned code;
    __device__ __forceinline__ bool run(const f32x4 (&v)[2][2][4][2], const Unit& u, int wr, int wc, int fr, int fq, PG8_LAS unsigned char* lds, int wid, int lane) const {
        typedef float f32x2v __attribute__((ext_vector_type(2)));
        PG8_LAS f32x2v* P = (PG8_LAS f32x2v*)lds;
        PG8_LAS f32x2v* S = (PG8_LAS f32x2v*)(lds + 8192);
        PG8_LAS unsigned* flag = (PG8_LAS unsigned*)(lds + 8192 + 2048);
#pragma unroll
        for (int ai = 0; ai < 2; ++ai)
#pragma unroll
            for (int m = 0; m < 4; ++m) {
                float s = 0.f;
#pragma unroll
                for (int bj = 0; bj < 2; ++bj)
#pragma unroll
                    for (int n = 0; n < 2; ++n) { const f32x4 x = v[ai][bj][m][n]; s += (x[0] + x[1]) + (x[2] + x[3]); }
                s += __shfl_xor(s, 16); s += __shfl_xor(s, 32);
                const float mw = s * (1.0f / 64.0f); float q = 0.f;
#pragma unroll
                for (int bj = 0; bj < 2; ++bj)
#pragma unroll
                    for (int n = 0; n < 2; ++n) { const f32x4 d = v[ai][bj][m][n] - mw; q += (d[0] * d[0] + d[1] * d[1]) + (d[2] * d[2] + d[3] * d[3]); }
                q += __shfl_xor(q, 16); q += __shfl_xor(q, 32);
                if (fq == 0) P[(ai * HALF + wr * 64 + m * 16 + fr) * 4 + wc] = (f32x2v){mw, q};
            }
        asm volatile("s_waitcnt lgkmcnt(0)" ::: "memory"); __builtin_amdgcn_s_barrier(); asm volatile("" ::: "memory");
#if defined(BROKEN_EXCHANGE_NO_WAIT)
#warning BROKEN CONTROL BUILD: the row-statistics exchange does not wait; results are wrong by design
        if (blockIdx.x >= 64) { const long long t0_ = clock64(); while (clock64() - t0_ < 60000) __builtin_amdgcn_s_sleep(8); }
#endif
        const int row = wid * 32 + (lane & 31);
        if (lane < 32) {
            const f32x2v a = P[row * 4 + 0], b = P[row * 4 + 1], c = P[row * 4 + 2], d = P[row * 4 + 3];
            const float mt = (a.x + b.x + c.x + d.x) * 0.25f;
            const float da = a.x - mt, db = b.x - mt, dc = c.x - mt, dd = d.x - mt;
            const float m2 = (a.y + b.y) + (c.y + d.y) + 64.0f * ((da * da + db * db) + (dc * dc + dd * dd));
            unsigned long long* slot = (unsigned long long*)xbuf + ((size_t)(u.pm * BM + row) * 4 + u.pn);
            __hip_atomic_store(slot, ((unsigned long long)__float_as_uint(m2) << 32) | __float_as_uint(mt), __ATOMIC_RELAXED, __HIP_MEMORY_SCOPE_AGENT);
        }
        asm volatile("s_waitcnt vmcnt(0)" ::: "memory");
        if (lane == 0) __hip_atomic_fetch_add(cnt + 64 * u.pm, 1u, __ATOMIC_RELAXED, __HIP_MEMORY_SCOPE_AGENT);
        if (wid == 0) {
            bool dead = false; const unsigned long long t0 = __builtin_amdgcn_s_memrealtime(); const unsigned want = 8u * (unsigned)ntn;
            for (;;) {
#if defined(BROKEN_EXCHANGE_NO_WAIT)
                break;
#endif
                if ((unsigned)__builtin_amdgcn_readfirstlane(__hip_atomic_load(cnt + 64 * u.pm, __ATOMIC_RELAXED, __HIP_MEMORY_SCOPE_AGENT)) >= want) break;
                if (__builtin_amdgcn_s_memrealtime() - t0 > 2000000ull) {
                    if (lane == 0) { unsigned expect = 0u; __hip_atomic_compare_exchange_strong(tmo + 1, &expect, code | (unsigned)(u.pm & 0xff), __ATOMIC_RELAXED, __ATOMIC_RELAXED, __HIP_MEMORY_SCOPE_AGENT);
                                     __hip_atomic_store(tmo, 1u, __ATOMIC_RELAXED, __HIP_MEMORY_SCOPE_AGENT); }
                    dead = true; break; }
                __builtin_amdgcn_s_sleep(2);
            }
            __builtin_amdgcn_fence(__ATOMIC_ACQUIRE, "agent");
            if (lane == 0) flag[0] = dead ? 1u : 0u;
        }
        asm volatile("s_waitcnt vmcnt(0) lgkmcnt(0)" ::: "memory"); __builtin_amdgcn_s_barrier(); asm volatile("" ::: "memory");
        const bool bad = flag[0] != 0u;
        if (lane < 32) {
            const unsigned long long* slot = (const unsigned long long*)xbuf + (size_t)(u.pm * BM + row) * 4; float mt[4], m2[4]; float ms = 0.f;
#pragma unroll
            for (int t = 0; t < 4; ++t) { if (t < ntn) { const unsigned long long w = __hip_atomic_load(slot + t, __ATOMIC_RELAXED, __HIP_MEMORY_SCOPE_AGENT); mt[t] = __uint_as_float((unsigned)w); m2[t] = __uint_as_float((unsigned)(w >> 32)); } else { mt[t] = 0.f; m2[t] = 0.f; } ms += mt[t]; }
            const float mean = ms / (float)ntn; float q = 0.f;
#pragma unroll
            for (int t = 0; t < 4; ++t) if (t < ntn) { const float dm = mt[t] - mean; q += m2[t] + 256.0f * dm * dm; }
            S[row] = (f32x2v){mean, 1.0f / sqrtf(q / (256.0f * (float)ntn) + eps)};
        }
        asm volatile("s_waitcnt lgkmcnt(0)" ::: "memory"); __builtin_amdgcn_s_barrier(); asm volatile("" ::: "memory");
        return bad;
    }
};
struct EpiLnRes {
    static constexpr bool PERM = false, AFTER_DRAIN = true;
    const float* base; float* out; int ldc; const float* bias; PanelStats st; unsigned poison;
    __device__ __forceinline__ void fused(f32x4 (&acc)[2][2][4][2], const Unit& u, int wr, int wc, int fr, int fq, PG8_LAS unsigned char* lds, int wid, int lane) const {
        typedef float f32x2v __attribute__((ext_vector_type(2)));
        const PG8_LAS f32x2v* S = (const PG8_LAS f32x2v*)(lds + 8192);
        const int col0 = u.pn * BM + wc * 32 + 4 * fq;
#pragma unroll
        for (int bj = 0; bj < 2; ++bj)
#pragma unroll
            for (int n = 0; n < 2; ++n) { const f32x4 bv = bias ? *(const f32x4*)(bias + col0 + bj * HALF + n * 16) : (f32x4){0.f, 0.f, 0.f, 0.f};
#pragma unroll
                for (int ai = 0; ai < 2; ++ai)
#pragma unroll
                    for (int m = 0; m < 4; ++m) acc[ai][bj][m][n] += bv; }
        f32x4 pre[4][2][2];
#pragma unroll
        for (int m = 0; m < 4; ++m) { const size_t off = (size_t)(u.pm * BM + wr * 64 + m * 16 + fr) * ldc + col0;
#pragma unroll
            for (int bj = 0; bj < 2; ++bj)
#pragma unroll
                for (int n = 0; n < 2; ++n) pre[m][bj][n] = *(const f32x4*)(base + off + bj * HALF + n * 16); }
        const bool bad = st.run(acc, u, wr, wc, fr, fq, lds, wid, lane) || poison != 0u;
        const float qnan = __builtin_nanf("");
#pragma unroll
        for (int ai = 0; ai < 2; ++ai)
#pragma unroll
            for (int m = 0; m < 4; ++m) { const int r = ai * HALF + wr * 64 + m * 16 + fr; const f32x2v sr = S[r]; const size_t off = (size_t)(u.pm * BM + r) * ldc + col0;
#pragma unroll
                for (int bj = 0; bj < 2; ++bj)
#pragma unroll
                    for (int n = 0; n < 2; ++n) { const f32x4 bs = ai == 0 ? pre[m][bj][n] : *(const f32x4*)(base + off + bj * HALF + n * 16); f32x4 o = bs + (acc[ai][bj][m][n] - sr.x) * sr.y;
                        if (bad) o = (f32x4){qnan, qnan, qnan, qnan}; *(f32x4*)(out + off + bj * HALF + n * 16) = o; }
                if (m & 1) asm volatile("" ::: "memory"); }
    }
};
struct EpiLnResLn {
    static constexpr bool PERM = false, AFTER_DRAIN = true;
    const float* base; float* out; bf16_t* xn; int ldc; const float* bias; PanelStats st1, st2; unsigned poison;
    __device__ __forceinline__ void fused(f32x4 (&acc)[2][2][4][2], const Unit& u, int wr, int wc, int fr, int fq, PG8_LAS unsigned char* lds, int wid, int lane) const {
        typedef float f32x2v __attribute__((ext_vector_type(2))); typedef unsigned u32x2v __attribute__((ext_vector_type(2)));
        const PG8_LAS f32x2v* S = (const PG8_LAS f32x2v*)(lds + 8192);
        const int col0 = u.pn * BM + wc * 32 + 4 * fq;
#pragma unroll
        for (int bj = 0; bj < 2; ++bj)
#pragma unroll
            for (int n = 0; n < 2; ++n) { const f32x4 bv = bias ? *(const f32x4*)(bias + col0 + bj * HALF + n * 16) : (f32x4){0.f, 0.f, 0.f, 0.f};
#pragma unroll
                for (int ai = 0; ai < 2; ++ai)
#pragma unroll
                    for (int m = 0; m < 4; ++m) acc[ai][bj][m][n] += bv; }
        bool bad = st1.run(acc, u, wr, wc, fr, fq, lds, wid, lane) || poison != 0u;
        const float qnan = __builtin_nanf("");
#pragma unroll
        for (int ai = 0; ai < 2; ++ai)
#pragma unroll
            for (int m = 0; m < 4; ++m) { const int r = ai * HALF + wr * 64 + m * 16 + fr; const f32x2v sr = S[r]; const size_t off = (size_t)(u.pm * BM + r) * ldc + col0;
#pragma unroll
                for (int bj = 0; bj < 2; ++bj)
#pragma unroll
                    for (int n = 0; n < 2; ++n) { const f32x4 bs = *(const f32x4*)(base + off + bj * HALF + n * 16); acc[ai][bj][m][n] = bs + (acc[ai][bj][m][n] - sr.x) * sr.y; }
                asm volatile("" : "+v"(acc[ai][0][m][0]), "+v"(acc[ai][0][m][1]), "+v"(acc[ai][1][m][0]), "+v"(acc[ai][1][m][1]));
                if (m & 1) asm volatile("" ::: "memory"); }
        const bool bad1 = bad;
        bad = st2.run(acc, u, wr, wc, fr, fq, lds, wid, lane) || bad;
#pragma unroll
        for (int ai = 0; ai < 2; ++ai)
#pragma unroll
            for (int m = 0; m < 4; ++m) { const int r = ai * HALF + wr * 64 + m * 16 + fr; const f32x2v sr = S[r]; const size_t off = (size_t)(u.pm * BM + r) * ldc + col0;
#pragma unroll
                for (int bj = 0; bj < 2; ++bj)
#pragma unroll
                    for (int n = 0; n < 2; ++n) { const f32x4 x1 = acc[ai][bj][m][n]; *(f32x4*)(out + off + bj * HALF + n * 16) = bad1 ? (f32x4){qnan, qnan, qnan, qnan} : x1;
                        const f32x4 o = (x1 - sr.x) * sr.y; u32x2v w; w.x = cvt_pk_bf16(o[0], o[1]); w.y = cvt_pk_bf16(o[2], o[3]);
                        if (bad) { w.x = 0x7fc07fc0u; w.y = 0x7fc07fc0u; } *(u32x2v*)(xn + off + bj * HALF + n * 16) = w; }
                asm volatile("" ::: "memory"); }
    }
};

template <class Epi, class Sched, bool ALIGN_EPI = false, bool SP2 = false>
__device__ __forceinline__ void gemm_phase(PG8_LAS unsigned char* lds, const Gemm g, const Sched& S, const Epi& E) {
    int tid_l = threadIdx.x; asm volatile("" : "+v"(tid_l));
    const int tid = tid_l, wid = __builtin_amdgcn_readfirstlane(tid >> 6), lane = tid & 63, wr = wid >> 2, wc = wid & 3, fr = lane & 15, fq = lane >> 4;
    const int K = g.K, nt = K / BK;
    unsigned voffA[2], voffB[2];
#pragma unroll
    for (int i = 0; i < 2; ++i) { int R, C; stage_rc(tid * 16 + i * 8192, R, C); const int Rb = Epi::PERM ? ((R & ~31) + perm32(R & 31)) : R;
        voffA[i] = (unsigned)(R * K + C) * 2u; voffB[i] = (unsigned)(Rb * K + C) * 2u; }
    const size_t kstep = (size_t)(BK * 2);
    const size_t hstep = (size_t)HALF * K * 2;
    const size_t tstep = 2 * hstep;
    const unsigned ldsw = (unsigned)wid * 1024u;
    const int aoff = lds_byte(wr * 64 + fr, fq * 8), boff = lds_byte(wc * 32 + fr, fq * 8);
#define PG8_SA(b, h) (((b) * 2 + (h)) * HTB)
#define PG8_SB(b, h) ((4 + (b) * 2 + (h)) * HTB)
#define PG8_STAGE(bufoff, gbase, voff) do { _Pragma("unroll") for (int _i = 0; _i < 2; ++_i) \
        __builtin_amdgcn_global_load_lds((const unsigned*)((const char*)(gbase) + (voff)[_i]), (PG8_LAS unsigned*)(lds + (bufoff) + ldsw + _i * 8192), 16, 0, 0); } while (0)
#define PG8_LDA(dst, b, h) do { _Pragma("unroll") for (int m = 0; m < 4; ++m) _Pragma("unroll") for (int k = 0; k < 2; ++k) dst[m][k] = *(const PG8_LAS bf16x8*)(lds + PG8_SA(b, h) + aoff + m * 2048 + k * 1024); } while (0)
#define PG8_LDB(dst, b, h) do { _Pragma("unroll") for (int n = 0; n < 2; ++n) _Pragma("unroll") for (int k = 0; k < 2; ++k) dst[n][k] = *(const PG8_LAS bf16x8*)(lds + PG8_SB(b, h) + boff + n * 2048 + k * 1024); } while (0)
#define PG8_MMA(ai, bj, At, Bt) do { __builtin_amdgcn_s_setprio(1); _Pragma("unroll") for (int m = 0; m < 4; ++m) _Pragma("unroll") for (int n = 0; n < 2; ++n) _Pragma("unroll") for (int k = 0; k < 2; ++k) \
        acc[ai][bj][m][n] = __builtin_amdgcn_mfma_f32_16x16x32_bf16(Bt[n][k], At[m][k], acc[ai][bj][m][n], 0, 0, 0); __builtin_amdgcn_s_setprio(0); } while (0)
#define PG8_WAIT_V(n) asm volatile("s_waitcnt vmcnt(" #n ")" ::: "memory")
#define PG8_WAIT_L(n) asm volatile("s_waitcnt lgkmcnt(" #n ")" ::: "memory")
#define PG8_BAR __builtin_amdgcn_s_barrier()
#define PG8_SCHED __builtin_amdgcn_sched_barrier(0)
    Unit cur, nxt; int ui = 0;
    if (!S.next(0, cur)) return;
    f32x4 acc[2][2][4][2];
#pragma unroll
    for (int a = 0; a < 2; ++a)
#pragma unroll
        for (int b = 0; b < 2; ++b)
#pragma unroll
            for (int m = 0; m < 4; ++m)
#pragma unroll
                for (int n = 0; n < 2; ++n) acc[a][b][m][n] = (f32x4){0.f, 0.f, 0.f, 0.f};
    bf16x8 At[4][2], B0[2][2], B1[2][2];
    const char* cA = (const char*)g.A + (size_t)cur.pm * tstep; const char* cB = (const char*)g.Bt + (size_t)cur.pn * tstep;
    S.a_ready(cur);
    if constexpr (SP2) {
        PG8_STAGE(PG8_SB(0, 0), cB, voffB); PG8_STAGE(PG8_SB(0, 1), cB + hstep, voffB); PG8_STAGE(PG8_SA(0, 0), cA, voffA); PG8_STAGE(PG8_SA(0, 1), cA + hstep, voffA);
        if (wr == 1) PG8_BAR;
        PG8_WAIT_V(2); PG8_BAR;
        PG8_STAGE(PG8_SB(1, 0), cB + kstep, voffB); PG8_STAGE(PG8_SA(1, 0), cA + kstep, voffA); PG8_STAGE(PG8_SB(1, 1), cB + hstep + kstep, voffB);
        PG8_WAIT_V(6); PG8_BAR;
    } else {
        PG8_STAGE(PG8_SB(0, 0), cB, voffB); PG8_STAGE(PG8_SA(0, 0), cA, voffA); PG8_STAGE(PG8_SB(0, 1), cB + hstep, voffB); PG8_STAGE(PG8_SA(0, 1), cA + hstep, voffA);
        if (wr == 1) PG8_BAR;
        PG8_WAIT_V(4); PG8_BAR;
        PG8_STAGE(PG8_SB(1, 0), cB + kstep, voffB); PG8_STAGE(PG8_SA(1, 0), cA + kstep, voffA); PG8_STAGE(PG8_SB(1, 1), cB + hstep + kstep, voffB);
        PG8_WAIT_V(6); PG8_BAR;
    }
    for (;;) {
        const bool has_next = S.next(ui + 1, nxt);
        const char* nA = has_next ? (const char*)g.A + (size_t)nxt.pm * tstep : cA; const char* nB = has_next ? (const char*)g.Bt + (size_t)nxt.pn * tstep : cB;
        for (int t = 0; t < nt; t += 2) {
            const bool last = (t == nt - 2);
            const char* a1 = cA + (size_t)(t + 1) * kstep;
            const char* a2 = last ? nA : cA + (size_t)(t + 2) * kstep; const char* b2 = last ? nB : cB + (size_t)(t + 2) * kstep;
            const char* a3 = a2 + kstep; const char* b3 = b2 + kstep;
            if (last && has_next) S.a_ready(nxt);
            if constexpr (SP2) {
            PG8_LDB(B0, 0, 0); PG8_LDB(B1, 0, 1); PG8_SCHED; PG8_LDA(At, 0, 0); PG8_STAGE(PG8_SA(1, 1), a1 + hstep, voffA);
            PG8_WAIT_V(8); PG8_WAIT_L(0); PG8_BAR; PG8_MMA(0, 0, At, B0); PG8_MMA(0, 1, At, B1); PG8_BAR; PG8_SCHED;
            PG8_LDA(At, 0, 1); PG8_STAGE(PG8_SB(0, 0), b2, voffB); PG8_STAGE(PG8_SB(0, 1), b2 + hstep, voffB); PG8_STAGE(PG8_SA(0, 0), a2, voffA);
            PG8_WAIT_V(8); PG8_WAIT_L(0); PG8_BAR; PG8_MMA(1, 0, At, B0); PG8_MMA(1, 1, At, B1); PG8_BAR; PG8_SCHED;
            PG8_LDB(B0, 1, 0); PG8_LDB(B1, 1, 1); PG8_SCHED; PG8_LDA(At, 1, 0); PG8_STAGE(PG8_SA(0, 1), a2 + hstep, voffA);
            PG8_WAIT_V(8); PG8_WAIT_L(0); PG8_BAR; PG8_MMA(0, 0, At, B0); PG8_MMA(0, 1, At, B1); PG8_BAR; PG8_SCHED;
            PG8_LDA(At, 1, 1); PG8_STAGE(PG8_SB(1, 0), b3, voffB); PG8_STAGE(PG8_SB(1, 1), b3 + hstep, voffB); PG8_STAGE(PG8_SA(1, 0), a3, voffA);
            PG8_WAIT_V(8); PG8_WAIT_L(0); PG8_BAR; PG8_MMA(1, 0, At, B0); PG8_MMA(1, 1, At, B1); PG8_BAR; PG8_SCHED;
            } else {
            PG8_LDB(B0, 0, 0); PG8_SCHED; PG8_LDA(At, 0, 0); PG8_STAGE(PG8_SA(1, 1), a1 + hstep, voffA);
            PG8_WAIT_L(8); PG8_BAR; PG8_WAIT_L(0); PG8_MMA(0, 0, At, B0); PG8_BAR; PG8_SCHED;
            PG8_LDB(B1, 0, 1); PG8_STAGE(PG8_SB(0, 0), b2, voffB);
            PG8_BAR; PG8_WAIT_L(0); PG8_MMA(0, 1, At, B1); PG8_BAR;
            PG8_LDA(At, 0, 1); PG8_STAGE(PG8_SA(0, 0), a2, voffA);
            PG8_BAR; PG8_WAIT_L(0); PG8_MMA(1, 0, At, B0); PG8_BAR; PG8_SCHED;
            PG8_STAGE(PG8_SB(0, 1), b2 + hstep, voffB);
            PG8_WAIT_V(6); PG8_BAR; PG8_MMA(1, 1, At, B1); PG8_BAR;
            PG8_LDB(B0, 1, 0); PG8_SCHED; PG8_LDA(At, 1, 0); PG8_STAGE(PG8_SA(0, 1), a2 + hstep, voffA);
            PG8_WAIT_L(8); PG8_BAR; PG8_WAIT_L(0); PG8_MMA(0, 0, At, B0); PG8_BAR; PG8_SCHED;
            PG8_LDB(B1, 1, 1); PG8_STAGE(PG8_SB(1, 0), b3, voffB);
            PG8_BAR; PG8_WAIT_L(0); PG8_MMA(0, 1, At, B1); PG8_BAR;
            PG8_LDA(At, 1, 1); PG8_STAGE(PG8_SA(1, 0), a3, voffA);
            PG8_BAR; PG8_WAIT_L(0); PG8_MMA(1, 0, At, B0); PG8_BAR; PG8_SCHED;
            PG8_STAGE(PG8_SB(1, 1), b3 + hstep, voffB);
            PG8_WAIT_V(6); PG8_BAR; PG8_MMA(1, 1, At, B1); PG8_BAR;
            }
        }
        if constexpr (ALIGN_EPI) { if (wr == 0) PG8_BAR; }
        if constexpr (!Epi::AFTER_DRAIN) { E(acc, cur, wr, wc, fr, fq); S.done(cur); }
        if (!has_next) break;
#pragma unroll
        for (int a = 0; a < 2; ++a)
#pragma unroll
            for (int b = 0; b < 2; ++b)
#pragma unroll
                for (int m = 0; m < 4; ++m)
#pragma unroll
                    for (int n = 0; n < 2; ++n) acc[a][b][m][n] = (f32x4){0.f, 0.f, 0.f, 0.f};
        cur = nxt; cA = nA; cB = nB; ++ui;
        if constexpr (ALIGN_EPI) { if (wr == 1) PG8_BAR; }
    }
    PG8_WAIT_V(0);
    if constexpr (!ALIGN_EPI) { if (wr == 0) PG8_BAR; }
    PG8_BAR;
    if constexpr (Epi::AFTER_DRAIN) { E.fused(acc, cur, wr, wc, fr, fq, lds, wid, lane); S.done(cur); }
#undef PG8_SA
#undef PG8_SB
#undef PG8_STAGE
#undef PG8_LDA
#undef PG8_LDB
#undef PG8_MMA
#undef PG8_WAIT_V
#undef PG8_WAIT_L
#undef PG8_BAR
#undef PG8_SCHED
}
}
namespace pg8 {
struct EpiSwiGLU {
    static constexpr bool PERM = true, AFTER_DRAIN = false;
    bf16_t* O; int ldc;
    __device__ __forceinline__ void operator()(const f32x4 (&acc)[2][2][4][2], const Unit& u, int wr, int wc, int fr, int fq) const {
        const int row0 = u.pm * BM + wr * 64 + fr, col0 = u.pn * HALF + wc * 32 + 8 * fq;
#pragma unroll
        for (int ai = 0; ai < 2; ++ai)
#pragma unroll
            for (int m = 0; m < 4; ++m) { bf16_t* rowp = O + (size_t)(row0 + ai * HALF + m * 16) * ldc + col0;
                float v[8];
#pragma unroll
                for (int n = 0; n < 2; ++n)
#pragma unroll
                    for (int j = 0; j < 4; ++j) { const float g = acc[ai][0][m][n][j], up = acc[ai][1][m][n][j];
                        const float e = __builtin_amdgcn_exp2f(g * -1.4426950408889634f); v[4 * n + j] = g * __builtin_amdgcn_rcpf(1.0f + e) * up; }
                u32x4 w; w.x = cvt_pk_bf16(v[0], v[1]); w.y = cvt_pk_bf16(v[2], v[3]); w.z = cvt_pk_bf16(v[4], v[5]); w.w = cvt_pk_bf16(v[6], v[7]);
                __builtin_nontemporal_store(w, (u32x4*)rowp); }
    }
};
struct EpiResid {
    static constexpr bool PERM = true, AFTER_DRAIN = false;
    bf16_t* X; int ldc; float alpha;
    __device__ __forceinline__ void operator()(const f32x4 (&acc)[2][2][4][2], const Unit& u, int wr, int wc, int fr, int fq) const {
        const int row0 = u.pm * BM + wr * 64 + fr, col0 = u.pn * BM + wc * 32 + 8 * fq;
#pragma unroll
        for (int ai = 0; ai < 2; ++ai)
#pragma unroll
            for (int m = 0; m < 4; ++m) { bf16_t* rowp = X + (size_t)(row0 + ai * HALF + m * 16) * ldc + col0;
#pragma unroll
                for (int bj = 0; bj < 2; ++bj) { const u32x4 x = *(const u32x4*)(rowp + bj * HALF);
                    const f32x4 a0 = acc[ai][bj][m][0], a1 = acc[ai][bj][m][1];
                    float r[8];
                    r[0] = alpha * __uint_as_float(x.x << 16) + a0[0]; r[1] = alpha * __uint_as_float(x.x & 0xffff0000u) + a0[1];
                    r[2] = alpha * __uint_as_float(x.y << 16) + a0[2]; r[3] = alpha * __uint_as_float(x.y & 0xffff0000u) + a0[3];
                    r[4] = alpha * __uint_as_float(x.z << 16) + a1[0]; r[5] = alpha * __uint_as_float(x.z & 0xffff0000u) + a1[1];
                    r[6] = alpha * __uint_as_float(x.w << 16) + a1[2]; r[7] = alpha * __uint_as_float(x.w & 0xffff0000u) + a1[3];
                    u32x4 w; w.x = cvt_pk_bf16(r[0], r[1]); w.y = cvt_pk_bf16(r[2], r[3]); w.z = cvt_pk_bf16(r[4], r[5]); w.w = cvt_pk_bf16(r[6], r[7]);
                    *(u32x4*)(rowp + bj * HALF) = w; } }
    }
};
}
#define LAS __attribute__((address_space(3)))
typedef unsigned short bf16;
typedef short bf16x8 __attribute__((ext_vector_type(8)));
typedef short s16x4 __attribute__((ext_vector_type(4)));
typedef float f32x4 __attribute__((ext_vector_type(4)));
typedef float f32x16 __attribute__((ext_vector_type(16)));
typedef unsigned v4u __attribute__((ext_vector_type(4)));
typedef unsigned v2u __attribute__((ext_vector_type(2)));

constexpr int NWAVES = 8, NTHR = 512;
constexpr int BATCH = 8, SEQ = 4096, DM = 1024, M = BATCH * SEQ;
constexpr int NQ0 = 2560;
constexpr int C_QA = 0, C_CKV = 512, C_QIDX = 640, C_KIDX = 896, C_QB = 960, C_KB = 1472, C_VB = 1984, C_WIDX = 2496;
constexpr int KO0 = 1024;
constexpr int DFF = 2816, NGU = 2 * DFF;
constexpr int NQ1 = 3072;
constexpr int TOPK = 256;
constexpr float LOG2E = 1.4426950408889634f;
constexpr float C2 = 0.125f * LOG2E;
constexpr float ALPHA = 1.4142135623730951f;

constexpr size_t MiB = 1u << 20;
constexpr size_t WS_W0IN = 1 * MiB, WS_W0OUT = 7 * MiB, WS_WGU0 = 10 * MiB, WS_WGU1 = 21 * MiB, WS_WDN0 = 32 * MiB, WS_WDN1 = 38 * MiB, WS_W1IN = 44 * MiB, WS_W1OUT = 50 * MiB;
constexpr size_t WS_KMEAN = 52 * MiB, WS_ALLOW = 53 * MiB, WS_KN2 = 55 * MiB, WS_WUKT = 55 * MiB + 262144, WS_WUVT = 55 * MiB + 524288, WS_CKVN = 56 * MiB, WS_X = 64 * MiB, WS_R1 = 128 * MiB, WS_OCAT = 320 * MiB, WS_KIDXC = 416 * MiB, WS_END = 420 * MiB;

constexpr int LDS_BYTES = 163840;

__device__ __forceinline__ unsigned f2bf(float f) { unsigned u = __builtin_bit_cast(unsigned, f); return (u + 0x7fffu + ((u >> 16) & 1u)) >> 16; }
__device__ __forceinline__ unsigned pk2(float lo, float hi) { return f2bf(lo) | (f2bf(hi) << 16); }
__device__ __forceinline__ float bflo(unsigned w) { return __uint_as_float(w << 16); }
__device__ __forceinline__ float bfhi(unsigned w) { return __uint_as_float(w & 0xffff0000u); }
__device__ __forceinline__ float bf1(unsigned short h) { return __uint_as_float(((unsigned)h) << 16); }
#define LDS_WAIT() asm volatile("s_waitcnt lgkmcnt(0)" ::: "memory")
__device__ __forceinline__ float wave_sum(float v) {
    v += __builtin_bit_cast(float, __builtin_amdgcn_update_dpp(0, __builtin_bit_cast(int, v), 0xB1, 0xf, 0xf, false));
    v += __builtin_bit_cast(float, __builtin_amdgcn_update_dpp(0, __builtin_bit_cast(int, v), 0x4E, 0xf, 0xf, false));
    v += __builtin_bit_cast(float, __builtin_amdgcn_update_dpp(0, __builtin_bit_cast(int, v), 0x124, 0xf, 0xf, false));
    v += __builtin_bit_cast(float, __builtin_amdgcn_update_dpp(0, __builtin_bit_cast(int, v), 0x128, 0xf, 0xf, false));
    const float a = __builtin_bit_cast(float, __builtin_amdgcn_readlane(__builtin_bit_cast(int, v), 0)), b = __builtin_bit_cast(float, __builtin_amdgcn_readlane(__builtin_bit_cast(int, v), 16));
    const float c = __builtin_bit_cast(float, __builtin_amdgcn_readlane(__builtin_bit_cast(int, v), 32)), d = __builtin_bit_cast(float, __builtin_amdgcn_readlane(__builtin_bit_cast(int, v), 48));
    return (a + b) + (c + d);
}
__device__ __forceinline__ int crow(int r, int hi) { return (r & 3) + 8 * (r >> 2) + 4 * hi; }

__device__ __forceinline__ void tr_item(const float* W, int ldsrc, int k0, int c0, int cvalid, bf16* WT, int lddst, int r0, int dk0, float scale, LAS float* scr, int lane) {
#pragma unroll 8
    for (int i = 0; i < 32; ++i) { const int kk = 2 * i + (lane >> 5), c = lane & 31;
        scr[kk * 33 + c] = (c < cvalid) ? __builtin_nontemporal_load(W + (size_t)(k0 + kk) * ldsrc + c0 + c) * scale : 0.f; }
    LDS_WAIT(); asm volatile("" ::: "memory");
    const int c8 = lane & 7;
#pragma unroll
    for (int j = 0; j < 4; ++j) { const int n = (lane >> 3) + 8 * j; const LAS float* s = scr + (8 * c8) * 33 + n;
        v4u o; o.x = pk2(s[0 * 33], s[1 * 33]); o.y = pk2(s[2 * 33], s[3 * 33]); o.z = pk2(s[4 * 33], s[5 * 33]); o.w = pk2(s[6 * 33], s[7 * 33]);
        *(v4u*)(WT + (size_t)(r0 + n) * lddst + dk0 + k0 + 8 * c8) = o; }
    LDS_WAIT(); asm volatile("" ::: "memory");
}
__device__ __forceinline__ void tr_job(const float* W, int ldsrc, int K, int cs, int ncols, int nvalid, bf16* WT, int lddst, int r0, int dk0, float scale, int mode,
                                       LAS float* scr, int lane, int gw, int NGW, int& rot) {
    const int ncg = ncols / 32, nitems = (K / 64) * ncg;
    int start = gw - rot; if (start < 0) start += NGW;
    for (int it = start; it < nitems; it += NGW) {
        const int kb = it / ncg, cg_ = it % ncg, crel = 32 * cg_;
        const int cv = nvalid - crel < 0 ? 0 : (nvalid - crel > 32 ? 32 : nvalid - crel);
        const int col = cs + crel;
        const int row = mode == 0 ? r0 + crel : 256 * (col / 128) + 128 * (mode - 1) + (col % 128);
        tr_item(W, ldsrc, 64 * kb, col, cv, WT, lddst, row, dk0, scale, scr, lane);
    }
    rot = (rot + nitems) % NGW;
}

template <bool FINAL> __device__ __forceinline__ void ln_row(bf16* xrow, const float* g, const float* bta, float* orow, int lane) {
    const v4u* xp = (const v4u*)xrow; v4u w[2]; float v[16]; float s = 0.f;
#pragma unroll
    for (int j = 0; j < 2; ++j) { w[j] = xp[lane + 64 * j];
        v[8 * j + 0] = bflo(w[j].x); v[8 * j + 1] = bfhi(w[j].x); v[8 * j + 2] = bflo(w[j].y); v[8 * j + 3] = bfhi(w[j].y);
        v[8 * j + 4] = bflo(w[j].z); v[8 * j + 5] = bfhi(w[j].z); v[8 * j + 6] = bflo(w[j].w); v[8 * j + 7] = bfhi(w[j].w); }
#pragma unroll
    for (int i = 0; i < 16; ++i) s += v[i];
    const float mean = wave_sum(s) * (1.f / DM); float s2 = 0.f;
#pragma unroll
    for (int i = 0; i < 16; ++i) { v[i] -= mean; s2 += v[i] * v[i]; }
    const float rstd = 1.f / sqrtf(wave_sum(s2) * (1.f / DM) + 1e-5f);
#pragma unroll
    for (int j = 0; j < 2; ++j) { const int c0 = 8 * (lane + 64 * j);
        const f32x4 g0 = *(const f32x4*)(g + c0), g1 = *(const f32x4*)(g + c0 + 4), b0 = *(const f32x4*)(bta + c0), b1 = *(const f32x4*)(bta + c0 + 4);
        float r[8];
#pragma unroll
        for (int i = 0; i < 4; ++i) { r[i] = v[8 * j + i] * rstd * g0[i] + b0[i]; r[4 + i] = v[8 * j + 4 + i] * rstd * g1[i] + b1[i]; }
        if (FINAL) { __builtin_nontemporal_store((f32x4){r[0], r[1], r[2], r[3]}, (f32x4*)(orow + c0)); __builtin_nontemporal_store((f32x4){r[4], r[5], r[6], r[7]}, (f32x4*)(orow + c0 + 4)); }
        else { v4u o; o.x = pk2(r[0], r[1]); o.y = pk2(r[2], r[3]); o.z = pk2(r[4], r[5]); o.w = pk2(r[6], r[7]); ((v4u*)xrow)[lane + 64 * j] = o; } }
}

__device__ __forceinline__ void stick_unit(const bf16* QKV, bf16* OCAT, int b, int h, int qt, int lane) {
    const int r32 = lane & 31, hi = lane >> 5, q0 = qt * 32, t = q0 + r32; const size_t rowb = (size_t)b * SEQ;
    bf16x8 qf[4];
    { const bf16* qp = QKV + (rowb + q0 + r32) * NQ0 + C_QB + h * 64 + hi * 8;
#pragma unroll
      for (int ks = 0; ks < 4; ++ks) qf[ks] = *(const bf16x8*)(qp + ks * 16); }
    f32x16 o0 = f32x16{}, o1 = f32x16{}; float carry = 0.f;
    for (int kt = qt; kt >= 0; --kt) {
        const int kb = kt * 32;
        const bf16* kp = QKV + (rowb + kb + r32) * NQ0 + C_KB + h * 64 + hi * 8;
        f32x16 z = f32x16{};
#pragma unroll
        for (int ks = 0; ks < 4; ++ks) { const bf16x8 kf = *(const bf16x8*)(kp + ks * 16); z = __builtin_amdgcn_mfma_f32_32x32x16_bf16(kf, qf[ks], z, 0, 0, 0); }
        bf16x8 vf[2][2];
        { const bf16* vp = QKV + (rowb + kb + 4 * hi) * NQ0 + C_VB + h * 64 + r32;
#pragma unroll
          for (int s = 0; s < 2; ++s)
#pragma unroll
            for (int dh = 0; dh < 2; ++dh)
#pragma unroll
              for (int j = 0; j < 8; ++j) vf[s][dh][j] = (short)vp[(size_t)(16 * s + 8 * (j >> 2) + (j & 3)) * NQ0 + 32 * dh]; }
        float l1m[16], L2v[16];
#pragma unroll
        for (int r = 0; r < 16; ++r) { const float zz = z[r], e = __builtin_amdgcn_exp2f(-__builtin_fabsf(zz)), lg = __builtin_amdgcn_logf(1.0f + e);
            const bool strict = (kb + crow(r, hi)) < t;
            L2v[r] = __builtin_fminf(zz, 0.f) - lg;
            l1m[r] = strict ? -(__builtin_fmaxf(zz, 0.f) + lg) : 0.f; }
        float gs[4], ps[4];
#pragma unroll
        for (int j = 0; j < 4; ++j) { gs[j] = (l1m[4 * j] + l1m[4 * j + 1]) + (l1m[4 * j + 2] + l1m[4 * j + 3]);
            auto sw = __builtin_amdgcn_permlane32_swap(__float_as_uint(gs[j]), __float_as_uint(gs[j]), false, false); ps[j] = __uint_as_float(hi ? sw[0] : sw[1]); }
        float a[16]; float above = carry;
#pragma unroll
        for (int j = 3; j >= 0; --j) {
            float rem = above + (hi == 0 ? ps[j] : 0.f);
#pragma unroll
            for (int i = 3; i >= 0; --i) { const int r = 4 * j + i; const bool strict = (kb + crow(r, hi)) < t;
                a[r] = strict ? __builtin_amdgcn_exp2f(L2v[r] + rem) : 0.f; rem += l1m[r]; }
            above += gs[j] + ps[j]; }
        carry = above;
        bf16x8 pa0, pa1;
#pragma unroll
        for (int j = 0; j < 8; ++j) { pa0[j] = (short)f2bf(a[j]); pa1[j] = (short)f2bf(a[8 + j]); }
        o0 = __builtin_amdgcn_mfma_f32_32x32x16_bf16(pa0, vf[0][0], o0, 0, 0, 0); o1 = __builtin_amdgcn_mfma_f32_32x32x16_bf16(pa0, vf[0][1], o1, 0, 0, 0);
        o0 = __builtin_amdgcn_mfma_f32_32x32x16_bf16(pa1, vf[1][0], o0, 0, 0, 0); o1 = __builtin_amdgcn_mfma_f32_32x32x16_bf16(pa1, vf[1][1], o1, 0, 0, 0);
        if (kt > 0 && __all(carry < -48.f)) break;
    }
    bf16* op = OCAT + (rowb + q0) * KO0 + 512 + h * 64 + r32;
#pragma unroll
    for (int r = 0; r < 16; ++r) { op[(size_t)crow(r, hi) * KO0] = (bf16)f2bf(o0[r]); op[(size_t)crow(r, hi) * KO0 + 32] = (bf16)f2bf(o1[r]); }
}

constexpr int IX_HIST = 0, IX_HSTRIDE = 513;
constexpr int IX_STAGE = 0, IX_SROW = 272, IX_SBYTES = 32 * IX_SROW;
#ifndef DSA_RL
#define DSA_RL 96u
#endif
constexpr int IX_CAP = 640;
constexpr int IX_CU = 0;
constexpr int IX_CK = IX_CU + 32 * IX_CAP * 4;
constexpr int IX_MASK = IX_CK + 32 * IX_CAP * 2;
constexpr int IX_ST = IX_MASK + 16384;
constexpr int IX_SEL = IX_ST + 2048;
constexpr int IX_SELSTRIDE = 256;
constexpr int IX_END = IX_SEL + 16384;
constexpr int IX_QL = NWAVES * IX_SBYTES;
static_assert(IX_QL + 65536 <= IX_ST && 32 * IX_HSTRIDE * 4 <= IX_MASK && IX_END <= LDS_BYTES - 64, "indexer LDS map");
enum { ST_LO = 0, ST_HI = 1, ST_NEED = 2, ST_MODE = 3, ST_TGE = 4, ST_TEQ = 5, ST_TI = 6, ST_ILO = 7, ST_IHI = 8, ST_NSEL = 9, ST_BSTAR = 10, ST_CCNT = 11 };

struct IdxTile { float v[16]; };
__device__ __forceinline__ void idx_load(const bf16* KIDXC, size_t rowb, int kt, int r32, int hi, bf16x8 (&kf)[4]) {
    const bf16* kp = KIDXC + (rowb + 32 * kt + r32) * 64 + hi * 8;
#pragma unroll
    for (int ks = 0; ks < 4; ++ks) kf[ks] = *(const bf16x8*)(kp + ks * 16);
}
__device__ __forceinline__ void idx_comp(const bf16x8 (&kf)[4], const bf16x8 (&qf)[4][4], const float (&w)[4], float (&v)[16]) {
#pragma unroll
    for (int r = 0; r < 16; ++r) v[r] = 0.f;
#pragma unroll
    for (int hd = 0; hd < 4; ++hd) { f32x16 d = f32x16{};
#pragma unroll
        for (int ks = 0; ks < 4; ++ks) d = __builtin_amdgcn_mfma_f32_32x32x16_bf16(kf[ks], qf[hd][ks], d, 0, 0, 0);
#pragma unroll
        for (int r = 0; r < 16; ++r) v[r] = __builtin_fmaf(w[hd], __builtin_fmaxf(d[r], 0.f), v[r]);
        }
}
#define IDX_TILE_LOOP_BEGIN() bf16x8 kfn[4]; if (wave <= qt) idx_load(KIDXC, rowb, wave, r32, hi, kfn); \
    _Pragma("unroll 1") for (int kt = wave; kt <= qt; kt += NWAVES) { bf16x8 kfc[4]; \
        _Pragma("unroll") for (int ks_ = 0; ks_ < 4; ++ks_) kfc[ks_] = kfn[ks_]; \
        if (kt + NWAVES <= qt) idx_load(KIDXC, rowb, kt + NWAVES, r32, hi, kfn); \
        float v[16]; idx_comp(kfc, qf, w, v);
__device__ __forceinline__ unsigned okey(float v) {
    unsigned b = __float_as_uint(v); if ((b << 1) == 0u) b = 0u;
    return b ^ ((unsigned)((int)b >> 31) | 0x80000000u);
}
__device__ __forceinline__ unsigned wave_sum_u32(unsigned x) {
    x += (unsigned)__builtin_amdgcn_update_dpp(0, (int)x, 0xB1, 0xf, 0xf, false);
    x += (unsigned)__builtin_amdgcn_update_dpp(0, (int)x, 0x4E, 0xf, 0xf, false);
    x += (unsigned)__builtin_amdgcn_update_dpp(0, (int)x, 0x124, 0xf, 0xf, false);
    x += (unsigned)__builtin_amdgcn_update_dpp(0, (int)x, 0x128, 0xf, 0xf, false);
    return (unsigned)__builtin_amdgcn_readlane((int)x, 0) + (unsigned)__builtin_amdgcn_readlane((int)x, 16) + (unsigned)__builtin_amdgcn_readlane((int)x, 32) + (unsigned)__builtin_amdgcn_readlane((int)x, 48);
}
__device__ __forceinline__ unsigned row_scan_u32(unsigned x) {
    x += (unsigned)__builtin_amdgcn_update_dpp(0, (int)x, 0x111, 0xf, 0xf, false);
    x += (unsigned)__builtin_amdgcn_update_dpp(0, (int)x, 0x112, 0xf, 0xf, false);
    x += (unsigned)__builtin_amdgcn_update_dpp(0, (int)x, 0x114, 0xf, 0xf, false);
    x += (unsigned)__builtin_amdgcn_update_dpp(0, (int)x, 0x118, 0xf, 0xf, false);
    return x;
}
__device__ __forceinline__ unsigned wave_scan_u32(unsigned x, int lane) {
    x = row_scan_u32(x);
    const unsigned t0 = (unsigned)__builtin_amdgcn_readlane((int)x, 15), t1 = (unsigned)__builtin_amdgcn_readlane((int)x, 31), t2 = (unsigned)__builtin_amdgcn_readlane((int)x, 47); const int row = lane >> 4;
    return x + (row >= 1 ? t0 : 0u) + (row >= 2 ? t1 : 0u) + (row >= 3 ? t2 : 0u);
}
__device__ __forceinline__ unsigned cbin(float v, int key) {
    const unsigned b = __float_as_uint(v), a = b & 0x7fffffffu; const unsigned A0 = 107u << 23, A0n = 111u << 23, A1 = (139u << 23) - 1u;
    const unsigned kp = ((a < A0 ? A0 : (a > A1 ? A1 : a)) - A0) >> 19, kn = ((a < A0n ? A0n : (a > A1 ? A1 : a)) - A0n) >> 19;
    const unsigned nz = ((int)b < 0) ? 447u - kn : 512u + kp;
    return a == 0u ? 448u + (63u - ((unsigned)key >> 6)) : nz;
}
__device__ __forceinline__ float cbin_edge(unsigned bin) {
    const unsigned A0 = 107u << 23, A0n = 111u << 23;
    if (bin >= 1024u) return INFINITY;
    if (bin >= 512u) { const unsigned kp = bin - 512u; return kp == 0u ? __uint_as_float(1u) : __uint_as_float(A0 + (kp << 19)); }
    if (bin >= 448u) return __uint_as_float(1u);
    const unsigned kn = 447u - bin; if (kn >= 447u) return -INFINITY;
    return -__uint_as_float(A0n + ((kn + 1u) << 19) - 1u);
}
__device__ __forceinline__ int range_shift(unsigned span) {
    const int bits = 32 - __builtin_clz(span | 1u); return bits > 10 ? bits - 10 : 0;
}

__device__ __forceinline__ void dsa_unit(const bf16* QKV, const bf16* KIDXC, const bf16* CKVN, const bf16* WUKT, const bf16* WUVT, bf16* OCAT, int b, int qt, LAS unsigned char* lds, int tid, int wave, int lane, bool do_att, int secs, unsigned long long& pacc) {
    asm volatile("" : "+v"(tid)); lane = tid & 63;
#ifdef DSA_TSEC
    unsigned long long tprev_ = __builtin_amdgcn_s_memrealtime();
#define TS(k) do { const unsigned long long now_ = __builtin_amdgcn_s_memrealtime(); if ((k) == DSA_TSEC || DSA_TSEC == 9) pacc += now_ - tprev_; tprev_ = now_; } while (0)
#else
#define TS(k) do { } while (0)
#endif
    const int r32 = lane & 31, hi = lane >> 5, q0 = qt * 32, t = q0 + r32; const size_t rowb = (size_t)b * SEQ;
    LAS unsigned* HIST = (LAS unsigned*)(lds + IX_HIST); LAS unsigned* MASK = (LAS unsigned*)(lds + IX_MASK);
    LAS unsigned short* SEL = (LAS unsigned short*)(lds + IX_SEL); LAS unsigned* ST = (LAS unsigned*)(lds + IX_ST);
    LAS unsigned* CU = (LAS unsigned*)(lds + IX_CU); LAS unsigned short* CK = (LAS unsigned short*)(lds + IX_CK);
#define LOAD_QF() bf16x8 qf[4][4]; float w[4]; \
    { const bf16* qp = QKV + (rowb + t) * NQ0; \
      _Pragma("unroll") for (int hd = 0; hd < 4; ++hd) { w[hd] = bf1(qp[C_WIDX + hd]); \
        _Pragma("unroll") for (int ks = 0; ks < 4; ++ks) qf[hd][ks] = *(const bf16x8*)(qp + C_QIDX + hd * 64 + ks * 16 + hi * 8); } }
    const bool select_all = (q0 + 32 <= TOPK);
    bool need_generic = false;
    if (select_all) {
        for (int i = tid; i < 32 * (qt + 1); i += NTHR) { const int q = i / (qt + 1), wd = i % (qt + 1); const int nb = (q0 + q) - 32 * wd + 1;
            MASK[q * 128 + wd] = nb >= 32 ? 0xffffffffu : (nb <= 0 ? 0u : ((1u << nb) - 1u)); }
    } else {
        for (int i = tid; i < 32 * IX_HSTRIDE; i += NTHR) HIST[i] = 0u;
        for (int i = tid; i < 32 * (qt + 1); i += NTHR) MASK[(i / (qt + 1)) * 128 + (i % (qt + 1))] = 0u;
        if (tid < 32) ST[tid * 16 + ST_CCNT] = 0u;
        __syncthreads();
        if (secs & 1) { LOAD_QF();
          _Pragma("unroll 1") for (int kt = 4 * wave; kt <= qt; kt += 4 * NWAVES) { bf16x8 kfc[4]; idx_load(KIDXC, rowb, kt, r32, hi, kfc);
              float v[16]; idx_comp(kfc, qf, w, v);
#pragma unroll
              for (int r = 0; r < 16; ++r) { const int key = 32 * kt + crow(r, hi); const unsigned bin = cbin(v[r], key);
                  if (key <= t) __hip_atomic_fetch_add(HIST + r32 * IX_HSTRIDE + (bin >> 1), (bin & 1u) ? 0x10000u : 1u, __ATOMIC_RELAXED, __HIP_MEMORY_SCOPE_WORKGROUP); }
          } }
        __syncthreads(); TS(1);
        { const int q = tid >> 4, sub = tid & 15; LAS unsigned* s = ST + q * 16;
          const LAS unsigned* hq = HIST + q * IX_HSTRIDE + sub * 32; unsigned csum = 0;
#pragma unroll 8
          for (int i = 0; i < 32; ++i) { const unsigned x = hq[i]; csum += (x & 0xffffu) + (x >> 16); }
          const unsigned incl = row_scan_u32(csum);
          const unsigned total = __shfl(incl, 15, 16); const unsigned sufx = total - incl, need = DSA_RL;
          const bool isf = (total >= need) && (sufx < need) && (need <= sufx + csum);
          const unsigned long long fm = __ballot(isf); const unsigned rowbits = (unsigned)(fm >> (16 * (lane >> 4))) & 0xffffu;
          if (total < need) { if (sub == 0) s[ST_BSTAR] = 0u; }
          else { const int f = __builtin_ctz(rowbits | 0x10000u);
              const unsigned base = __shfl(sufx, f, 16);
              const LAS unsigned* hf = HIST + q * IX_HSTRIDE + f * 32 + (30 - 2 * sub);
              const unsigned x1 = hf[1], x0 = hf[0]; const unsigned c3 = x1 >> 16, c2 = x1 & 0xffffu, c1 = x0 >> 16, c0 = x0 & 0xffffu;
              const unsigned s4 = (c3 + c2) + (c1 + c0); const unsigned in4 = row_scan_u32(s4); const unsigned above = base + in4 - s4;
              if (above < need && need <= above + s4) { int bsel = 60 - 4 * sub; unsigned cum = above;
                  if (cum + c3 >= need) bsel += 3; else { cum += c3; if (cum + c2 >= need) bsel += 2; else { cum += c2; if (cum + c1 >= need) bsel += 1; } }
                  s[ST_BSTAR] = (unsigned)(f * 64 + bsel); } } }
        __syncthreads(); TS(2);
        if (secs & 2) { const unsigned lbin = ST[r32 * 16 + ST_BSTAR]; const float thL = cbin_edge(lbin);
          LOAD_QF();
          IDX_TILE_LOOP_BEGIN() unsigned flags = 0u;
              const bool zc = (448u + (63u - ((unsigned)kt >> 1))) >= lbin; const int lim = (kt == qt) ? t : 0x7fffffff;
#pragma unroll
              for (int r = 0; r < 16; ++r) { const int key = 32 * kt + crow(r, hi); const float x = v[r]; flags |= (key <= lim && (x == 0.f ? zc : x >= thL)) ? (1u << r) : 0u; }
              const unsigned cnt = (unsigned)__builtin_popcount(flags);
              unsigned pos = 0u; if (cnt) pos = __hip_atomic_fetch_add(ST + r32 * 16 + ST_CCNT, cnt, __ATOMIC_RELAXED, __HIP_MEMORY_SCOPE_WORKGROUP);
#pragma unroll
              for (int r = 0; r < 16; ++r) { if ((flags >> r) & 1u) { if (pos < (unsigned)IX_CAP) { CU[r32 * IX_CAP + pos] = __float_as_uint(v[r]); CK[r32 * IX_CAP + pos] = (unsigned short)(32 * kt + crow(r, hi)); } ++pos; } }
          } }
        __syncthreads(); TS(3);
        { bool bad = false;
#pragma unroll 4
          for (int q = 0; q < 32; ++q) { const unsigned c = ST[q * 16 + ST_CCNT]; bad = bad || (c > (unsigned)IX_CAP) || (c < (unsigned)TOPK); }
#ifdef DSA_NO_FALLBACK
          need_generic = false; (void)bad; }
#else
          need_generic = bad; }
#endif
        if (!need_generic && (secs & 4)) {
            int cmax = 0;
#pragma unroll
            for (int qq = 0; qq < 4; ++qq) { const int C = (int)ST[(wave * 4 + qq) * 16 + ST_CCNT]; cmax = C > cmax ? C : cmax; }
#define DSA_SELECT(NR) do { unsigned u[4][NR], k[4][NR]; \
            _Pragma("unroll") for (int qq = 0; qq < 4; ++qq) { const int q = wave * 4 + qq; const int C = (int)ST[q * 16 + ST_CCNT]; \
                _Pragma("unroll") for (int i = 0; i < NR; ++i) { const int idx = lane + 64 * i; const bool ok = idx < C; u[qq][i] = ok ? okey(__uint_as_float(CU[q * IX_CAP + idx])) : 0u; k[qq][i] = ok ? (unsigned)CK[q * IX_CAP + idx] : 0xffffu; } } \
            unsigned T0 = 0u, T1 = 0u, T2 = 0u, T3 = 0u; \
            for (int bit = 31; bit >= 0; --bit) { const unsigned c0 = T0 | (1u << bit), c1 = T1 | (1u << bit), c2 = T2 | (1u << bit), c3 = T3 | (1u << bit); unsigned n01 = 0u, n23 = 0u; \
                _Pragma("unroll") for (int i = 0; i < NR; ++i) { n01 += (u[0][i] >= c0 ? 1u : 0u) + (u[1][i] >= c1 ? 0x10000u : 0u); n23 += (u[2][i] >= c2 ? 1u : 0u) + (u[3][i] >= c3 ? 0x10000u : 0u); } \
                n01 = wave_sum_u32(n01); n23 = wave_sum_u32(n23); \
                if ((n01 & 0xffffu) >= (unsigned)TOPK) T0 = c0; if ((n01 >> 16) >= (unsigned)TOPK) T1 = c1; if ((n23 & 0xffffu) >= (unsigned)TOPK) T2 = c2; if ((n23 >> 16) >= (unsigned)TOPK) T3 = c3; } \
            _Pragma("unroll") for (int qq = 0; qq < 4; ++qq) { const int q = wave * 4 + qq; const unsigned T = qq == 0 ? T0 : qq == 1 ? T1 : qq == 2 ? T2 : T3; unsigned ng = 0u; \
                _Pragma("unroll") for (int i = 0; i < NR; ++i) ng += (u[qq][i] > T ? 1u : 0u) + (u[qq][i] == T ? 0x10000u : 0u); \
                ng = wave_sum_u32(ng); \
                const int needt = TOPK - (int)(ng & 0xffffu), ceq = (int)(ng >> 16); unsigned Kth = 0xffffu; \
                if (ceq != needt) { Kth = 0u;                     \
                    for (int bit = 11; bit >= 0; --bit) { const unsigned cand = Kth | (1u << bit); unsigned c = 0u; \
                        _Pragma("unroll") for (int i = 0; i < NR; ++i) c += (u[qq][i] == T && k[qq][i] < cand) ? 1u : 0u; \
                        c = wave_sum_u32(c); \
                        if ((int)c < needt) Kth = cand; } } \
                _Pragma("unroll") for (int i = 0; i < NR; ++i) { if (u[qq][i] > T || (u[qq][i] == T && k[qq][i] <= Kth && u[qq][i] != 0u)) \
                        __hip_atomic_fetch_or(MASK + q * 128 + (k[qq][i] >> 5), 1u << (k[qq][i] & 31u), __ATOMIC_RELAXED, __HIP_MEMORY_SCOPE_WORKGROUP); } \
            } } while (0)
            if (cmax <= 448) DSA_SELECT(7); else DSA_SELECT(10);
#undef DSA_SELECT
        }
    }
    if (need_generic) {
        __syncthreads();
    if (tid < 32) { LAS unsigned* s = ST + tid * 16;
        unsigned z_ = 0u; asm volatile("" : "+v"(z_));
        s[ST_LO] = z_; s[ST_HI] = ~z_; s[ST_NEED] = z_ + TOPK; s[ST_MODE] = z_; s[ST_TGE] = z_; s[ST_TEQ] = z_; s[ST_TI] = z_ + 0xffffu; s[ST_ILO] = z_; s[ST_IHI] = (unsigned)(q0 + tid); }
    __syncthreads();
    for (int pass = 0; pass < 12; ++pass) {
        bool alldone = true;
#pragma unroll 4
        for (int q = 0; q < 32; ++q) alldone = alldone && (ST[q * 16 + ST_MODE] == 2u);
        if (alldone) break;
        for (int i = tid; i < 32 * IX_HSTRIDE; i += NTHR) HIST[i] = 0u;
        const unsigned mode = ST[r32 * 16 + ST_MODE], lo = ST[r32 * 16 + ST_LO], hi_u = ST[r32 * 16 + ST_HI], ilo = ST[r32 * 16 + ST_ILO], ihi = ST[r32 * 16 + ST_IHI];
        const bool usek = (mode == 1u); const unsigned ulo = lo, uspan = (mode == 0u) ? hi_u - lo : 0u, klo = (mode == 2u) ? 0xffffffffu : (usek ? ilo : 0u), kspan = usek ? ihi - ilo : ((mode == 2u) ? 0u : 0xffffffffu);
        const int bsh = usek ? range_shift(ihi - ilo) : range_shift(hi_u - lo);
        __syncthreads();
        { LOAD_QF();
        IDX_TILE_LOOP_BEGIN()
#pragma unroll
            for (int r = 0; r < 16; ++r) { const unsigned key = (unsigned)(32 * kt + crow(r, hi)); const unsigned u = okey(v[r]);
                const unsigned du = u - ulo, dk = key - klo; const bool hit = (du <= uspan) && (dk <= kspan) && ((int)key <= t);
                const unsigned bin = (usek ? dk : du) >> bsh;
                if (hit) __hip_atomic_fetch_add(HIST + r32 * IX_HSTRIDE + (bin >> 1), (bin & 1u) ? 0x10000u : 1u, __ATOMIC_RELAXED, __HIP_MEMORY_SCOPE_WORKGROUP); }
        } }
        __syncthreads();
        { const int q = tid >> 4, sub = tid & 15; LAS unsigned* s = ST + q * 16; const unsigned md = s[ST_MODE];
          const LAS unsigned* hq = HIST + q * IX_HSTRIDE + sub * 32; unsigned csum = 0;
#pragma unroll 8
          for (int i = 0; i < 32; ++i) { const unsigned x = hq[i]; csum += (x & 0xffffu) + (x >> 16); }
          unsigned incl = csum;
#pragma unroll
          for (int o = 1; o < 16; o <<= 1) { const unsigned y = __shfl_up(incl, o, 16); if (sub >= o) incl += y; }
          const unsigned total = __shfl(incl, 15, 16);
          const unsigned need = s[ST_NEED];
          if (md == 0u) {
              const unsigned sufx = total - incl;
              if (sufx < need && need <= sufx + csum) {
                  const unsigned lo_ = s[ST_LO], hi_ = s[ST_HI]; const int sh_ = range_shift(hi_ - lo_);
                  unsigned cum = sufx; int bsel = 0; unsigned cb = 0;
                  for (int bn = 63; bn >= 0; --bn) { const unsigned x = hq[bn >> 1]; const unsigned c = (bn & 1) ? (x >> 16) : (x & 0xffffu);
                      if (cum + c >= need) { bsel = bn; cb = c; break; } cum += c; }
                  const unsigned bglob = (unsigned)(sub * 64 + bsel); const unsigned nlo = lo_ + (bglob << sh_); const unsigned wdt = (sh_ >= 32) ? 0xffffffffu : ((1u << sh_) - 1u);
                  const unsigned nhi = (hi_ - nlo < wdt) ? hi_ : nlo + wdt; const unsigned nneed = need - cum;
                  s[ST_LO] = nlo; s[ST_HI] = nhi; s[ST_NEED] = nneed;
                  if (cb == nneed) { s[ST_TGE] = nlo; s[ST_TEQ] = 0u; s[ST_TI] = 0xffffu; s[ST_MODE] = 2u; }
                  else if (nlo == nhi) { s[ST_MODE] = 1u; }
              }
          } else if (md == 1u) {
              const unsigned prefx = incl - csum;
              if (prefx < need && need <= prefx + csum) {
                  const unsigned ilo_ = s[ST_ILO], ihi_ = s[ST_IHI]; const int ish_ = range_shift(ihi_ - ilo_);
                  unsigned cum = prefx; int bsel = 0; unsigned cb = 0;
                  for (int bn = 0; bn < 64; ++bn) { const unsigned x = hq[bn >> 1]; const unsigned c = (bn & 1) ? (x >> 16) : (x & 0xffffu);
                      if (cum + c >= need) { bsel = bn; cb = c; break; } cum += c; }
                  const unsigned bglob = (unsigned)(sub * 64 + bsel); const unsigned nilo = ilo_ + (bglob << ish_); const unsigned wdt = (1u << ish_) - 1u;
                  const unsigned nihi = (ihi_ - nilo < wdt) ? ihi_ : nilo + wdt; const unsigned nneed = need - cum;
                  s[ST_ILO] = nilo; s[ST_IHI] = nihi; s[ST_NEED] = nneed;
                  if (cb == nneed || nilo == nihi) { s[ST_TGE] = s[ST_LO]; s[ST_TEQ] = s[ST_LO]; s[ST_TI] = nihi; s[ST_MODE] = 2u; }
              }
          } }
        __syncthreads();
    }
    { const unsigned tge = ST[r32 * 16 + ST_TGE], teq = ST[r32 * 16 + ST_TEQ], ti = ST[r32 * 16 + ST_TI]; const bool tie = (ti != 0xffffu);
      LOAD_QF();
      IDX_TILE_LOOP_BEGIN() unsigned bits = 0u;
#pragma unroll
          for (int r = 0; r < 16; ++r) { const int key = 32 * kt + crow(r, hi); const unsigned u = okey(v[r]);
              const bool sel = (key <= t) && (u >= tge) && !(tie && u == teq && (unsigned)key > ti);
              bits |= sel ? (1u << crow(r, hi)) : 0u; }
          bits |= __shfl_xor(bits, 32);
          if (hi == 0) MASK[r32 * 128 + kt] = bits; } }
    }
    __syncthreads(); TS(4);
    if (secs & 8) {
        const int w0i = 2 * lane, w1i = 2 * lane + 1; unsigned m0[4], m1[4], cn[4];
#pragma unroll
        for (int qq = 0; qq < 4; ++qq) { const int q = wave * 4 + qq; m0[qq] = (w0i <= qt) ? MASK[q * 128 + w0i] : 0u; m1[qq] = (w1i <= qt) ? MASK[q * 128 + w1i] : 0u;
            cn[qq] = (unsigned)(__builtin_popcount(m0[qq]) + __builtin_popcount(m1[qq])); }
        const unsigned s01 = wave_scan_u32(cn[0] | (cn[1] << 16), lane), s23 = wave_scan_u32(cn[2] | (cn[3] << 16), lane);
        const unsigned tot01 = (unsigned)__builtin_amdgcn_readlane((int)s01, 63), tot23 = (unsigned)__builtin_amdgcn_readlane((int)s23, 63);
#pragma unroll
        for (int qq = 0; qq < 4; ++qq) { const int q = wave * 4 + qq; const unsigned inc = (qq == 0 ? s01 & 0xffffu : qq == 1 ? s01 >> 16 : qq == 2 ? s23 & 0xffffu : s23 >> 16);
            int pos = (int)(inc - cn[qq]); unsigned a0 = m0[qq], a1 = m1[qq];
            while (a0) { const int bpos = __builtin_ctz(a0); a0 &= a0 - 1u; if (pos < TOPK) SEL[q * IX_SELSTRIDE + pos] = (unsigned short)(64 * lane + bpos); ++pos; }
            while (a1) { const int bpos = __builtin_ctz(a1); a1 &= a1 - 1u; if (pos < TOPK) SEL[q * IX_SELSTRIDE + pos] = (unsigned short)(64 * lane + 32 + bpos); ++pos; }
            const unsigned total = (qq == 0 ? tot01 & 0xffffu : qq == 1 ? tot01 >> 16 : qq == 2 ? tot23 & 0xffffu : tot23 >> 16);
            if (lane == 0) ST[q * 16 + ST_NSEL] = total < (unsigned)TOPK ? total : (unsigned)TOPK; } }
    __syncthreads(); TS(5);
    LAS unsigned char* QLb = lds + IX_QL;
    if (do_att) { bf16x8 qb_[4];
      { const bf16* qa = QKV + (rowb + q0 + r32) * NQ0 + C_QA + wave * 64 + hi * 8;
#pragma unroll
        for (int ks = 0; ks < 4; ++ks) qb_[ks] = *(const bf16x8*)(qa + 16 * ks); }
#pragma unroll
      for (int nt = 0; nt < 4; ++nt) { f32x16 d = f32x16{}; const bf16* wp = WUKT + ((size_t)wave * 128 + 32 * nt + r32) * 64 + hi * 8;
#pragma unroll
          for (int ks = 0; ks < 4; ++ks) d = __builtin_amdgcn_mfma_f32_32x32x16_bf16(*(const bf16x8*)(wp + 16 * ks), qb_[ks], d, 0, 0, 0);
#pragma unroll
          for (int j = 0; j < 4; ++j) { v2u wv; wv.x = pk2(d[4 * j], d[4 * j + 1]); wv.y = pk2(d[4 * j + 2], d[4 * j + 3]);
              *(LAS v2u*)(QLb + ((size_t)r32 * 1024 + wave * 128 + 32 * nt + 8 * j + 4 * hi) * 2) = wv; } } }
    __syncthreads(); TS(6);
    if (do_att) { const int c = lane & 15, g = lane >> 4;
      LAS unsigned char* stg = lds + IX_STAGE + wave * IX_SBYTES;
      const float slope2 = (c < 8) ? LOG2E * __builtin_amdgcn_exp2f(-(float)(c + 1)) : 0.f;
      for (int qi = 0; qi < 4; ++qi) { const int q = wave * 4 + qi, tq = q0 + q; const size_t mrow = rowb + tq;
          const int nsel = (int)ST[q * 16 + ST_NSEL]; const int nsteps = (nsel + 31) >> 5;
          bf16x8 ql[4];
#pragma unroll
          for (int ks = 0; ks < 4; ++ks) { ql[ks] = bf16x8{}; if (c < 8) ql[ks] = *(const LAS bf16x8*)(QLb + ((size_t)q * 1024 + c * 128 + 32 * ks + 8 * g) * 2); }
          float mrun = -INFINITY, lrun = 0.f; f32x4 o[8];
#pragma unroll
          for (int dt = 0; dt < 8; ++dt) o[dt] = f32x4{};
          v4u rvA[8], rvB[8], rvC[8];
          {
#pragma unroll
            for (int i = 0; i < 8; ++i) { const int j = 32 * (0) + 4 * i + g; const int key = (j < nsel) ? (int)SEL[q * IX_SELSTRIDE + j] : 0;
                rvA[i] = *(const v4u*)(CKVN + (rowb + key) * 128 + c * 8); }
            if (nsteps > 1) {
#pragma unroll
            for (int i = 0; i < 8; ++i) { const int j = 32 * (1) + 4 * i + g; const int key = (j < nsel) ? (int)SEL[q * IX_SELSTRIDE + j] : 0;
                rvB[i] = *(const v4u*)(CKVN + (rowb + key) * 128 + c * 8); }
            }
            if (nsteps > 2) {
#pragma unroll
            for (int i = 0; i < 8; ++i) { const int j = 32 * (2) + 4 * i + g; const int key = (j < nsel) ? (int)SEL[q * IX_SELSTRIDE + j] : 0;
                rvC[i] = *(const v4u*)(CKVN + (rowb + key) * 128 + c * 8); }
            } }
          for (int st = 0; st < nsteps; st += 3) {
              {
#pragma unroll
              for (int i = 0; i < 8; ++i) *(LAS v4u*)(stg + (4 * i + g) * IX_SROW + c * 16) = rvA[i];
              if (st + 3 < nsteps) {
#pragma unroll
                  for (int i = 0; i < 8; ++i) { const int j = 32 * (st + 3) + 4 * i + g; const int key = (j < nsel) ? (int)SEL[q * IX_SELSTRIDE + j] : 0;
                      rvA[i] = *(const v4u*)(CKVN + (rowb + key) * 128 + c * 8); } }
              float sc[8];
              { const LAS unsigned short* sp = SEL + q * IX_SELSTRIDE + 32 * (st) + 4 * g;
                f32x4 sa = f32x4{}, sb = f32x4{};
#pragma unroll
                for (int ks = 0; ks < 4; ++ks) { const bf16x8 ka = *(const LAS bf16x8*)(stg + c * IX_SROW + (32 * ks + 8 * g) * 2), kb2 = *(const LAS bf16x8*)(stg + (16 + c) * IX_SROW + (32 * ks + 8 * g) * 2);
                    sa = __builtin_amdgcn_mfma_f32_16x16x32_bf16(ka, ql[ks], sa, 0, 0, 0); sb = __builtin_amdgcn_mfma_f32_16x16x32_bf16(kb2, ql[ks], sb, 0, 0, 0); }
#pragma unroll
                for (int jj = 0; jj < 8; ++jj) { const int li = (jj < 4) ? jj : 12 + jj; const int j = 32 * (st) + 4 * g + li;
                    const float raw = (jj < 4) ? sa[jj] : sb[jj - 4]; const float dist = (float)(tq - (int)sp[li]);
                    sc[jj] = (j < nsel) ? raw - slope2 * dist : -INFINITY; } }
              float smax = __builtin_fmaxf(__builtin_fmaxf(__builtin_fmaxf(sc[0], sc[1]), __builtin_fmaxf(sc[2], sc[3])), __builtin_fmaxf(__builtin_fmaxf(sc[4], sc[5]), __builtin_fmaxf(sc[6], sc[7])));
              { auto r16 = __builtin_amdgcn_permlane16_swap(__float_as_uint(smax), __float_as_uint(smax), false, false); smax = __builtin_fmaxf(__uint_as_float(r16[0]), __uint_as_float(r16[1]));
                auto r32_ = __builtin_amdgcn_permlane32_swap(__float_as_uint(smax), __float_as_uint(smax), false, false); smax = __builtin_fmaxf(__uint_as_float(r32_[0]), __uint_as_float(r32_[1])); }
              const float mnew = __builtin_fmaxf(mrun, smax); const float alpha = __builtin_amdgcn_exp2f(mrun - mnew); mrun = mnew;
              bf16x8 pb; float psum = 0.f;
              { float p[8];
#pragma unroll
                for (int jj = 0; jj < 8; ++jj) { p[jj] = __builtin_amdgcn_exp2f(sc[jj] - mnew); psum += p[jj]; }
                typedef float f32x2_t __attribute__((ext_vector_type(2))); typedef __bf16 bf16x2_t __attribute__((ext_vector_type(2)));
#pragma unroll
                for (int jj = 0; jj < 8; jj += 2) { const f32x2_t pv = {p[jj], p[jj + 1]}; const unsigned pk = __builtin_bit_cast(unsigned, __builtin_convertvector(pv, bf16x2_t)); pb[jj] = (short)(pk & 0xffffu); pb[jj + 1] = (short)(pk >> 16); } }
              lrun = lrun * alpha + psum;
              const bool resc = !__all(alpha == 1.0f);
#pragma unroll
              for (int dt = 0; dt < 8; ++dt) { if (resc) o[dt] = o[dt] * alpha;
                  const LAS unsigned char* a0 = stg + (4 * g + (c >> 2)) * IX_SROW + (16 * dt + 4 * (c & 3)) * 2;
                  const s16x4 lo4 = __builtin_bit_cast(s16x4, __builtin_amdgcn_ds_read_tr16_b64_v4i16((LAS s16x4*)a0));
                  const s16x4 hi4 = __builtin_bit_cast(s16x4, __builtin_amdgcn_ds_read_tr16_b64_v4i16((LAS s16x4*)(a0 + 16 * IX_SROW)));
                  const bf16x8 ca = (bf16x8){lo4[0], lo4[1], lo4[2], lo4[3], hi4[0], hi4[1], hi4[2], hi4[3]};
                  o[dt] = __builtin_amdgcn_mfma_f32_16x16x32_bf16(ca, pb, o[dt], 0, 0, 0); }
              LDS_WAIT(); asm volatile("" ::: "memory");
              }
              if (st + 1 < nsteps)
              {
#pragma unroll
              for (int i = 0; i < 8; ++i) *(LAS v4u*)(stg + (4 * i + g) * IX_SROW + c * 16) = rvB[i];
              if (st + 4 < nsteps) {
#pragma unroll
                  for (int i = 0; i < 8; ++i) { const int j = 32 * (st + 4) + 4 * i + g; const int key = (j < nsel) ? (int)SEL[q * IX_SELSTRIDE + j] : 0;
                      rvB[i] = *(const v4u*)(CKVN + (rowb + key) * 128 + c * 8); } }
              float sc[8];
              { const LAS unsigned short* sp = SEL + q * IX_SELSTRIDE + 32 * (st + 1) + 4 * g;
                f32x4 sa = f32x4{}, sb = f32x4{};
#pragma unroll
                for (int ks = 0; ks < 4; ++ks) { const bf16x8 ka = *(const LAS bf16x8*)(stg + c * IX_SROW + (32 * ks + 8 * g) * 2), kb2 = *(const LAS bf16x8*)(stg + (16 + c) * IX_SROW + (32 * ks + 8 * g) * 2);
                    sa = __builtin_amdgcn_mfma_f32_16x16x32_bf16(ka, ql[ks], sa, 0, 0, 0); sb = __builtin_amdgcn_mfma_f32_16x16x32_bf16(kb2, ql[ks], sb, 0, 0, 0); }
#pragma unroll
                for (int jj = 0; jj < 8; ++jj) { const int li = (jj < 4) ? jj : 12 + jj; const int j = 32 * (st + 1) + 4 * g + li;
                    const float raw = (jj < 4) ? sa[jj] : sb[jj - 4]; const float dist = (float)(tq - (int)sp[li]);
                    sc[jj] = (j < nsel) ? raw - slope2 * dist : -INFINITY; } }
              float smax = __builtin_fmaxf(__builtin_fmaxf(__builtin_fmaxf(sc[0], sc[1]), __builtin_fmaxf(sc[2], sc[3])), __builtin_fmaxf(__builtin_fmaxf(sc[4], sc[5]), __builtin_fmaxf(sc[6], sc[7])));
              { auto r16 = __builtin_amdgcn_permlane16_swap(__float_as_uint(smax), __float_as_uint(smax), false, false); smax = __builtin_fmaxf(__uint_as_float(r16[0]), __uint_as_float(r16[1]));
                auto r32_ = __builtin_amdgcn_permlane32_swap(__float_as_uint(smax), __float_as_uint(smax), false, false); smax = __builtin_fmaxf(__uint_as_float(r32_[0]), __uint_as_float(r32_[1])); }
              const float mnew = __builtin_fmaxf(mrun, smax); const float alpha = __builtin_amdgcn_exp2f(mrun - mnew); mrun = mnew;
              bf16x8 pb; float psum = 0.f;
              { float p[8];
#pragma unroll
                for (int jj = 0; jj < 8; ++jj) { p[jj] = __builtin_amdgcn_exp2f(sc[jj] - mnew); psum += p[jj]; }
                typedef float f32x2_t __attribute__((ext_vector_type(2))); typedef __bf16 bf16x2_t __attribute__((ext_vector_type(2)));
#pragma unroll
                for (int jj = 0; jj < 8; jj += 2) { const f32x2_t pv = {p[jj], p[jj + 1]}; const unsigned pk = __builtin_bit_cast(unsigned, __builtin_convertvector(pv, bf16x2_t)); pb[jj] = (short)(pk & 0xffffu); pb[jj + 1] = (short)(pk >> 16); } }
              lrun = lrun * alpha + psum;
              const bool resc = !__all(alpha == 1.0f);
#pragma unroll
              for (int dt = 0; dt < 8; ++dt) { if (resc) o[dt] = o[dt] * alpha;
                  const LAS unsigned char* a0 = stg + (4 * g + (c >> 2)) * IX_SROW + (16 * dt + 4 * (c & 3)) * 2;
                  const s16x4 lo4 = __builtin_bit_cast(s16x4, __builtin_amdgcn_ds_read_tr16_b64_v4i16((LAS s16x4*)a0));
                  const s16x4 hi4 = __builtin_bit_cast(s16x4, __builtin_amdgcn_ds_read_tr16_b64_v4i16((LAS s16x4*)(a0 + 16 * IX_SROW)));
                  const bf16x8 ca = (bf16x8){lo4[0], lo4[1], lo4[2], lo4[3], hi4[0], hi4[1], hi4[2], hi4[3]};
                  o[dt] = __builtin_amdgcn_mfma_f32_16x16x32_bf16(ca, pb, o[dt], 0, 0, 0); }
              LDS_WAIT(); asm volatile("" ::: "memory");
              }
              if (st + 2 < nsteps)
              {
#pragma unroll
              for (int i = 0; i < 8; ++i) *(LAS v4u*)(stg + (4 * i + g) * IX_SROW + c * 16) = rvC[i];
              if (st + 5 < nsteps) {
#pragma unroll
                  for (int i = 0; i < 8; ++i) { const int j = 32 * (st + 5) + 4 * i + g; const int key = (j < nsel) ? (int)SEL[q * IX_SELSTRIDE + j] : 0;
                      rvC[i] = *(const v4u*)(CKVN + (rowb + key) * 128 + c * 8); } }
              float sc[8];
              { const LAS unsigned short* sp = SEL + q * IX_SELSTRIDE + 32 * (st + 2) + 4 * g;
                f32x4 sa = f32x4{}, sb = f32x4{};
#pragma unroll
                for (int ks = 0; ks < 4; ++ks) { const bf16x8 ka = *(const LAS bf16x8*)(stg + c * IX_SROW + (32 * ks + 8 * g) * 2), kb2 = *(const LAS bf16x8*)(stg + (16 + c) * IX_SROW + (32 * ks + 8 * g) * 2);
                    sa = __builtin_amdgcn_mfma_f32_16x16x32_bf16(ka, ql[ks], sa, 0, 0, 0); sb = __builtin_amdgcn_mfma_f32_16x16x32_bf16(kb2, ql[ks], sb, 0, 0, 0); }
#pragma unroll
                for (int jj = 0; jj < 8; ++jj) { const int li = (jj < 4) ? jj : 12 + jj; const int j = 32 * (st + 2) + 4 * g + li;
                    const float raw = (jj < 4) ? sa[jj] : sb[jj - 4]; const float dist = (float)(tq - (int)sp[li]);
                    sc[jj] = (j < nsel) ? raw - slope2 * dist : -INFINITY; } }
              float smax = __builtin_fmaxf(__builtin_fmaxf(__builtin_fmaxf(sc[0], sc[1]), __builtin_fmaxf(sc[2], sc[3])), __builtin_fmaxf(__builtin_fmaxf(sc[4], sc[5]), __builtin_fmaxf(sc[6], sc[7])));
              { auto r16 = __builtin_amdgcn_permlane16_swap(__float_as_uint(smax), __float_as_uint(smax), false, false); smax = __builtin_fmaxf(__uint_as_float(r16[0]), __uint_as_float(r16[1]));
                auto r32_ = __builtin_amdgcn_permlane32_swap(__float_as_uint(smax), __float_as_uint(smax), false, false); smax = __builtin_fmaxf(__uint_as_float(r32_[0]), __uint_as_float(r32_[1])); }
              const float mnew = __builtin_fmaxf(mrun, smax); const float alpha = __builtin_amdgcn_exp2f(mrun - mnew); mrun = mnew;
              bf16x8 pb; float psum = 0.f;
              { float p[8];
#pragma unroll
                for (int jj = 0; jj < 8; ++jj) { p[jj] = __builtin_amdgcn_exp2f(sc[jj] - mnew); psum += p[jj]; }
                typedef float f32x2_t __attribute__((ext_vector_type(2))); typedef __bf16 bf16x2_t __attribute__((ext_vector_type(2)));
#pragma unroll
                for (int jj = 0; jj < 8; jj += 2) { const f32x2_t pv = {p[jj], p[jj + 1]}; const unsigned pk = __builtin_bit_cast(unsigned, __builtin_convertvector(pv, bf16x2_t)); pb[jj] = (short)(pk & 0xffffu); pb[jj + 1] = (short)(pk >> 16); } }
              lrun = lrun * alpha + psum;
              const bool resc = !__all(alpha == 1.0f);
#pragma unroll
              for (int dt = 0; dt < 8; ++dt) { if (resc) o[dt] = o[dt] * alpha;
                  const LAS unsigned char* a0 = stg + (4 * g + (c >> 2)) * IX_SROW + (16 * dt + 4 * (c & 3)) * 2;
                  const s16x4 lo4 = __builtin_bit_cast(s16x4, __builtin_amdgcn_ds_read_tr16_b64_v4i16((LAS s16x4*)a0));
                  const s16x4 hi4 = __builtin_bit_cast(s16x4, __builtin_amdgcn_ds_read_tr16_b64_v4i16((LAS s16x4*)(a0 + 16 * IX_SROW)));
                  const bf16x8 ca = (bf16x8){lo4[0], lo4[1], lo4[2], lo4[3], hi4[0], hi4[1], hi4[2], hi4[3]};
                  o[dt] = __builtin_amdgcn_mfma_f32_16x16x32_bf16(ca, pb, o[dt], 0, 0, 0); }
              LDS_WAIT(); asm volatile("" ::: "memory");
              }
          }
          { auto r16 = __builtin_amdgcn_permlane16_swap(__float_as_uint(lrun), __float_as_uint(lrun), false, false); lrun = __uint_as_float(r16[0]) + __uint_as_float(r16[1]);
            auto r32_ = __builtin_amdgcn_permlane32_swap(__float_as_uint(lrun), __float_as_uint(lrun), false, false); lrun = __uint_as_float(r32_[0]) + __uint_as_float(r32_[1]); }
          const float rl = 1.0f / lrun;
          if (c < 8) { LAS unsigned char* op = QLb + ((size_t)q * 1024 + c * 128 + 4 * g) * 2;
#pragma unroll
              for (int dt = 0; dt < 8; ++dt) { v2u wv; wv.x = pk2(o[dt][0] * rl, o[dt][1] * rl); wv.y = pk2(o[dt][2] * rl, o[dt][3] * rl); *(LAS v2u*)(op + 32 * dt) = wv; } }
      } }
    __syncthreads(); TS(7);
    if (do_att) {
#pragma unroll
      for (int dt = 0; dt < 2; ++dt) { f32x16 d = f32x16{}; const bf16* wp = WUVT + ((size_t)wave * 64 + 32 * dt + r32) * 128 + hi * 8;
#pragma unroll
          for (int ks = 0; ks < 8; ++ks) { const bf16x8 ob = *(const LAS bf16x8*)(QLb + ((size_t)r32 * 1024 + wave * 128 + 16 * ks + 8 * hi) * 2);
              d = __builtin_amdgcn_mfma_f32_32x32x16_bf16(*(const bf16x8*)(wp + 16 * ks), ob, d, 0, 0, 0); }
          bf16* op = OCAT + (rowb + q0 + r32) * KO0 + wave * 64 + 32 * dt + 4 * hi;
#pragma unroll
          for (int j = 0; j < 4; ++j) { v2u wv; wv.x = pk2(d[4 * j], d[4 * j + 1]); wv.y = pk2(d[4 * j + 2], d[4 * j + 3]); *(v2u*)(op + 8 * j) = wv; } } }
    __syncthreads(); TS(8);
#undef LOAD_QF
#undef TS
}
#define XB_TMO      128
#define XB_XCNT(j)  (256  + 64 * (j))
#define XB_XSUB(j)  (1280 + 64 * (j))
#define XB_XGEN(j)  (2304 + 64 * (j))
#define XB_TOP      3328
#define XB_TOPGEN   3392
#define XCD_BAR_WORDS 3456
#define XB_SPIN_CAP (1u << 18)

__device__ __forceinline__ unsigned xb_ld(unsigned* p)              { return __hip_atomic_load(p, __ATOMIC_RELAXED, __HIP_MEMORY_SCOPE_AGENT); }
__device__ __forceinline__ unsigned xb_add(unsigned* p, unsigned v) { return __hip_atomic_fetch_add(p, v, __ATOMIC_RELAXED, __HIP_MEMORY_SCOPE_AGENT); }
__device__ __forceinline__ unsigned xb_xcc_id() { return (unsigned)__builtin_amdgcn_s_getreg((3 << 11) | 20) & 0xFu; }
#define XB_SPIN(cond, bar) do { unsigned _sp = 0; while (cond) { __builtin_amdgcn_s_sleep(1); \
    if ((++_sp & 255u) == 0u) { if (xb_ld(&(bar)[XB_TMO])) break; if (_sp > XB_SPIN_CAP) { atomicAdd(&(bar)[XB_TMO], 1u); break; } } } } while (0)

struct XcdBarrier {
    unsigned* bar; unsigned x;
    volatile LAS unsigned* st;
};

__device__ __forceinline__ XcdBarrier xcd_barrier_post(unsigned* bar, volatile LAS unsigned* st) {
    XcdBarrier b; b.bar = bar; b.x = xb_xcc_id(); b.st = st;
    if (threadIdx.x == 0) (void)xb_add(&bar[XB_XCNT(b.x)], 1u);
    return b;
}
__device__ __forceinline__ void xcd_barrier_complete(unsigned* bar, unsigned x, unsigned& nloc, unsigned& nx) {
    const unsigned G = gridDim.x * gridDim.y * gridDim.z;
    unsigned sum, cnt, mine, sp = 0u;
    for (;;) {
        sum = 0u; cnt = 0u; mine = 0u;
#pragma unroll
        for (unsigned j = 0; j < 16; ++j) { const unsigned c = xb_ld(&bar[XB_XCNT(j)]); sum += c; cnt += (c > 0u) ? 1u : 0u; mine = (j == x) ? c : mine; }
        if (sum == G) break;
        __builtin_amdgcn_s_sleep(1);
        if ((++sp & 255u) == 0u) { if (xb_ld(&bar[XB_TMO])) break; if (sp > XB_SPIN_CAP) { atomicAdd(&bar[XB_TMO], 1u); break; } }
    }
    nloc = mine > 0u ? mine : 1u; nx = cnt > 0u ? cnt : 1u;
}

__device__ __forceinline__ void xcd_barrier(const XcdBarrier& b) {
    asm volatile("s_waitcnt vmcnt(0)" ::: "memory");
    __syncthreads();
    if (threadIdx.x == 0) {
        unsigned* bar = b.bar;
        __builtin_amdgcn_s_waitcnt(0);
        unsigned nloc = b.st[0], nx = b.st[1];
        if (nloc == 0u) { xcd_barrier_complete(bar, b.x, nloc, nx); b.st[0] = nloc; b.st[1] = nx; }
        const unsigned old = xb_add(&bar[XB_XSUB(b.x)], 1u);
        const unsigned gen = old / nloc;
        if (old + 1u == (gen + 1u) * nloc) {
            __builtin_amdgcn_fence(__ATOMIC_RELEASE, "agent");
            asm volatile("s_waitcnt vmcnt(0)" ::: "memory");
            const unsigned og = xb_add(&bar[XB_TOP], 1u);
            const unsigned tg = og / nx;
            if (og + 1u == (tg + 1u) * nx) xb_add(&bar[XB_TOPGEN], 1u);
            else XB_SPIN(xb_ld(&bar[XB_TOPGEN]) == tg, bar);
            __builtin_amdgcn_fence(__ATOMIC_ACQUIRE, "agent");
            xb_add(&bar[XB_XGEN(b.x)], 1u);
            asm volatile("s_waitcnt vmcnt(0)" ::: "memory");
        } else {
            XB_SPIN(xb_ld(&bar[XB_XGEN(b.x)]) == gen, bar);
            __builtin_amdgcn_fence(__ATOMIC_ACQUIRE, "agent");
            asm volatile("s_waitcnt vmcnt(0)" ::: "memory");
        }
    }
    __syncthreads();
}
namespace moba {
using bf16=__hip_bfloat16;
using bf16x8=__attribute__((ext_vector_type(8)))short;
using s16x4=__attribute__((ext_vector_type(4)))short;
using f32x16=__attribute__((ext_vector_type(16)))float;
using u32x4=__attribute__((ext_vector_type(4)))unsigned;
constexpr int SEQ=4096,D=64,PQ=3072,PO=1024;
constexpr int NW=8,QBLK=32,QB=QBLK*NW,KVBLK=64,NQB=SEQ/QB;
constexpr int ATTN_UNIT_ROWS=QB;
__device__ __forceinline__ int crow(int r,int hi){return (r&3)+8*(r>>2)+4*hi;}
#define SBAR() __builtin_amdgcn_sched_barrier(0)
__device__ __forceinline__ void cmask(f32x16&p0,f32x16&p1,int jb,int qrel,int hi){
  const float NEG=-INFINITY; int kb=64*jb+4*hi;
  #pragma unroll
  for(int r=0;r<16;++r){int kv=kb+(r&3)+8*(r>>2); if(kv>qrel)p0[r]=NEG; if(kv+32>qrel)p1[r]=NEG;}
}

constexpr int NSLOT=3, SLOTB=8192;
constexpr int LDS_K=0, LDS_V=NSLOT*SLOTB, LDS_WS=2*NSLOT*SLOTB, LDS_OST=LDS_WS+NW*64*4, LDS_BYTES=LDS_OST+NW*4096;
constexpr float C2=0.125f*1.4426950408889634f;
__device__ __forceinline__ void glds16(const void*gsrc,unsigned lds_dst){unsigned keep;
  asm volatile("s_mov_b32 %0, m0\n\ts_mov_b32 m0, %2\n\ts_nop 0\n\tglobal_load_lds_dwordx4 %1, off\n\ts_mov_b32 m0, %0":"=&s"(keep):"v"(gsrc),"s"(lds_dst):"memory");}
__device__ __forceinline__ float max3f(float a,float b,float c){float r;asm("v_max3_f32 %0, %1, %2, %3":"=v"(r):"v"(a),"v"(b),"v"(c));return r;}
__device__ __forceinline__ float max2f(float a,float b){float r;asm("v_max_f32_e32 %0, %1, %2":"=v"(r):"v"(a),"v"(b));return r;}
__device__ __forceinline__ float fadd_s(float a,float b){float r;asm("v_add_f32_e32 %0, %1, %2":"=v"(r):"v"(a),"v"(b));return r;}
__device__ __forceinline__ float fsub_s(float a,float b){float r;asm("v_sub_f32_e32 %0, %1, %2":"=v"(r):"v"(a),"v"(b));return r;}
typedef float f32x2_t __attribute__((ext_vector_type(2))); typedef __bf16 bf16x2_t __attribute__((ext_vector_type(2)));
__device__ __forceinline__ unsigned cvtpk_s(float lo,float hi){f32x2_t v={lo,hi};bf16x2_t b=__builtin_convertvector(v,bf16x2_t);return __builtin_bit_cast(unsigned,b);}
#define WAIT_BAR(N) asm volatile("s_waitcnt vmcnt(" #N ") lgkmcnt(0)\n\ts_barrier":::"memory")

__device__ __forceinline__ void qkt(f32x16&p0,f32x16&p1,const char*Kslot,const bf16x8*qr,int r32,int hi){ const f32x16 negm=f32x16{};
  const char*kb=Kslot+hi*1024+r32*16;
  #pragma unroll
  for(int d0=0;d0<4;++d0){
    const bf16x8 b0=*reinterpret_cast<const bf16x8*>(kb+d0*2048);
    const bf16x8 b1=*reinterpret_cast<const bf16x8*>(kb+d0*2048+512);
    if(d0==0){p0=__builtin_amdgcn_mfma_f32_32x32x16_bf16(b0,qr[0],negm,0,0,0);p1=__builtin_amdgcn_mfma_f32_32x32x16_bf16(b1,qr[0],negm,0,0,0);}
    else{p0=__builtin_amdgcn_mfma_f32_32x32x16_bf16(b0,qr[d0],p0,0,0,0);p1=__builtin_amdgcn_mfma_f32_32x32x16_bf16(b1,qr[d0],p1,0,0,0);}}
}
typedef __attribute__((address_space(3))) const char* lds_cptr;
typedef short v4i16_t __attribute__((ext_vector_type(4)));
__device__ __forceinline__ void kload8(bf16x8*kf,lds_cptr kp){
  kf[0]=*(const __attribute__((address_space(3))) bf16x8*)(kp);      kf[1]=*(const __attribute__((address_space(3))) bf16x8*)(kp+512);
  kf[2]=*(const __attribute__((address_space(3))) bf16x8*)(kp+2048); kf[3]=*(const __attribute__((address_space(3))) bf16x8*)(kp+2560);
  kf[4]=*(const __attribute__((address_space(3))) bf16x8*)(kp+4096); kf[5]=*(const __attribute__((address_space(3))) bf16x8*)(kp+4608);
  kf[6]=*(const __attribute__((address_space(3))) bf16x8*)(kp+6144); kf[7]=*(const __attribute__((address_space(3))) bf16x8*)(kp+6656);
}
__device__ __forceinline__ void kload2(bf16x8*kf,lds_cptr kp,int j){ kf[2*j]=*(const __attribute__((address_space(3))) bf16x8*)(kp+j*2048); kf[2*j+1]=*(const __attribute__((address_space(3))) bf16x8*)(kp+j*2048+512); }
__device__ __forceinline__ s16x4 vtr(lds_cptr p){ return __builtin_bit_cast(s16x4,__builtin_amdgcn_ds_read_tr16_b64_v4i16((__attribute__((address_space(3))) v4i16_t*)p)); }
__device__ __forceinline__ float rowmax(const f32x16&p0,const f32x16&p1){
  float a=max3f(p0[0],p0[1],p1[0]),b=max3f(p0[2],p0[3],p1[1]);a=max3f(a,p1[2],p1[3]);
  #pragma unroll
  for(int r=4;r<16;r+=4){a=max3f(a,p0[r],p0[r+1]);b=max3f(b,p0[r+2],p0[r+3]);a=max3f(a,p1[r],p1[r+1]);b=max3f(b,p1[r+2],p1[r+3]);}
  const float m=max2f(a,b);
  auto rr=__builtin_amdgcn_permlane32_swap(__float_as_uint(m),__float_as_uint(m),false,false);
  return max2f(__uint_as_float(rr[0]),__uint_as_float(rr[1]));
}
__device__ __forceinline__ void pv(f32x16*o,int vb,bf16x8 pa0,bf16x8 pa1,bf16x8 pa2,bf16x8 pa3){
  #pragma unroll
  for(int d0=0;d0<2;++d0){s16x4 lo[4],hi[4];
    #pragma unroll
    for(int ks=0;ks<4;++ks){
      asm volatile("ds_read_b64_tr_b16 %0,%1 offset:%c2":"=&v"(lo[ks]):"v"(vb),"i"(d0*4096+ks*1024):"memory");
      asm volatile("ds_read_b64_tr_b16 %0,%1 offset:%c2":"=&v"(hi[ks]):"v"(vb),"i"(d0*4096+ks*1024+512):"memory");}
    asm volatile("s_waitcnt lgkmcnt(0)":::"memory");SBAR();
    #define PK(k) (bf16x8){lo[k][0],lo[k][1],lo[k][2],lo[k][3],hi[k][0],hi[k][1],hi[k][2],hi[k][3]}
    o[d0]=__builtin_amdgcn_mfma_f32_32x32x16_bf16(pa0,PK(0),o[d0],0,0,0);
    o[d0]=__builtin_amdgcn_mfma_f32_32x32x16_bf16(pa1,PK(1),o[d0],0,0,0);
    o[d0]=__builtin_amdgcn_mfma_f32_32x32x16_bf16(pa2,PK(2),o[d0],0,0,0);
    o[d0]=__builtin_amdgcn_mfma_f32_32x32x16_bf16(pa3,PK(3),o[d0],0,0,0);
    #undef PK
  }
}

#ifndef ATTN_STORE16
#define ATTN_STORE16(p,v) (*(u32x4*)(p)=(v))
#endif
template<int THRL,bool WITH_BIAS=true> __device__ __forceinline__ void attn_unit(int b,int h,int qb,const bf16*Q,const bf16*__restrict__ K,const bf16*__restrict__ V,bf16*O,const unsigned short*__restrict__ ALLOW,const float*__restrict__ KN2,const float sig2,char*shm){
  int tid_l=threadIdx.x; asm volatile("":"+v"(tid_l)); const int tid=tid_l,lane=tid&63,r32=lane&31,hi=lane>>5; const int wid=__builtin_amdgcn_readfirstlane(tid>>6);
  const long rowbase=(long)b*SEQ; const int q0=qb*QB;
  const bf16*Qw=Q+(rowbase+q0+wid*QBLK)*PQ+h*D;
  const bf16*Kh=K+rowbase*PQ+h*D,*Vh=V+rowbase*PQ+h*D;
  const unsigned lds0=(unsigned)(uintptr_t)shm;
  float*wsf=(float*)(shm+LDS_WS)+wid*64;
  const int NT0=(q0+QB)/KVBLK;
  bf16x8 qr[4];
  #pragma unroll
  for(int d0=0;d0<4;++d0)qr[d0]=*reinterpret_cast<const bf16x8*>(&Qw[(long)r32*PQ+d0*16+hi*8]);
  float mhat=0.f,l_reg=0.f;f32x16 o[2];o[0]=f32x16{};o[1]=f32x16{};
  const int qrel=wid*QBLK+r32; const int qpos=q0+qrel;
  const unsigned allow=ALLOW[(rowbase+qpos)*16+h];
  float qn2=0.f;
  {
    float ss=0.f;
    _Pragma("unroll") for(int d0=0;d0<4;++d0){ const bf16x8 kk=*reinterpret_cast<const bf16x8*>(&Kh[(long)qpos*PQ+d0*16+hi*8]);
      _Pragma("unroll") for(int j=0;j<8;++j){ const float qv=__uint_as_float(((unsigned)(unsigned short)qr[d0][j])<<16); ss+=qv*__uint_as_float(((unsigned)(unsigned short)kk[j])<<16); qn2+=qv*qv; } }
    ss+=__shfl_xor(ss,32); qn2+=__shfl_xor(qn2,32); mhat=ss; }
  int t0=0;
  { float qm=qn2, mm=mhat;
    _Pragma("unroll") for(int off=1;off<32;off<<=1){ qm=__builtin_fmaxf(qm,__shfl_xor(qm,off)); mm=__builtin_fminf(mm,__shfl_xor(mm,off)); }
    float*exch=(float*)(shm+LDS_OST);
    if(lane==0){ exch[2*wid]=qm; exch[2*wid+1]=mm; }
    __syncthreads();
    float Qn2=exch[0], Mmin=exch[1];
    _Pragma("unroll") for(int w=1;w<NW;++w){ Qn2=__builtin_fmaxf(Qn2,exch[2*w]); Mmin=__builtin_fminf(Mmin,exch[2*w+1]); }
    const float kn=KN2[lane];
    const float bound=sqrtf(Qn2*kn)-sig2*(float)(q0-(64*lane+63))-Mmin;
    const unsigned long long nosk=__ballot(!(bound<-40.f)||lane>=NT0-4);
    t0=nosk?(int)__builtin_ctzll(nosk):0; t0&=~1; if(t0>NT0-4)t0=NT0-4; }
  const int NT=NT0-t0;
  const bf16*ksrc=Kh+(long)(lane+t0*KVBLK)*PQ+wid*8;
  const bf16*vsrc=Vh+(long)(16*(wid&3)+(lane>>2)+t0*KVBLK)*PQ+(wid>>2)*32+(lane&3)*8;
  const unsigned kdst=lds0+LDS_K+wid*1024, vdst=lds0+LDS_V+wid*1024;
  #define DMA_K(t,slot) glds16(ksrc+(long)(t)*KVBLK*PQ,(unsigned)__builtin_amdgcn_readfirstlane(kdst+(slot)))
  #define DMA_V(t,slot) glds16(vsrc+(long)(t)*KVBLK*PQ,(unsigned)__builtin_amdgcn_readfirstlane(vdst+(slot)))
  const int vb0=(int)(lds0+LDS_V)+((lane>>4)&1)*32+(lane&3)*8+(4*hi+((lane&15)>>2))*64;
  const char*Kbase=shm+LDS_K; bf16x8 kf[8];
  const lds_cptr shm3=(lds_cptr)shm; const lds_cptr kp0=shm3+LDS_K+hi*1024+r32*16; const lds_cptr vp0=shm3+LDS_V+((lane>>4)&1)*32+(lane&3)*8+(4*hi+((lane&15)>>2))*64;
  DMA_K(0,0);DMA_V(0,0);DMA_K(1,SLOTB);
  const f32x16 negm=f32x16{};
  bf16x8 kx0=bf16x8{}, kx1=bf16x8{};
  if(hi==0){ const short one=(short)0x3F80; const short k0_=(short)(cvtpk_s((float)r32,0.f)&0xffffu), k1_=(short)(cvtpk_s((float)(32+r32),0.f)&0xffffu);
    kx0[0]=one;kx0[1]=one;kx0[2]=one;kx0[3]=k0_;kx0[4]=k0_; kx1[0]=one;kx1[1]=one;kx1[2]=one;kx1[3]=k1_;kx1[4]=k1_; }
  const unsigned sgh_=cvtpk_s(sig2,0.f)&0xffffu, sgl_=cvtpk_s(sig2-__uint_as_float(sgh_<<16),0.f)&0xffffu;
  const float bq=sig2*(float)(-qpos);
  #define BIASM(P0,P1,t) do{ if(!WITH_BIAS)break; const bool al_=((allow>>(((t)+t0)>>2))&1u)!=0u; const float s0_=(bq-mhat)+sig2*(float)(64*((t)+t0)); \
    unsigned h1_=cvtpk_s(s0_,0.f)&0xffffu; const float r1_=s0_-__uint_as_float(h1_<<16); unsigned h2_=cvtpk_s(r1_,0.f)&0xffffu; const float r2_=r1_-__uint_as_float(h2_<<16); unsigned h3_=cvtpk_s(r2_,0.f)&0xffffu; \
    if(!al_){h1_=0xff80u;h2_=0u;h3_=0u;} \
    u32x4 qw_; qw_[0]=hi?0u:(h1_|(h2_<<16)); qw_[1]=hi?0u:(h3_|(sgh_<<16)); qw_[2]=hi?0u:sgl_; qw_[3]=0u; const bf16x8 qx_=__builtin_bit_cast(bf16x8,qw_); \
    P0=__builtin_amdgcn_mfma_f32_32x32x16_bf16(kx0,qx_,P0,0,0,0); P1=__builtin_amdgcn_mfma_f32_32x32x16_bf16(kx1,qx_,P1,0,0,0); }while(0)
  #define CMASK(P0,P1,t) do{int jb_=(t)-(NT-4); if(jb_>=0)cmask(P0,P1,jb_,qrel,hi);}while(0)
  bool resc=false;
  #define MXF3(a,b,c) __builtin_fmaxf(__builtin_fmaxf((a),(b)),(c))
  #define DECIDE(C0,C1) do{ float a=MXF3(C0[0],C0[1],C1[0]),b=MXF3(C0[2],C0[3],C1[1]); a=MXF3(a,C1[2],C1[3]);     \
      _Pragma("unroll") for(int r=4;r<16;r+=4){a=MXF3(a,C0[r],C0[r+1]);b=MXF3(b,C0[r+2],C0[r+3]);a=MXF3(a,C1[r],C1[r+1]);b=MXF3(b,C1[r+2],C1[r+3]);} \
      float rm=__builtin_fmaxf(a,b); { auto rr=__builtin_amdgcn_permlane32_swap(__float_as_uint(rm),__float_as_uint(rm),false,false); rm=__builtin_fmaxf(__uint_as_float(rr[0]),__uint_as_float(rr[1])); } \
      resc=false; \
      if(__builtin_expect(__any(rm>(float)THRL),0)){ const float dl=__builtin_fmaxf(rm,0.f); mhat+=dl; \
        _Pragma("unroll") for(int r=0;r<16;++r){C0[r]-=dl;C1[r]-=dl;} \
        const float f=__builtin_amdgcn_exp2f(-dl); l_reg*=f; if(hi==0)wsf[r32]=f; resc=true; } }while(0)
  #define RESC() do{ if(resc){ asm volatile("s_waitcnt lgkmcnt(0)":::"memory"); \
      _Pragma("unroll") for(int d_=0;d_<2;++d_) _Pragma("unroll") for(int r=0;r<16;++r)o[d_][r]*=wsf[crow(r,hi)]; } }while(0)
  f32x16 pA0,pA1,pB0,pB1;
  int sl_prev=0,sl_cur=0,sl_next=SLOTB;
  #define ROT() do{sl_prev=sl_cur;sl_cur=sl_next;sl_next=(sl_next==(NSLOT-1)*SLOTB)?0:sl_next+SLOTB;}while(0)
  DMA_K(2,2*SLOTB);
  WAIT_BAR(3);
  qkt(pA0,pA1,Kbase,qr,r32,hi);asm volatile("s_nop 15\n\ts_nop 7":"+v"(pA0),"+v"(pA1));BIASM(pA0,pA1,0);CMASK(pA0,pA1,0);
  DECIDE(pA0,pA1); resc=false;
  _Pragma("unroll") for(int r=0;r<16;++r){pA0[r]=__builtin_amdgcn_exp2f(pA0[r]);pA1[r]=__builtin_amdgcn_exp2f(pA1[r]);}
  WAIT_BAR(0);
  DMA_K(3,0);DMA_V(1,SLOTB);
  ROT();
  kload8(kf,kp0+sl_cur);
  WAIT_BAR(2);
  s16x4 vlo[8],vhi[8]; u32x4 pw0,pw1,pw2,pw3;
  #define PKW(P,B) cvtpk_s(P[B],P[B+1])
  #define PAF(k) __builtin_bit_cast(bf16x8,pw##k)
  #define VFR(i) (bf16x8){vlo[i][0],vlo[i][1],vlo[i][2],vlo[i][3],vhi[i][0],vhi[i][1],vhi[i][2],vhi[i][3]}
  #define PIN(x) asm volatile("":"+v"(x))
  #define MX3(a,b,c) __builtin_fmaxf(__builtin_fmaxf((a),(b)),(c))
  #define GAPA(MF,A0,A1,A2,A3,W0,W1,PW) do{ MF; sacc+=A0; sacc+=A1; sacc+=A2; sacc+=A3; PIN(sacc); W0; W1; PIN(PW); SBAR(); }while(0)
  #define EX(v) __builtin_amdgcn_exp2f(v)
  #define GAPB(MF,X,B) do{ MF; X[B]=EX(X[B]); X[B+1]=EX(X[B+1]); X[B+2]=EX(X[B+2]); X[B+3]=EX(X[B+3]); PIN(X); SBAR(); }while(0)
  #define VRD(i) do{ vlo[i]=vtr(vp_+(((i)>>2)*4096+((i)&3)*1024)); vhi[i]=vtr(vp_+(((i)>>2)*4096+((i)&3)*1024+512)); }while(0)
  #define KRD(G,j) do{ if(G){ kload2(kf,kp0+sl_next,j); SBAR(); } }while(0)
  #define STEP(C0,C1,P0,P1,t,GK,GV,GL) do{ SBAR(); \
    const lds_cptr vp_=vp0+sl_prev; \
    VRD(0); SBAR(); float sacc=(P0[0]+P0[1]); \
    GAPA(C0=__builtin_amdgcn_mfma_f32_32x32x16_bf16(kf[0],qr[0],negm,0,0,0), P0[2],P0[3],P0[4],P0[5],     pw0[0]=PKW(P0,0), pw0[1]=PKW(P0,2), pw0); \
    VRD(4); SBAR(); GAPA(C1=__builtin_amdgcn_mfma_f32_32x32x16_bf16(kf[1],qr[0],negm,0,0,0), P0[6],P0[7],P0[8],P0[9],     pw0[2]=PKW(P0,4), pw0[3]=PKW(P0,6), pw0); \
    VRD(1); SBAR(); GAPA(C0=__builtin_amdgcn_mfma_f32_32x32x16_bf16(kf[2],qr[1],C0,0,0,0),   P0[10],P0[11],P0[12],P0[13], pw1[0]=PKW(P0,8), pw1[1]=PKW(P0,10), pw1); \
    VRD(5); SBAR(); GAPA(C1=__builtin_amdgcn_mfma_f32_32x32x16_bf16(kf[3],qr[1],C1,0,0,0),   P0[14],P0[15],P1[0],P1[1],   pw1[2]=PKW(P0,12),pw1[3]=PKW(P0,14), pw1); \
    VRD(2); SBAR(); GAPA(C0=__builtin_amdgcn_mfma_f32_32x32x16_bf16(kf[4],qr[2],C0,0,0,0),   P1[2],P1[3],P1[4],P1[5],     pw2[0]=PKW(P1,0), pw2[1]=PKW(P1,2), pw2); \
    VRD(6); SBAR(); GAPA(C1=__builtin_amdgcn_mfma_f32_32x32x16_bf16(kf[5],qr[2],C1,0,0,0),   P1[6],P1[7],P1[8],P1[9],     pw2[2]=PKW(P1,4), pw2[3]=PKW(P1,6), pw2); \
    VRD(3); SBAR(); GAPA(C0=__builtin_amdgcn_mfma_f32_32x32x16_bf16(kf[6],qr[3],C0,0,0,0),   P1[10],P1[11],P1[12],P1[13], pw3[0]=PKW(P1,8), pw3[1]=PKW(P1,10), pw3); \
    VRD(7); SBAR(); GAPA(C1=__builtin_amdgcn_mfma_f32_32x32x16_bf16(kf[7],qr[3],C1,0,0,0),   P1[14],P1[15],0.f,0.f,       pw3[2]=PKW(P1,12),pw3[3]=PKW(P1,14), pw3); \
    l_reg+=sacc; \
    if(GK){DMA_K((t)+3,sl_cur);} if(GV){DMA_V((t)+1,sl_next);} \
    BIASM(C0,C1,t); CMASK(C0,C1,t); \
    DECIDE(C0,C1); \
    SBAR(); \
    GAPB(o[0]=__builtin_amdgcn_mfma_f32_32x32x16_bf16(PAF(0),VFR(0),o[0],0,0,0), C0,0); \
    GAPB(o[1]=__builtin_amdgcn_mfma_f32_32x32x16_bf16(PAF(0),VFR(4),o[1],0,0,0), C0,4); \
    KRD(GL,0); GAPB(o[0]=__builtin_amdgcn_mfma_f32_32x32x16_bf16(PAF(1),VFR(1),o[0],0,0,0), C0,8); \
    KRD(GL,1); GAPB(o[1]=__builtin_amdgcn_mfma_f32_32x32x16_bf16(PAF(1),VFR(5),o[1],0,0,0), C0,12); \
    KRD(GL,2); GAPB(o[0]=__builtin_amdgcn_mfma_f32_32x32x16_bf16(PAF(2),VFR(2),o[0],0,0,0), C1,0); \
    KRD(GL,3); GAPB(o[1]=__builtin_amdgcn_mfma_f32_32x32x16_bf16(PAF(2),VFR(6),o[1],0,0,0), C1,4); \
    GAPB(o[0]=__builtin_amdgcn_mfma_f32_32x32x16_bf16(PAF(3),VFR(3),o[0],0,0,0), C1,8); \
    GAPB(o[1]=__builtin_amdgcn_mfma_f32_32x32x16_bf16(PAF(3),VFR(7),o[1],0,0,0), C1,12); \
    }while(0)
  int t=1;
  #undef CMASK
  #define CMASK(P0,P1,t) do{}while(0)
  for(;t+5<NT;t+=2){
    STEP(pB0,pB1,pA0,pA1,t,true,true,true);     WAIT_BAR(2); RESC(); ROT();
    STEP(pA0,pA1,pB0,pB1,t+1,true,true,true);   WAIT_BAR(2); RESC(); ROT();
  }
  #undef CMASK
  #define CMASK(P0,P1,t) do{int jb_=(t)-(NT-4); if(jb_>=0)cmask(P0,P1,jb_,qrel,hi);}while(0)
  #define ENDW(tt) do{ if((tt)+3<NT){WAIT_BAR(2);} else if((tt)+2<NT){WAIT_BAR(1);} else {WAIT_BAR(0);} }while(0)
  for(;t+1<NT;t+=2){
    STEP(pB0,pB1,pA0,pA1,t,(t+3<NT),(t+1<NT),(t+1<NT));       ENDW(t);   RESC(); ROT();
    STEP(pA0,pA1,pB0,pB1,t+1,(t+4<NT),(t+2<NT),(t+2<NT));     ENDW(t+1); RESC(); ROT();
  }
  STEP(pB0,pB1,pA0,pA1,NT-1,false,false,false); RESC();
  { float sacc=pB0[0]+pB0[1]; _Pragma("unroll") for(int r=2;r<16;++r)sacc+=pB0[r]; _Pragma("unroll") for(int r=0;r<16;++r)sacc+=pB1[r]; l_reg+=sacc;
    pw0=(u32x4){PKW(pB0,0),PKW(pB0,2),PKW(pB0,4),PKW(pB0,6)};pw1=(u32x4){PKW(pB0,8),PKW(pB0,10),PKW(pB0,12),PKW(pB0,14)};pw2=(u32x4){PKW(pB1,0),PKW(pB1,2),PKW(pB1,4),PKW(pB1,6)};pw3=(u32x4){PKW(pB1,8),PKW(pB1,10),PKW(pB1,12),PKW(pB1,14)};
    SBAR(); pv(o,vb0+sl_cur,PAF(0),PAF(1),PAF(2),PAF(3)); }
  #undef PKW
  #undef PAF
  #undef VFR
  #undef PIN
  #undef MX3
  #undef GAPA
  #undef GAPB
  #undef EX
  #undef VRD
  #undef KRD
  #undef STEP
  #undef ENDW
  {auto rr=__builtin_amdgcn_permlane32_swap(__float_as_uint(l_reg),__float_as_uint(l_reg),false,false);l_reg=__uint_as_float(rr[0])+__uint_as_float(rr[1]);}
  if(hi==0)wsf[32+r32]=l_reg;asm volatile("s_waitcnt lgkmcnt(0)":::"memory");
  float rli[16];
  #pragma unroll
  for(int r=0;r<16;++r)rli[r]=__builtin_amdgcn_rcpf(wsf[32+crow(r,hi)]);
  bf16*Ow=O+(rowbase+q0+wid*QBLK)*PO+h*D;
  { bf16*stg=(bf16*)(shm+LDS_OST)+wid*2048;
    #pragma unroll
    for(int r=0;r<16;++r){const int orow=crow(r,hi);
      #pragma unroll
      for(int d0=0;d0<2;++d0)stg[orow*64+d0*32+r32]=__float2bfloat16(o[d0][r]*rli[r]);}
    asm volatile("s_waitcnt lgkmcnt(0)":::"memory");
    #pragma unroll
    for(int i=0;i<4;++i){const int row=i*8+(lane>>3),ch=lane&7; const u32x4 v=*(const u32x4*)(stg+row*64+ch*8); ATTN_STORE16(Ow+(long)row*PO+ch*8,v);} }
  asm volatile("s_waitcnt lgkmcnt(0)\n\ts_barrier":::"memory");
  #undef DMA_K
  #undef DMA_V
  #undef CMASK
  #undef DECIDE
  #undef MXF3
  #undef BIASM
  #undef RESC
  #undef ROT
}
constexpr int ATTN_LDS_BYTES=LDS_BYTES;
#undef SBAR
#undef WAIT_BAR
}
struct Args { const float* in[15]; float* out; unsigned char* ws; int ph_lo, ph_hi; };
enum { I_X = 0, I_EWIN, I_EKVN, I_EWUK, I_EWUV, I_EWOUT, I_OWIN, I_OWOUT, I_LNMG, I_LNMB, I_FG, I_FU, I_FD, I_LNFG, I_LNFB };
constexpr int NPHASE = 18;

__global__ void __launch_bounds__(NTHR, 2) mega_fwd(Args args) {
    extern __shared__ __attribute__((aligned(16))) unsigned char lds_raw[];
    LAS unsigned char* lds = (LAS unsigned char*)lds_raw;
    cg::grid_group grid = cg::this_grid();
    volatile LAS unsigned* MISC = (volatile LAS unsigned*)(lds + LDS_BYTES - 64);
    if (threadIdx.x < 16) ((LAS unsigned*)(lds + LDS_BYTES - 64))[threadIdx.x] = 0u;
    __syncthreads();
    const int G = gridDim.x; const int bx = blockIdx.x; const int vcu = (G % 8 == 0) ? (bx % 8) * (G / 8) + bx / 8 : bx;
    const int NGW = G * NWAVES;
#ifndef DUP_MASK
#define DUP_MASK 0
#endif
#ifdef DOUBLE_BARRIER
#define SEAM_EXTRA xcd_barrier(bar);
#else
#define SEAM_EXTRA
#endif
#define REP(k) for (int rep_ = 0; rep_ <= ((DUP_MASK >> (k)) & 1); ++rep_)
#define PHASE_IDS() int tid = threadIdx.x; asm volatile("" : "+v"(tid)); const int lane = tid & 63, wave = __builtin_amdgcn_readfirstlane(tid >> 6), gw = vcu * NWAVES + wave; (void)gw; (void)lane; \
    size_t zoff_ = 0; asm volatile("" : "+s"(zoff_)); unsigned char* ws = args.ws + zoff_;     \
    bf16* const W0IN = (bf16*)(ws + WS_W0IN); bf16* const W0OUT = (bf16*)(ws + WS_W0OUT); bf16* const WGU0 = (bf16*)(ws + WS_WGU0); bf16* const WGU1 = (bf16*)(ws + WS_WGU1); \
    bf16* const WDN0 = (bf16*)(ws + WS_WDN0); bf16* const WDN1 = (bf16*)(ws + WS_WDN1); bf16* const W1IN = (bf16*)(ws + WS_W1IN); bf16* const W1OUT = (bf16*)(ws + WS_W1OUT); \
    float* const KMEAN = (float*)(ws + WS_KMEAN); unsigned short* const ALLOW = (unsigned short*)(ws + WS_ALLOW); bf16* const CKVN = (bf16*)(ws + WS_CKVN); \
    bf16* const X = (bf16*)(ws + WS_X); bf16* const R1 = (bf16*)(ws + WS_R1); bf16* const OCAT = (bf16*)(ws + WS_OCAT); \
    (void)W0IN; (void)W0OUT; (void)WGU0; (void)WGU1; (void)WDN0; (void)WDN1; (void)W1IN; (void)W1OUT; (void)KMEAN; (void)ALLOW; (void)CKVN; (void)X; (void)R1; (void)OCAT;
    const int lo = args.ph_lo, hi = args.ph_hi;
#ifdef ONLY_PHASE
#define IN(k) ((k) == ONLY_PHASE && lo <= (k) && (k) < hi)
#else
#define IN(k) (lo <= (k) && (k) < hi)
#endif
    XcdBarrier bar; bar.bar = (unsigned*)args.ws + 4096; bar.x = 0; bar.st = nullptr;
    if (hi - lo > 1) bar = xcd_barrier_post((unsigned*)args.ws + 4096, MISC);
#define SEAM(k) do { if (IN(k) && IN((k) + 1)) { if ((k) == 0) grid.sync(); else { xcd_barrier(bar); SEAM_EXTRA } } } while (0)

    if (IN(0)) REP(0) { PHASE_IDS();
        LAS float* scr = (LAS float*)(lds + wave * 16384);
        int rot = 0;
        const float* ewin = args.in[I_EWIN];
        tr_job(ewin, 2500, 1024, 0, 512, 512, W0IN, 1024, C_QA, 0, C2, 0, scr, lane, gw, NGW, rot);
        tr_job(ewin, 2500, 1024, 512, 128, 128, W0IN, 1024, C_CKV, 0, 1.f, 0, scr, lane, gw, NGW, rot);
        tr_job(ewin, 2500, 1024, 640, 256, 256, W0IN, 1024, C_QIDX, 0, 1.f, 0, scr, lane, gw, NGW, rot);
        tr_job(ewin, 2500, 1024, 896, 64, 64, W0IN, 1024, C_KIDX, 0, 1.f, 0, scr, lane, gw, NGW, rot);
        tr_job(ewin, 2500, 1024, 964, 512, 512, W0IN, 1024, C_QB, 0, C2, 0, scr, lane, gw, NGW, rot);
        tr_job(ewin, 2500, 1024, 1476, 512, 512, W0IN, 1024, C_KB, 0, 1.f, 0, scr, lane, gw, NGW, rot);
        tr_job(ewin, 2500, 1024, 1988, 512, 512, W0IN, 1024, C_VB, 0, 1.f, 0, scr, lane, gw, NGW, rot);
        tr_job(ewin, 2500, 1024, 960, 64, 4, W0IN, 1024, C_WIDX, 0, 1.f, 0, scr, lane, gw, NGW, rot);
        tr_job(args.in[I_EWOUT], 1024, 1024, 0, 1024, 1024, W0OUT, KO0, 0, 0, 1.f, 0, scr, lane, gw, NGW, rot);
        { bf16* WUKT = (bf16*)(ws + WS_WUKT); bf16* WUVT = (bf16*)(ws + WS_WUVT); const float* wuk = args.in[I_EWUK]; const float* wuv = args.in[I_EWUV];
          for (int e = bx * NTHR + tid; e < 8 * 128 * 64; e += G * NTHR) { const int h = e >> 13, r = (e >> 6) & 127, d = e & 63;
              WUKT[e] = (bf16)f2bf(wuk[(h * 64 + d) * 128 + r]); WUVT[(h * 64 + d) * 128 + r] = (bf16)f2bf(wuv[(h * 128 + r) * 64 + d]); } }
        for (int l = 0; l < 2; ++l) {
            tr_job(args.in[I_FG] + (size_t)l * 1024 * DFF, DFF, 1024, 0, DFF, DFF, l ? WGU1 : WGU0, 1024, 0, 0, 1.f, 1, scr, lane, gw, NGW, rot);
            tr_job(args.in[I_FU] + (size_t)l * 1024 * DFF, DFF, 1024, 0, DFF, DFF, l ? WGU1 : WGU0, 1024, 0, 0, 1.f, 2, scr, lane, gw, NGW, rot);
            tr_job(args.in[I_FD] + (size_t)l * DFF * 1024, 1024, DFF, 0, 1024, 1024, l ? WDN1 : WDN0, DFF, 0, 0, 1.f, 0, scr, lane, gw, NGW, rot);
        }
        tr_job(args.in[I_OWIN], 3072, 1024, 0, 1024, 1024, W1IN, 1024, 0, 0, C2, 0, scr, lane, gw, NGW, rot);
        tr_job(args.in[I_OWIN], 3072, 1024, 1024, 2048, 2048, W1IN, 1024, 1024, 0, 1.f, 0, scr, lane, gw, NGW, rot);
        tr_job(args.in[I_OWOUT], 1024, 1024, 0, 1024, 1024, W1OUT, 1024, 0, 0, 1.f, 0, scr, lane, gw, NGW, rot);
        { const float* x = args.in[I_X]; const size_t nchunk = (size_t)M * DM / 8;
          for (size_t i = (size_t)bx * NTHR + tid; i < nchunk; i += (size_t)G * NTHR) { const f32x4 a = __builtin_nontemporal_load((const f32x4*)(x + 8 * i)), b = __builtin_nontemporal_load((const f32x4*)(x + 8 * i + 4));
              v4u o; o.x = pk2(a[0], a[1]); o.y = pk2(a[2], a[3]); o.z = pk2(b[0], b[1]); o.w = pk2(b[2], b[3]); *(v4u*)(X + 8 * i) = o; } }
    }
    SEAM(0);
    if (IN(1)) REP(1) { PHASE_IDS(); pg8::Gemm g{X, W0IN, M, NQ0, DM}; pg8::StaticOrder S; S.init(M, NQ0, G, bx); pg8::EpiBf16<0> E{R1, NQ0, nullptr, 0, 0, 1.f};
        pg8::gemm_phase<pg8::EpiBf16<0>, pg8::StaticOrder, true, true>(lds, g, S, E); }
    SEAM(1);
    if (IN(2)) REP(2) { PHASE_IDS();
        const float* kvn = args.in[I_EKVN];
        for (int m = gw; m < M; m += NGW) { const unsigned wv = *(const unsigned*)(R1 + (size_t)m * NQ0 + C_CKV + 2 * lane); const float a = bflo(wv), b = bfhi(wv);
            const float r = 1.f / sqrtf(wave_sum(a * a + b * b) * (1.f / 128.f) + 1e-6f);
            *(unsigned*)(CKVN + (size_t)m * 128 + 2 * lane) = pk2(a * r * kvn[2 * lane], b * r * kvn[2 * lane + 1]);
            if (lane < 32) *(unsigned*)((bf16*)(ws + WS_KIDXC) + (size_t)m * 64 + 2 * lane) = *(const unsigned*)(R1 + (size_t)m * NQ0 + C_KIDX + 2 * lane); }
        for (int u = gw; u < BATCH * 8 * (SEQ / 32); u += NGW) { const int qt = (SEQ / 32 - 1) - (u / (BATCH * 8)), bh = u % (BATCH * 8); stick_unit(R1, OCAT, bh >> 3, bh & 7, qt, lane); }
    }
    SEAM(2);
    if (IN(3)) REP(3) { PHASE_IDS(); unsigned long long pacc = 0ull;
        if (G == 256 && !(DUP_MASK >> 3 & 1)) {
            unsigned* qctr = (unsigned*)ws + 8192 + 2048 + 64 * (bx & 7);
            const int b = bx & 7;
            if (tid == 0) MISC[4] = __hip_atomic_fetch_add(qctr, 1u, __ATOMIC_RELAXED, __HIP_MEMORY_SCOPE_AGENT);
            __syncthreads();
            int L = (int)MISC[4];
            while (L < 128) { unsigned nxt = 0u;
                if (tid == 0) nxt = __hip_atomic_fetch_add(qctr, 1u, __ATOMIC_RELAXED, __HIP_MEMORY_SCOPE_AGENT);
                dsa_unit(R1, (const bf16*)(ws + WS_KIDXC), CKVN, (const bf16*)(ws + WS_WUKT), (const bf16*)(ws + WS_WUVT), OCAT, b, 127 - L, lds, tid, wave, lane, true, 127, pacc);
                if (tid == 0) MISC[4] = nxt;
                __syncthreads();
                L = (int)MISC[4];
                __syncthreads(); }
        } else {
        const int nun = (G == 256) ? 4 : (BATCH * 128 - bx + G - 1) / G;
#ifndef DSA_ORDER
#define DSA_ORDER(i, j) ((i) == 0 ? 127 - (j) : (i) == 1 ? 64 + (j) : (i) == 2 ? 63 - (j) : (j))
#endif
#ifndef DSA_DUMMY_MASK
#define DSA_DUMMY_MASK 15
#endif
#ifdef DSA_DUP_SEARCH
        for (int i2 = 0; i2 < 2 * nun; ++i2) { const int i = i2 >> 1; const bool do_att = (i2 & 1) != 0; int b, qt;
#else
        for (int i = 0; i < nun; ++i) { const bool do_att = true; int b, qt;
#endif
            if (G == 256) { const int j = vcu & 31; b = vcu >> 5; qt = DSA_ORDER(i, j); }
            else { const int u = bx + i * G; b = u >> 7; qt = u & 127; }
            dsa_unit(R1, (const bf16*)(ws + WS_KIDXC), CKVN, (const bf16*)(ws + WS_WUKT), (const bf16*)(ws + WS_WUVT), OCAT, b, qt, lds, tid, wave, lane, do_att, do_att ? 127 : DSA_DUMMY_MASK, pacc); }
        }
#ifdef DSA_TSEC
        { const unsigned long long t0_ = __builtin_amdgcn_s_memrealtime(); while (__builtin_amdgcn_s_memrealtime() - t0_ < 4ull * pacc) __builtin_amdgcn_s_sleep(8); __syncthreads(); }
#endif
    }
#ifdef DSA_TSEC
    if (IN(3)) {   }
#endif
    SEAM(3);
    if (IN(4)) REP(4) { PHASE_IDS(); pg8::Gemm g{OCAT, W0OUT, M, DM, KO0}; pg8::StaticOrder S; S.init(M, DM, G, bx); pg8::EpiResid E{(DUP_MASK >> 4 & 1) && rep_ == 0 ? R1 : X, DM, ALPHA};
        pg8::gemm_phase<pg8::EpiResid, pg8::StaticOrder, true, true>(lds, g, S, E); }
    SEAM(4);
    if (IN(5)) REP(5) { PHASE_IDS(); for (int m = gw; m < M; m += NGW) ln_row<false>(X + (size_t)m * DM, args.in[I_LNMG], args.in[I_LNMB], nullptr, lane); }
    SEAM(5);
    if (IN(6)) REP(6) { PHASE_IDS(); pg8::Gemm g{X, WGU0, M, NGU, DM}; pg8::StaticOrder S; S.init(M, NGU, G, bx); pg8::EpiSwiGLU E{R1, DFF};
        pg8::gemm_phase<pg8::EpiSwiGLU, pg8::StaticOrder, true, true>(lds, g, S, E); }
    SEAM(6);
    if (IN(7)) REP(7) { PHASE_IDS(); pg8::Gemm g{R1, WDN0, M, DM, DFF}; pg8::StaticOrder S; S.init(M, DM, G, bx); pg8::EpiResid E{(DUP_MASK >> 7 & 1) && rep_ == 0 ? OCAT : X, DM, ALPHA};
        pg8::gemm_phase<pg8::EpiResid, pg8::StaticOrder, true, true>(lds, g, S, E); }
    SEAM(7);
    if (IN(8)) REP(8) { PHASE_IDS(); for (int m = gw; m < M; m += NGW) ln_row<false>(X + (size_t)m * DM, args.in[I_LNFG], args.in[I_LNFB], nullptr, lane); }
    SEAM(8);
    if (IN(9)) REP(9) { PHASE_IDS(); pg8::Gemm g{X, W1IN, M, NQ1, DM}; pg8::StaticOrder S; S.init(M, NQ1, G, bx); pg8::EpiBf16<0> E{R1, NQ1, nullptr, 0, 0, 1.f};
        pg8::gemm_phase<pg8::EpiBf16<0>, pg8::StaticOrder, true, true>(lds, g, S, E); }
    SEAM(9);
    if (IN(10)) REP(10) { PHASE_IDS();
        float* KN2 = (float*)(ws + WS_KN2);
        for (int u = gw; u < BATCH * 16 * 16; u += NGW) { const int b = u >> 8, h = (u >> 4) & 15, n = u & 15;
            const bf16* kp = R1 + ((size_t)b * SEQ + 256 * n + (lane >> 5)) * NQ1 + 1024 + h * 64 + 2 * (lane & 31);
            float s0 = 0.f, s1 = 0.f, nmax = 0.f;
#pragma unroll 4
            for (int i = 0; i < 128; ++i) { const unsigned wv = *(const unsigned*)(kp + (size_t)(2 * i) * NQ1); const float k0 = bflo(wv), k1 = bfhi(wv);
                s0 += k0; s1 += k1;
                float n2 = k0 * k0 + k1 * k1;
                n2 += __builtin_bit_cast(float, __builtin_amdgcn_update_dpp(0, __builtin_bit_cast(int, n2), 0xB1, 0xf, 0xf, false));
                n2 += __builtin_bit_cast(float, __builtin_amdgcn_update_dpp(0, __builtin_bit_cast(int, n2), 0x4E, 0xf, 0xf, false));
                n2 += __builtin_bit_cast(float, __builtin_amdgcn_update_dpp(0, __builtin_bit_cast(int, n2), 0x124, 0xf, 0xf, false));
                n2 += __builtin_bit_cast(float, __builtin_amdgcn_update_dpp(0, __builtin_bit_cast(int, n2), 0x128, 0xf, 0xf, false));
                { auto sw = __builtin_amdgcn_permlane16_swap(__float_as_uint(n2), __float_as_uint(n2), false, false); n2 = __uint_as_float(sw[0]) + __uint_as_float(sw[1]); }
                nmax = __builtin_fmaxf(nmax, n2);
                if ((i & 31) == 31) {
                    const float m = __builtin_fmaxf(nmax, __shfl_xor(nmax, 32));
                    if (lane == 0) KN2[(size_t)u * 4 + (i >> 5)] = m; nmax = 0.f; } }
            s0 += __shfl_xor(s0, 32); s1 += __shfl_xor(s1, 32);
            if (lane < 32) { float* o = KMEAN + (size_t)u * 64 + 2 * lane; o[0] = s0 * (1.f / 256.f); o[1] = s1 * (1.f / 256.f); } }
    }
    SEAM(10);
    if (IN(11)) REP(11) { PHASE_IDS();
        for (size_t e = (size_t)bx * NTHR + tid; e < (size_t)M * 16; e += (size_t)G * NTHR) {
            const int h = (int)(e / M); const int m = (int)(e % M); const int b = m / SEQ, t = m % SEQ, cur = t >> 8;
            float q[64];
            { const bf16* qp = R1 + (size_t)m * NQ1 + h * 64;
#pragma unroll
              for (int i = 0; i < 8; ++i) { const v4u wv = *(const v4u*)(qp + 8 * i); q[8 * i] = bflo(wv.x); q[8 * i + 1] = bfhi(wv.x); q[8 * i + 2] = bflo(wv.y); q[8 * i + 3] = bfhi(wv.y);
                  q[8 * i + 4] = bflo(wv.z); q[8 * i + 5] = bfhi(wv.z); q[8 * i + 6] = bflo(wv.w); q[8 * i + 7] = bfhi(wv.w); } }
            float g0 = -INFINITY, g1 = -INFINITY, g2 = -INFINITY; int i0 = -1, i1 = -1, i2 = -1;
            for (int n = 0; n < cur; ++n) { const float* km = KMEAN + ((size_t)(b * 16 + h) * 16 + n) * 64; float s = 0.f;
#pragma unroll
                for (int d4 = 0; d4 < 16; ++d4) { const f32x4 kv = *(const f32x4*)(km + 4 * d4); s = __builtin_fmaf(q[4 * d4], kv[0], s); s = __builtin_fmaf(q[4 * d4 + 1], kv[1], s); s = __builtin_fmaf(q[4 * d4 + 2], kv[2], s); s = __builtin_fmaf(q[4 * d4 + 3], kv[3], s); }
                if (s > g0) { g2 = g1; i2 = i1; g1 = g0; i1 = i0; g0 = s; i0 = n; } else if (s > g1) { g2 = g1; i2 = i1; g1 = s; i1 = n; } else if (s > g2) { g2 = s; i2 = n; } }
            unsigned mask = 1u << cur; if (i0 >= 0) mask |= 1u << i0; if (i1 >= 0) mask |= 1u << i1; if (i2 >= 0) mask |= 1u << i2;
            ALLOW[(size_t)m * 16 + h] = (unsigned short)mask; }
    }
    SEAM(11);
    if (IN(12)) REP(12) { PHASE_IDS();
        const float* KN2 = (const float*)(ws + WS_KN2);
        if (G == 256) {
            unsigned* qctr = (unsigned*)ws + 8192 + 64 * (bx & 7) + 1024 * rep_;
            const int b = bx & 7;
            if (tid == 0) MISC[4] = __hip_atomic_fetch_add(qctr, 1u, __ATOMIC_RELAXED, __HIP_MEMORY_SCOPE_AGENT);
            __syncthreads();
            int L = (int)MISC[4];
            while (L < 256) { unsigned nxt = 0u;
                if (tid == 0) nxt = __hip_atomic_fetch_add(qctr, 1u, __ATOMIC_RELAXED, __HIP_MEMORY_SCOPE_AGENT);
                const int qb = 15 - (L >> 4), h = 15 - (L & 15);
#ifdef MOBA_PROBE_NOBIAS
                if ((DUP_MASK >> 12 & 1) && rep_ == 0) moba::attn_unit<8, false>(b, h, qb, (const moba::bf16*)R1, (const moba::bf16*)(R1 + 1024), (const moba::bf16*)(R1 + 2048), (moba::bf16*)OCAT, ALLOW, KN2 + (size_t)(b * 16 + h) * 64,
                                   LOG2E * __builtin_amdgcn_exp2f(-0.5f * (float)(h + 1)), (char*)lds_raw); else
#endif
                moba::attn_unit<8>(b, h, qb, (const moba::bf16*)R1, (const moba::bf16*)(R1 + 1024), (const moba::bf16*)(R1 + 2048), (moba::bf16*)OCAT, ALLOW, KN2 + (size_t)(b * 16 + h) * 64,
                                   LOG2E * __builtin_amdgcn_exp2f(-0.5f * (float)(h + 1)), (char*)lds_raw);
                if (tid == 0) MISC[4] = nxt;
                __syncthreads();
                L = (int)MISC[4];
                __syncthreads(); }
        } else for (int u = bx; u < BATCH * 256; u += G) { const int b = u >> 8, h = (u >> 4) & 15, qb = 15 - (u & 15);
            moba::attn_unit<8>(b, h, qb, (const moba::bf16*)R1, (const moba::bf16*)(R1 + 1024), (const moba::bf16*)(R1 + 2048), (moba::bf16*)OCAT, ALLOW, KN2 + (size_t)(b * 16 + h) * 64,
                               LOG2E * __builtin_amdgcn_exp2f(-0.5f * (float)(h + 1)), (char*)lds_raw); }
    }
    SEAM(12);
    if (IN(13)) REP(13) { PHASE_IDS(); pg8::Gemm g{OCAT, W1OUT, M, DM, DM}; pg8::StaticOrder S; S.init(M, DM, G, bx); pg8::EpiResid E{X, DM, ALPHA};
        pg8::gemm_phase<pg8::EpiResid, pg8::StaticOrder, true, true>(lds, g, S, E); }
    SEAM(13);
    if (IN(14)) REP(14) { PHASE_IDS(); for (int m = gw; m < M; m += NGW) ln_row<false>(X + (size_t)m * DM, args.in[I_LNMG] + DM, args.in[I_LNMB] + DM, nullptr, lane); }
    SEAM(14);
    if (IN(15)) REP(15) { PHASE_IDS(); pg8::Gemm g{X, WGU1, M, NGU, DM}; pg8::StaticOrder S; S.init(M, NGU, G, bx); pg8::EpiSwiGLU E{R1, DFF};
        pg8::gemm_phase<pg8::EpiSwiGLU, pg8::StaticOrder, true, true>(lds, g, S, E); }
    SEAM(15);
    if (IN(16)) REP(16) { PHASE_IDS(); pg8::Gemm g{R1, WDN1, M, DM, DFF}; pg8::StaticOrder S; S.init(M, DM, G, bx); pg8::EpiResid E{X, DM, ALPHA};
        pg8::gemm_phase<pg8::EpiResid, pg8::StaticOrder, true, true>(lds, g, S, E); }
    SEAM(16);
    if (IN(17)) REP(17) { PHASE_IDS(); for (int m = gw; m < M; m += NGW) ln_row<true>(X + (size_t)m * DM, args.in[I_LNFG] + DM, args.in[I_LNFB] + DM, args.out + (size_t)m * DM, lane); }
#undef IN
#undef SEAM
}

#ifndef MK_N_LAUNCHES
#define MK_N_LAUNCHES 1
#endif
extern "C" void kernel_launch(void* const* d_in, const int* in_sizes, int n_in, void* d_out, int out_size, void* d_ws, size_t ws_size, hipStream_t stream) {
    static int grid = 0;
    if (grid == 0) {
        if (n_in != 15 || in_sizes[0] != M * DM || out_size != M * DM || ws_size < WS_END) { fprintf(stderr, "kernel_launch: unexpected shapes (n_in %d, in0 %d, out %d, ws %zu); nothing launched\n", n_in, n_in > 0 ? in_sizes[0] : -1, out_size, ws_size); grid = -1; return; }
        int dev = 0, cus = 0, per_cu = 0;
        if (hipGetDevice(&dev) != hipSuccess || hipDeviceGetAttribute(&cus, hipDeviceAttributeMultiprocessorCount, dev) != hipSuccess) { grid = -1; return; }
        if (hipFuncSetAttribute((const void*)mega_fwd, hipFuncAttributeMaxDynamicSharedMemorySize, LDS_BYTES) != hipSuccess) { fprintf(stderr, "kernel_launch: hipFuncSetAttribute failed\n"); grid = -1; return; }
        if (hipOccupancyMaxActiveBlocksPerMultiprocessor(&per_cu, (const void*)mega_fwd, NTHR, LDS_BYTES) != hipSuccess || per_cu < 1) { fprintf(stderr, "kernel_launch: occupancy query reports %d\n", per_cu); per_cu = 1; }
        (void)hipGetLastError();
        grid = cus;
    }
    if (grid < 0) return;
    if (hipMemsetAsync(d_ws, 0, 65536, stream) != hipSuccess) { fprintf(stderr, "kernel_launch: hipMemsetAsync failed\n"); return; }
    Args a{};
    for (int i = 0; i < 15; ++i) a.in[i] = (const float*)d_in[i];
    a.out = (float*)d_out; a.ws = (unsigned char*)d_ws;
    if (MK_N_LAUNCHES == 1) {
        a.ph_lo = 0; a.ph_hi = NPHASE;
        void* kargs[] = {&a};
        hipError_t e = hipLaunchCooperativeKernel((const void*)mega_fwd, dim3(grid), dim3(NTHR), kargs, LDS_BYTES, stream);
        if (e != hipSuccess) fprintf(stderr, "kernel_launch: cooperative launch failed: %s (grid %d)\n", hipGetErrorString(e), grid);
    } else {
        for (int p = 0; p < NPHASE; ++p) { a.ph_lo = p; a.ph_hi = p + 1; hipLaunchKernelGGL(mega_fwd, dim3(grid), dim3(NTHR), LDS_BYTES, stream, a); }
    }
}
```

```cpp
#include <hip/hip_runtime.h>
#include <hip/hip_cooperative_groups.h>
#include <hip/hip_bf16.h>
#include <cstdio>
#include <cstdint>
#include <cmath>
namespace cg = cooperative_groups;
namespace pg8 {
#define PG8_LAS __attribute__((address_space(3)))
typedef unsigned short bf16_t;
typedef short bf16x8 __attribute__((ext_vector_type(8)));
typedef float f32x4 __attribute__((ext_vector_type(4)));
typedef unsigned u32x4 __attribute__((ext_vector_type(4)));
constexpr int BM = 256, BK = 64, HALF = 128, HTB = HALF * BK * 2  , STAGE_BYTES = 8 * HTB, NXCD = 8, WGM = 4;

__host__ __device__ __forceinline__ int lds_byte(int r, int c) { const int st = (r >> 4) * 2 + (c >> 5), rr = r & 15, cc = c & 31, ob = rr * 64 + cc * 2; return st * 1024 + (ob ^ (((ob >> 9) & 1) << 5)); }
__host__ __device__ __forceinline__ void stage_rc(int b, int& R, int& C) { const int st = b / 1024, sb = b % 1024, swz = sb ^ (((sb >> 9) & 1) << 5); R = (st >> 1) * 16 + swz / 64; C = (st & 1) * 32 + (swz % 64) / 2; }
__host__ __device__ __forceinline__ int perm32(int rho) { const int n = rho >> 4, i = rho & 15; return 8 * (i >> 2) + 4 * n + (i & 3); }

struct Unit { int pm, pn; };
struct Gemm { const bf16_t* A; const bf16_t* Bt; int M, N, K; };

struct StaticOrder {
    int nM, nN, nwg, G, c;
    __host__ __device__ void init(int M, int N, int G_, int c_) { nM = M / BM; nN = N / BM; nwg = nM * nN; G = G_; c = c_; }
    __host__ __device__ bool next(int i, Unit& u) const {
        const long L = (long)i * G + c; if (L >= nwg) return false;
        int wgid = (int)L; { const int q = nwg / NXCD, r = nwg % NXCD, xcd = wgid % NXCD, off = wgid / NXCD; wgid = (xcd < r ? xcd * (q + 1) : r * (q + 1) + (xcd - r) * q) + off; }
        const int nig = WGM * nN, gid = wgid / nig, fm = gid * WGM, gsz = (nM - fm) < WGM ? (nM - fm) : WGM;
        u.pm = fm + ((wgid % nig) % gsz); u.pn = (wgid % nig) / gsz; return true;
    }
    __device__ __forceinline__ void a_ready(const Unit&) const {}
    __device__ __forceinline__ void done(const Unit&) const {}
};

__device__ __forceinline__ unsigned cvt_pk_bf16(float lo, float hi) { unsigned r; asm volatile("v_cvt_pk_bf16_f32 %0, %1, %2" : "=v"(r) : "v"(lo), "v"(hi)); return r; }
typedef float f32x2 __attribute__((ext_vector_type(2)));
__device__ __forceinline__ f32x2 gelu_pk(f32x2 v) {
    const f32x2 av = __builtin_elementwise_abs(v), d = av * 0.2316418882f + 1.0f;
    f32x2 t; t.x = __builtin_amdgcn_rcpf(d.x); t.y = __builtin_amdgcn_rcpf(d.y);
    f32x2 q = t * 0.5307027145f + (-0.7265760135f); q = q * t + 0.7107068705f; q = q * t + (-0.142248368f); q = q * t + 0.127414796f; q = q * t;
    const f32x2 s = (v * v) * (-0.72134752044f);
    f32x2 e; e.x = __builtin_amdgcn_exp2f(s.x); e.y = __builtin_amdgcn_exp2f(s.y);
    const f32x2 m = v * (q * e), r = v - m;
    f32x2 o; o.x = v.x < 0.f ? m.x : r.x; o.y = v.y < 0.f ? m.y : r.y; return o;
}

template <int ACT  > struct EpiBf16 {
    static constexpr bool PERM = true, AFTER_DRAIN = false; static_assert(ACT == 0 || ACT == 1, "EpiBf16: ACT is 0 (none) or 1 (gelu_pk)");
    bf16_t* O; int ldc; const float* bias; int split_cols; size_t split_stride; float scale0;
    __device__ __forceinline__ void operator()(const f32x4 (&acc)[2][2][4][2], const Unit& u, int wr, int wc, int fr, int fq) const {
        const int row0 = u.pm * BM + wr * 64 + fr; int colt = u.pn * BM; bf16_t* base = O;
        float sc = 1.f; if (split_cols) { const int t = colt / split_cols; base += (size_t)t * split_stride; colt -= t * split_cols; if (t == 0) sc = scale0; }
        const int col0 = colt + wc * 32 + 8 * fq, bcol0 = u.pn * BM + wc * 32 + 8 * fq;
        f32x4 bv[2][2];
#pragma unroll
        for (int bj = 0; bj < 2; ++bj)
#pragma unroll
            for (int n = 0; n < 2; ++n) bv[bj][n] = bias ? *(const f32x4*)(bias + bcol0 + bj * HALF + 4 * n) : (f32x4){0.f, 0.f, 0.f, 0.f};
#pragma unroll
        for (int ai = 0; ai < 2; ++ai)
#pragma unroll
            for (int m = 0; m < 4; ++m) { bf16_t* rowp = base + (size_t)(row0 + ai * HALF + m * 16) * ldc + col0;
#pragma unroll
                for (int bj = 0; bj < 2; ++bj) { f32x4 v0 = acc[ai][bj][m][0] + bv[bj][0], v1 = acc[ai][bj][m][1] + bv[bj][1];
                    if (ACT == 1) { f32x2 a = gelu_pk((f32x2){v0[0], v0[1]}), b = gelu_pk((f32x2){v0[2], v0[3]}), c = gelu_pk((f32x2){v1[0], v1[1]}), d = gelu_pk((f32x2){v1[2], v1[3]});
                        v0 = (f32x4){a.x, a.y, b.x, b.y}; v1 = (f32x4){c.x, c.y, d.x, d.y}; }
                    v0 = v0 * sc; v1 = v1 * sc; u32x4 w; w.x = cvt_pk_bf16(v0[0], v0[1]); w.y = cvt_pk_bf16(v0[2], v0[3]); w.z = cvt_pk_bf16(v1[0], v1[1]); w.w = cvt_pk_bf16(v1[2], v1[3]);
                    *(u32x4*)(rowp + bj * HALF) = w; } }
    }
};

struct PanelStats {
    unsigned* xbuf;
    unsigned* cnt;
    unsigned* tmo;
    int ntn; float eps;
    unsigned code;
    __device__ __forceinline__ bool run(const f32x4 (&v)[2][2][4][2], const Unit& u, int wr, int wc, int fr, int fq, PG8_LAS unsigned char* lds, int wid, int lane) const {
        typedef float f32x2v __attribute__((ext_vector_type(2)));
        PG8_LAS f32x2v* P = (PG8_LAS f32x2v*)lds;
        PG8_LAS f32x2v* S = (PG8_LAS f32x2v*)(lds + 8192);
        PG8_LAS unsigned* flag = (PG8_LAS unsigned*)(lds + 8192 + 2048);
#pragma unroll
        for (int ai = 0; ai < 2; ++ai)
#pragma unroll
            for (int m = 0; m < 4; ++m) {
                float s = 0.f;
#pragma unroll
                for (int bj = 0; bj < 2; ++bj)
#pragma unroll
                    for (int n = 0; n < 2; ++n) { const f32x4 x = v[ai][bj][m][n]; s += (x[0] + x[1]) + (x[2] + x[3]); }
                s += __shfl_xor(s, 16); s += __shfl_xor(s, 32);
                const float mw = s * (1.0f / 64.0f); float q = 0.f;
#pragma unroll
                for (int bj = 0; bj < 2; ++bj)
#pragma unroll
                    for (int n = 0; n < 2; ++n) { const f32x4 d = v[ai][bj][m][n] - mw; q += (d[0] * d[0] + d[1] * d[1]) + (d[2] * d[2] + d[3] * d[3]); }
                q += __shfl_xor(q, 16); q += __shfl_xor(q, 32);
                if (fq == 0) P[(ai * HALF + wr * 64 + m * 16 + fr) * 4 + wc] = (f32x2v){mw, q};
            }
        asm volatile("s_waitcnt lgkmcnt(0)" ::: "memory"); __builtin_amdgcn_s_barrier(); asm volatile("" ::: "memory");
#if defined(BROKEN_EXCHANGE_NO_WAIT)
#warning BROKEN CONTROL BUILD: the row-statistics exchange does not wait; results are wrong by design
        if (blockIdx.x >= 64) { const long long t0_ = clock64(); while (clock64() - t0_ < 60000) __builtin_amdgcn_s_sleep(8); }
#endif
        const int row = wid * 32 + (lane & 31);
        if (lane < 32) {
            const f32x2v a = P[row * 4 + 0], b = P[row * 4 + 1], c = P[row * 4 + 2], d = P[row * 4 + 3];
            const float mt = (a.x + b.x + c.x + d.x) * 0.25f;
            const float da = a.x - mt, db = b.x - mt, dc = c.x - mt, dd = d.x - mt;
            const float m2 = (a.y + b.y) + (c.y + d.y) + 64.0f * ((da * da + db * db) + (dc * dc + dd * dd));
            unsigned long long* slot = (unsigned long long*)xbuf + ((size_t)(u.pm * BM + row) * 4 + u.pn);
            __hip_atomic_store(slot, ((unsigned long long)__float_as_uint(m2) << 32) | __float_as_uint(mt), __ATOMIC_RELAXED, __HIP_MEMORY_SCOPE_AGENT);
        }
        asm volatile("s_waitcnt vmcnt(0)" ::: "memory");
        if (lane == 0) __hip_atomic_fetch_add(cnt + 64 * u.pm, 1u, __ATOMIC_RELAXED, __HIP_MEMORY_SCOPE_AGENT);
        if (wid == 0) {
            bool dead = false; const unsigned long long t0 = __builtin_amdgcn_s_memrealtime(); const unsigned want = 8u * (unsigned)ntn;
            for (;;) {
#if defined(BROKEN_EXCHANGE_NO_WAIT)
                break;
#endif
                if ((unsigned)__builtin_amdgcn_readfirstlane(__hip_atomic_load(cnt + 64 * u.pm, __ATOMIC_RELAXED, __HIP_MEMORY_SCOPE_AGENT)) >= want) break;
                if (__builtin_amdgcn_s_memrealtime() - t0 > 2000000ull) {
                    if (lane == 0) { unsigned expect = 0u; __hip_atomic_compare_exchange_strong(tmo + 1, &expect, code | (unsigned)(u.pm & 0xff), __ATOMIC_RELAXED, __ATOMIC_RELAXED, __HIP_MEMORY_SCOPE_AGENT);
                                     __hip_atomic_store(tmo, 1u, __ATOMIC_RELAXED, __HIP_MEMORY_SCOPE_AGENT); }
                    dead = true; break; }
                __builtin_amdgcn_s_sleep(2);
            }
            __builtin_amdgcn_fence(__ATOMIC_ACQUIRE, "agent");
            if (lane == 0) flag[0] = dead ? 1u : 0u;
        }
        asm volatile("s_waitcnt vmcnt(0) lgkmcnt(0)" ::: "memory"); __builtin_amdgcn_s_barrier(); asm volatile("" ::: "memory");
        const bool bad = flag[0] != 0u;
        if (lane < 32) {
            const unsigned long long* slot = (const unsigned long long*)xbuf + (size_t)(u.pm * BM + row) * 4; float mt[4], m2[4]; float ms = 0.f;
#pragma unroll
            for (int t = 0; t < 4; ++t) { if (t < ntn) { const unsigned long long w = __hip_atomic_load(slot + t, __ATOMIC_RELAXED, __HIP_MEMORY_SCOPE_AGENT); mt[t] = __uint_as_float((unsigned)w); m2[t] = __uint_as_float((unsigned)(w >> 32)); } else { mt[t] = 0.f; m2[t] = 0.f; } ms += mt[t]; }
            const float mean = ms / (float)ntn; float q = 0.f;
#pragma unroll
            for (int t = 0; t < 4; ++t) if (t < ntn) { const float dm = mt[t] - mean; q += m2[t] + 256.0f * dm * dm; }
            S[row] = (f32x2v){mean, 1.0f / sqrtf(q / (256.0f * (float)ntn) + eps)};
        }
        asm volatile("s_waitcnt lgkmcnt(0)" ::: "memory"); __builtin_amdgcn_s_barrier(); asm volatile("" ::: "memory");
        return bad;
    }
};
struct EpiLnRes {
    static constexpr bool PERM = false, AFTER_DRAIN = true;
    const float* base; float* out; int ldc; const float* bias; PanelStats st; unsigned poison;
    __device__ __forceinline__ void fused(f32x4 (&acc)[2][2][4][2], const Unit& u, int wr, int wc, int fr, int fq, PG8_LAS unsigned char* lds, int wid, int lane) const {
        typedef float f32x2v __attribute__((ext_vector_type(2)));
        const PG8_LAS f32x2v* S = (const PG8_LAS f32x2v*)(lds + 8192);
        const int col0 = u.pn * BM + wc * 32 + 4 * fq;
#pragma unroll
        for (int bj = 0; bj < 2; ++bj)
#pragma unroll
            for (int n = 0; n < 2; ++n) { const f32x4 bv = bias ? *(const f32x4*)(bias + col0 + bj * HALF + n * 16) : (f32x4){0.f, 0.f, 0.f, 0.f};
#pragma unroll
                for (int ai = 0; ai < 2; ++ai)
#pragma unroll
                    for (int m = 0; m < 4; ++m) acc[ai][bj][m][n] += bv; }
        f32x4 pre[4][2][2];
#pragma unroll
        for (int m = 0; m < 4; ++m) { const size_t off = (size_t)(u.pm * BM + wr * 64 + m * 16 + fr) * ldc + col0;
#pragma unroll
            for (int bj = 0; bj < 2; ++bj)
#pragma unroll
                for (int n = 0; n < 2; ++n) pre[m][bj][n] = *(const f32x4*)(base + off + bj * HALF + n * 16); }
        const bool bad = st.run(acc, u, wr, wc, fr, fq, lds, wid, lane) || poison != 0u;
        const float qnan = __builtin_nanf("");
#pragma unroll
        for (int ai = 0; ai < 2; ++ai)
#pragma unroll
            for (int m = 0; m < 4; ++m) { const int r = ai * HALF + wr * 64 + m * 16 + fr; const f32x2v sr = S[r]; const size_t off = (size_t)(u.pm * BM + r) * ldc + col0;
#pragma unroll
                for (int bj = 0; bj < 2; ++bj)
#pragma unroll
                    for (int n = 0; n < 2; ++n) { const f32x4 bs = ai == 0 ? pre[m][bj][n] : *(const f32x4*)(base + off + bj * HALF + n * 16); f32x4 o = bs + (acc[ai][bj][m][n] - sr.x) * sr.y;
                        if (bad) o = (f32x4){qnan, qnan, qnan, qnan}; *(f32x4*)(out + off + bj * HALF + n * 16) = o; }
                if (m & 1) asm volatile("" ::: "memory"); }
    }
};
struct EpiLnResLn {
    static constexpr bool PERM = false, AFTER_DRAIN = true;
    const float* base; float* out; bf16_t* xn; int ldc; const float* bias; PanelStats st1, st2; unsigned poison;
    __device__ __forceinline__ void fused(f32x4 (&acc)[2][2][4][2], const Unit& u, int wr, int wc, int fr, int fq, PG8_LAS unsigned char* lds, int wid, int lane) const {
        typedef float f32x2v __attribute__((ext_vector_type(2))); typedef unsigned u32x2v __attribute__((ext_vector_type(2)));
        const PG8_LAS f32x2v* S = (const PG8_LAS f32x2v*)(lds + 8192);
        const int col0 = u.pn * BM + wc * 32 + 4 * fq;
#pragma unroll
        for (int bj = 0; bj < 2; ++bj)
#pragma unroll
            for (int n = 0; n < 2; ++n) { const f32x4 bv = bias ? *(const f32x4*)(bias + col0 + bj * HALF + n * 16) : (f32x4){0.f, 0.f, 0.f, 0.f};
#pragma unroll
                for (int ai = 0; ai < 2; ++ai)
#pragma unroll
                    for (int m = 0; m < 4; ++m) acc[ai][bj][m][n] += bv; }
        bool bad = st1.run(acc, u, wr, wc, fr, fq, lds, wid, lane) || poison != 0u;
        const float qnan = __builtin_nanf("");
#pragma unroll
        for (int ai = 0; ai < 2; ++ai)
#pragma unroll
            for (int m = 0; m < 4; ++m) { const int r = ai * HALF + wr * 64 + m * 16 + fr; const f32x2v sr = S[r]; const size_t off = (size_t)(u.pm * BM + r) * ldc + col0;
#pragma unroll
                for (int bj = 0; bj < 2; ++bj)
#pragma unroll
                    for (int n = 0; n < 2; ++n) { const f32x4 bs = *(const f32x4*)(base + off + bj * HALF + n * 16); acc[ai][bj][m][n] = bs + (acc[ai][bj][m][n] - sr.x) * sr.y; }
                asm volatile("" : "+v"(acc[ai][0][m][0]), "+v"(acc[ai][0][m][1]), "+v"(acc[ai][1][m][0]), "+v"(acc[ai][1][m][1]));
                if (m & 1) asm volatile("" ::: "memory"); }
        const bool bad1 = bad;
        bad = st2.run(acc, u, wr, wc, fr, fq, lds, wid, lane) || bad;
#pragma unroll
        for (int ai = 0; ai < 2; ++ai)
#pragma unroll
            for (int m = 0; m < 4; ++m) { const int r = ai * HALF + wr * 64 + m * 16 + fr; const f32x2v sr = S[r]; const size_t off = (size_t)(u.pm * BM + r) * ldc + col0;
#pragma unroll
                for (int bj = 0; bj < 2; ++bj)
#pragma unroll
                    for (int n = 0; n < 2; ++n) { const f32x4 x1 = acc[ai][bj][m][n]; *(f32x4*)(out + off + bj * HALF + n * 16) = bad1 ? (f32x4){qnan, qnan, qnan, qnan} : x1;
                        const f32x4 o = (x1 - sr.x) * sr.y; u32x2v w; w.x = cvt_pk_bf16(o[0], o[1]); w.y = cvt_pk_bf16(o[2], o[3]);
                        if (bad) { w.x = 0x7fc07fc0u; w.y = 0x7fc07fc0u; } *(u32x2v*)(xn + off + bj * HALF + n * 16) = w; }
                asm volatile("" ::: "memory"); }
    }
};

template <class Epi, class Sched, bool ALIGN_EPI = false, bool SP2 = false>
__device__ __forceinline__ void gemm_phase(PG8_LAS unsigned char* lds, const Gemm g, const Sched& S, const Epi& E) {
    int tid_l = threadIdx.x; asm volatile("" : "+v"(tid_l));
    const int tid = tid_l, wid = __builtin_amdgcn_readfirstlane(tid >> 6), lane = tid & 63, wr = wid >> 2, wc = wid & 3, fr = lane & 15, fq = lane >> 4;
    const int K = g.K, nt = K / BK;
    unsigned voffA[2], voffB[2];
#pragma unroll
    for (int i = 0; i < 2; ++i) { int R, C; stage_rc(tid * 16 + i * 8192, R, C); const int Rb = Epi::PERM ? ((R & ~31) + perm32(R & 31)) : R;
        voffA[i] = (unsigned)(R * K + C) * 2u; voffB[i] = (unsigned)(Rb * K + C) * 2u; }
    const size_t kstep = (size_t)(BK * 2);
    const size_t hstep = (size_t)HALF * K * 2;
    const size_t tstep = 2 * hstep;
    const unsigned ldsw = (unsigned)wid * 1024u;
    const int aoff = lds_byte(wr * 64 + fr, fq * 8), boff = lds_byte(wc * 32 + fr, fq * 8);
#define PG8_SA(b, h) (((b) * 2 + (h)) * HTB)
#define PG8_SB(b, h) ((4 + (b) * 2 + (h)) * HTB)
#define PG8_STAGE(bufoff, gbase, voff) do { _Pragma("unroll") for (int _i = 0; _i < 2; ++_i) \
        __builtin_amdgcn_global_load_lds((const unsigned*)((const char*)(gbase) + (voff)[_i]), (PG8_LAS unsigned*)(lds + (bufoff) + ldsw + _i * 8192), 16, 0, 0); } while (0)
#define PG8_LDA(dst, b, h) do { _Pragma("unroll") for (int m = 0; m < 4; ++m) _Pragma("unroll") for (int k = 0; k < 2; ++k) dst[m][k] = *(const PG8_LAS bf16x8*)(lds + PG8_SA(b, h) + aoff + m * 2048 + k * 1024); } while (0)
#define PG8_LDB(dst, b, h) do { _Pragma("unroll") for (int n = 0; n < 2; ++n) _Pragma("unroll") for (int k = 0; k < 2; ++k) dst[n][k] = *(const PG8_LAS bf16x8*)(lds + PG8_SB(b, h) + boff + n * 2048 + k * 1024); } while (0)
#define PG8_MMA(ai, bj, At, Bt) do { __builtin_amdgcn_s_setprio(1); _Pragma("unroll") for (int m = 0; m < 4; ++m) _Pragma("unroll") for (int n = 0; n < 2; ++n) _Pragma("unroll") for (int k = 0; k < 2; ++k) \
        acc[ai][bj][m][n] = __builtin_amdgcn_mfma_f32_16x16x32_bf16(Bt[n][k], At[m][k], acc[ai][bj][m][n], 0, 0, 0); __builtin_amdgcn_s_setprio(0); } while (0)
#define PG8_WAIT_V(n) asm volatile("s_waitcnt vmcnt(" #n ")" ::: "memory")
#define PG8_WAIT_L(n) asm volatile("s_waitcnt lgkmcnt(" #n ")" ::: "memory")
#define PG8_BAR __builtin_amdgcn_s_barrier()
#define PG8_SCHED __builtin_amdgcn_sched_barrier(0)
    Unit cur, nxt; int ui = 0;
    if (!S.next(0, cur)) return;
    f32x4 acc[2][2][4][2];
#pragma unroll
    for (int a = 0; a < 2; ++a)
#pragma unroll
        for (int b = 0; b < 2; ++b)
#pragma unroll
            for (int m = 0; m < 4; ++m)
#pragma unroll
                for (int n = 0; n < 2; ++n) acc[a][b][m][n] = (f32x4){0.f, 0.f, 0.f, 0.f};
    bf16x8 At[4][2], B0[2][2], B1[2][2];
    const char* cA = (const char*)g.A + (size_t)cur.pm * tstep; const char* cB = (const char*)g.Bt + (size_t)cur.pn * tstep;
    S.a_ready(cur);
    if constexpr (SP2) {
        PG8_STAGE(PG8_SB(0, 0), cB, voffB); PG8_STAGE(PG8_SB(0, 1), cB + hstep, voffB); PG8_STAGE(PG8_SA(0, 0), cA, voffA); PG8_STAGE(PG8_SA(0, 1), cA + hstep, voffA);
        if (wr == 1) PG8_BAR;
        PG8_WAIT_V(2); PG8_BAR;
        PG8_STAGE(PG8_SB(1, 0), cB + kstep, voffB); PG8_STAGE(PG8_SA(1, 0), cA + kstep, voffA); PG8_STAGE(PG8_SB(1, 1), cB + hstep + kstep, voffB);
        PG8_WAIT_V(6); PG8_BAR;
    } else {
        PG8_STAGE(PG8_SB(0, 0), cB, voffB); PG8_STAGE(PG8_SA(0, 0), cA, voffA); PG8_STAGE(PG8_SB(0, 1), cB + hstep, voffB); PG8_STAGE(PG8_SA(0, 1), cA + hstep, voffA);
        if (wr == 1) PG8_BAR;
        PG8_WAIT_V(4); PG8_BAR;
        PG8_STAGE(PG8_SB(1, 0), cB + kstep, voffB); PG8_STAGE(PG8_SA(1, 0), cA + kstep, voffA); PG8_STAGE(PG8_SB(1, 1), cB + hstep + kstep, voffB);
        PG8_WAIT_V(6); PG8_BAR;
    }
    for (;;) {
        const bool has_next = S.next(ui + 1, nxt);
        const char* nA = has_next ? (const char*)g.A + (size_t)nxt.pm * tstep : cA; const char* nB = has_next ? (const char*)g.Bt + (size_t)nxt.pn * tstep : cB;
        for (int t = 0; t < nt; t += 2) {
            const bool last = (t == nt - 2);
            const char* a1 = cA + (size_t)(t + 1) * kstep;
            const char* a2 = last ? nA : cA + (size_t)(t + 2) * kstep; const char* b2 = last ? nB : cB + (size_t)(t + 2) * kstep;
            const char* a3 = a2 + kstep; const char* b3 = b2 + kstep;
            if (last && has_next) S.a_ready(nxt);
            if constexpr (SP2) {
            PG8_LDB(B0, 0, 0); PG8_LDB(B1, 0, 1); PG8_SCHED; PG8_LDA(At, 0, 0); PG8_STAGE(PG8_SA(1, 1), a1 + hstep, voffA);
            PG8_WAIT_V(8); PG8_WAIT_L(0); PG8_BAR; PG8_MMA(0, 0, At, B0); PG8_MMA(0, 1, At, B1); PG8_BAR; PG8_SCHED;
            PG8_LDA(At, 0, 1); PG8_STAGE(PG8_SB(0, 0), b2, voffB); PG8_STAGE(PG8_SB(0, 1), b2 + hstep, voffB); PG8_STAGE(PG8_SA(0, 0), a2, voffA);
            PG8_WAIT_V(8); PG8_WAIT_L(0); PG8_BAR; PG8_MMA(1, 0, At, B0); PG8_MMA(1, 1, At, B1); PG8_BAR; PG8_SCHED;
            PG8_LDB(B0, 1, 0); PG8_LDB(B1, 1, 1); PG8_SCHED; PG8_LDA(At, 1, 0); PG8_STAGE(PG8_SA(0, 1), a2 + hstep, voffA);
            PG8_WAIT_V(8); PG8_WAIT_L(0); PG8_BAR; PG8_MMA(0, 0, At, B0); PG8_MMA(0, 1, At, B1); PG8_BAR; PG8_SCHED;
            PG8_LDA(At, 1, 1); PG8_STAGE(PG8_SB(1, 0), b3, voffB); PG8_STAGE(PG8_SB(1, 1), b3 + hstep, voffB); PG8_STAGE(PG8_SA(1, 0), a3, voffA);
            PG8_WAIT_V(8); PG8_WAIT_L(0); PG8_BAR; PG8_MMA(1, 0, At, B0); PG8_MMA(1, 1, At, B1); PG8_BAR; PG8_SCHED;
            } else {
            PG8_LDB(B0, 0, 0); PG8_SCHED; PG8_LDA(At, 0, 0); PG8_STAGE(PG8_SA(1, 1), a1 + hstep, voffA);
            PG8_WAIT_L(8); PG8_BAR; PG8_WAIT_L(0); PG8_MMA(0, 0, At, B0); PG8_BAR; PG8_SCHED;
            PG8_LDB(B1, 0, 1); PG8_STAGE(PG8_SB(0, 0), b2, voffB);
            PG8_BAR; PG8_WAIT_L(0); PG8_MMA(0, 1, At, B1); PG8_BAR;
            PG8_LDA(At, 0, 1); PG8_STAGE(PG8_SA(0, 0), a2, voffA);
            PG8_BAR; PG8_WAIT_L(0); PG8_MMA(1, 0, At, B0); PG8_BAR; PG8_SCHED;
            PG8_STAGE(PG8_SB(0, 1), b2 + hstep, voffB);
            PG8_WAIT_V(6); PG8_BAR; PG8_MMA(1, 1, At, B1); PG8_BAR;
            PG8_LDB(B0, 1, 0); PG8_SCHED; PG8_LDA(At, 1, 0); PG8_STAGE(PG8_SA(0, 1), a2 + hstep, voffA);
            PG8_WAIT_L(8); PG8_BAR; PG8_WAIT_L(0); PG8_MMA(0, 0, At, B0); PG8_BAR; PG8_SCHED;
            PG8_LDB(B1, 1, 1); PG8_STAGE(PG8_SB(1, 0), b3, voffB);
            PG8_BAR; PG8_WAIT_L(0); PG8_MMA(0, 1, At, B1); PG8_BAR;
            PG8_LDA(At, 1, 1); PG8_STAGE(PG8_SA(1, 0), a3, voffA);
            PG8_BAR; PG8_WAIT_L(0); PG8_MMA(1, 0, At, B0); PG8_BAR; PG8_SCHED;
            PG8_STAGE(PG8_SB(1, 1), b3 + hstep, voffB);
            PG8_WAIT_V(6); PG8_BAR; PG8_MMA(1, 1, At, B1); PG8_BAR;
            }
        }
        if constexpr (ALIGN_EPI) { if (wr == 0) PG8_BAR; }
        if constexpr (!Epi::AFTER_DRAIN) { E(acc, cur, wr, wc, fr, fq); S.done(cur); }
        if (!has_next) break;
#pragma unroll
        for (int a = 0; a < 2; ++a)
#pragma unroll
            for (int b = 0; b < 2; ++b)
#pragma unroll
                for (int m = 0; m < 4; ++m)
#pragma unroll
                    for (int n = 0; n < 2; ++n) acc[a][b][m][n] = (f32x4){0.f, 0.f, 0.f, 0.f};
        cur = nxt; cA = nA; cB = nB; ++ui;
        if constexpr (ALIGN_EPI) { if (wr == 1) PG8_BAR; }
    }
    PG8_WAIT_V(0);
    if constexpr (!ALIGN_EPI) { if (wr == 0) PG8_BAR; }
    PG8_BAR;
    if constexpr (Epi::AFTER_DRAIN) { E.fused(acc, cur, wr, wc, fr, fq, lds, wid, lane); S.done(cur); }
#undef PG8_SA
#undef PG8_SB
#undef PG8_STAGE
#undef PG8_LDA
#undef PG8_LDB
#undef PG8_MMA
#undef PG8_WAIT_V
#undef PG8_WAIT_L
#undef PG8_BAR
#undef PG8_SCHED
}
}
namespace pg8 {
struct EpiSwiGLU {
    static constexpr bool PERM = true, AFTER_DRAIN = false;
    bf16_t* O; int ldc;
    __device__ __forceinline__ void operator()(const f32x4 (&acc)[2][2][4][2], const Unit& u, int wr, int wc, int fr, int fq) const {
        const int row0 = u.pm * BM + wr * 64 + fr, col0 = u.pn * HALF + wc * 32 + 8 * fq;
#pragma unroll
        for (int ai = 0; ai < 2; ++ai)
#pragma unroll
            for (int m = 0; m < 4; ++m) { bf16_t* rowp = O + (size_t)(row0 + ai * HALF + m * 16) * ldc + col0;
                float v[8];
#pragma unroll
                for (int n = 0; n < 2; ++n)
#pragma unroll
                    for (int j = 0; j < 4; ++j) { const float g = acc[ai][0][m][n][j], up = acc[ai][1][m][n][j];
                        const float e = __builtin_amdgcn_exp2f(g * -1.4426950408889634f); v[4 * n + j] = g * __builtin_amdgcn_rcpf(1.0f + e) * up; }
                u32x4 w; w.x = cvt_pk_bf16(v[0], v[1]); w.y = cvt_pk_bf16(v[2], v[3]); w.z = cvt_pk_bf16(v[4], v[5]); w.w = cvt_pk_bf16(v[6], v[7]);
                __builtin_nontemporal_store(w, (u32x4*)rowp); }
    }
};
struct EpiResid {
    static constexpr bool PERM = true, AFTER_DRAIN = false;
    bf16_t* X; int ldc; float alpha;
    __device__ __forceinline__ void operator()(const f32x4 (&acc)[2][2][4][2], const Unit& u, int wr, int wc, int fr, int fq) const {
        const int row0 = u.pm * BM + wr * 64 + fr, col0 = u.pn * BM + wc * 32 + 8 * fq;
#pragma unroll
        for (int ai = 0; ai < 2; ++ai)
#pragma unroll
            for (int m = 0; m < 4; ++m) { bf16_t* rowp = X + (size_t)(row0 + ai * HALF + m * 16) * ldc + col0;
#pragma unroll
                for (int bj = 0; bj < 2; ++bj) { const u32x4 x = *(const u32x4*)(rowp + bj * HALF);
                    const f32x4 a0 = acc[ai][bj][m][0], a1 = acc[ai][bj][m][1];
                    float r[8];
                    r[0] = alpha * __uint_as_float(x.x << 16) + a0[0]; r[1] = alpha * __uint_as_float(x.x & 0xffff0000u) + a0[1];
                    r[2] = alpha * __uint_as_float(x.y << 16) + a0[2]; r[3] = alpha * __uint_as_float(x.y & 0xffff0000u) + a0[3];
                    r[4] = alpha * __uint_as_float(x.z << 16) + a1[0]; r[5] = alpha * __uint_as_float(x.z & 0xffff0000u) + a1[1];
                    r[6] = alpha * __uint_as_float(x.w << 16) + a1[2]; r[7] = alpha * __uint_as_float(x.w & 0xffff0000u) + a1[3];
                    u32x4 w; w.x = cvt_pk_bf16(r[0], r[1]); w.y = cvt_pk_bf16(r[2], r[3]); w.z = cvt_pk_bf16(r[4], r[5]); w.w = cvt_pk_bf16(r[6], r[7]);
                    *(u32x4*)(rowp + bj * HALF) = w; } }
    }
};
}
#define LAS __attribute__((address_space(3)))
typedef unsigned short bf16;
typedef short bf16x8 __attribute__((ext_vector_type(8)));
typedef short s16x4 __attribute__((ext_vector_type(4)));
typedef float f32x4 __attribute__((ext_vector_type(4)));
typedef float f32x16 __attribute__((ext_vector_type(16)));
typedef unsigned v4u __attribute__((ext_vector_type(4)));
typedef unsigned v2u __attribute__((ext_vector_type(2)));

constexpr int NWAVES = 8, NTHR = 512;
constexpr int BATCH = 8, SEQ = 4096, DM = 1024, M = BATCH * SEQ;
constexpr int NQ0 = 2560;
constexpr int C_QA = 0, C_CKV = 512, C_QIDX = 640, C_KIDX = 896, C_QB = 960, C_KB = 1472, C_VB = 1984, C_WIDX = 2496;
constexpr int KO0 = 1024;
constexpr int DFF = 2816, NGU = 2 * DFF;
constexpr int NQ1 = 3072;
constexpr int TOPK = 256;
constexpr float LOG2E = 1.4426950408889634f;
constexpr float C2 = 0.125f * LOG2E;
constexpr float ALPHA = 1.4142135623730951f;

constexpr size_t MiB = 1u << 20;
constexpr size_t WS_W0IN = 1 * MiB, WS_W0OUT = 7 * MiB, WS_WGU0 = 10 * MiB, WS_WGU1 = 21 * MiB, WS_WDN0 = 32 * MiB, WS_WDN1 = 38 * MiB, WS_W1IN = 44 * MiB, WS_W1OUT = 50 * MiB;
constexpr size_t WS_KMEAN = 52 * MiB, WS_ALLOW = 53 * MiB, WS_KN2 = 55 * MiB, WS_WUKT = 55 * MiB + 262144, WS_WUVT = 55 * MiB + 524288, WS_CKVN = 56 * MiB, WS_X = 64 * MiB, WS_R1 = 128 * MiB, WS_OCAT = 320 * MiB, WS_KIDXC = 416 * MiB, WS_END = 420 * MiB;

constexpr int LDS_BYTES = 163840;

__device__ __forceinline__ unsigned f2bf(float f) { unsigned u = __builtin_bit_cast(unsigned, f); return (u + 0x7fffu + ((u >> 16) & 1u)) >> 16; }
__device__ __forceinline__ unsigned pk2(float lo, float hi) { return f2bf(lo) | (f2bf(hi) << 16); }
__device__ __forceinline__ float bflo(unsigned w) { return __uint_as_float(w << 16); }
__device__ __forceinline__ float bfhi(unsigned w) { return __uint_as_float(w & 0xffff0000u); }
__device__ __forceinline__ float bf1(unsigned short h) { return __uint_as_float(((unsigned)h) << 16); }
#define LDS_WAIT() asm volatile("s_waitcnt lgkmcnt(0)" ::: "memory")
__device__ __forceinline__ float wave_sum(float v) {
    v += __builtin_bit_cast(float, __builtin_amdgcn_update_dpp(0, __builtin_bit_cast(int, v), 0xB1, 0xf, 0xf, false));
    v += __builtin_bit_cast(float, __builtin_amdgcn_update_dpp(0, __builtin_bit_cast(int, v), 0x4E, 0xf, 0xf, false));
    v += __builtin_bit_cast(float, __builtin_amdgcn_update_dpp(0, __builtin_bit_cast(int, v), 0x124, 0xf, 0xf, false));
    v += __builtin_bit_cast(float, __builtin_amdgcn_update_dpp(0, __builtin_bit_cast(int, v), 0x128, 0xf, 0xf, false));
    const float a = __builtin_bit_cast(float, __builtin_amdgcn_readlane(__builtin_bit_cast(int, v), 0)), b = __builtin_bit_cast(float, __builtin_amdgcn_readlane(__builtin_bit_cast(int, v), 16));
    const float c = __builtin_bit_cast(float, __builtin_amdgcn_readlane(__builtin_bit_cast(int, v), 32)), d = __builtin_bit_cast(float, __builtin_amdgcn_readlane(__builtin_bit_cast(int, v), 48));
    return (a + b) + (c + d);
}
__device__ __forceinline__ int crow(int r, int hi) { return (r & 3) + 8 * (r >> 2) + 4 * hi; }

__device__ __forceinline__ void tr_item(const float* W, int ldsrc, int k0, int c0, int cvalid, bf16* WT, int lddst, int r0, int dk0, float scale, LAS float* scr, int lane) {
#pragma unroll 8
    for (int i = 0; i < 32; ++i) { const int kk = 2 * i + (lane >> 5), c = lane & 31;
        scr[kk * 33 + c] = (c < cvalid) ? __builtin_nontemporal_load(W + (size_t)(k0 + kk) * ldsrc + c0 + c) * scale : 0.f; }
    LDS_WAIT(); asm volatile("" ::: "memory");
    const int c8 = lane & 7;
#pragma unroll
    for (int j = 0; j < 4; ++j) { const int n = (lane >> 3) + 8 * j; const LAS float* s = scr + (8 * c8) * 33 + n;
        v4u o; o.x = pk2(s[0 * 33], s[1 * 33]); o.y = pk2(s[2 * 33], s[3 * 33]); o.z = pk2(s[4 * 33], s[5 * 33]); o.w = pk2(s[6 * 33], s[7 * 33]);
        *(v4u*)(WT + (size_t)(r0 + n) * lddst + dk0 + k0 + 8 * c8) = o; }
    LDS_WAIT(); asm volatile("" ::: "memory");
}
__device__ __forceinline__ void tr_job(const float* W, int ldsrc, int K, int cs, int ncols, int nvalid, bf16* WT, int lddst, int r0, int dk0, float scale, int mode,
                                       LAS float* scr, int lane, int gw, int NGW, int& rot) {
    const int ncg = ncols / 32, nitems = (K / 64) * ncg;
    int start = gw - rot; if (start < 0) start += NGW;
    for (int it = start; it < nitems; it += NGW) {
        const int kb = it / ncg, cg_ = it % ncg, crel = 32 * cg_;
        const int cv = nvalid - crel < 0 ? 0 : (nvalid - crel > 32 ? 32 : nvalid - crel);
        const int col = cs + crel;
        const int row = mode == 0 ? r0 + crel : 256 * (col / 128) + 128 * (mode - 1) + (col % 128);
        tr_item(W, ldsrc, 64 * kb, col, cv, WT, lddst, row, dk0, scale, scr, lane);
    }
    rot = (rot + nitems) % NGW;
}

template <bool FINAL> __device__ __forceinline__ void ln_row(bf16* xrow, const float* g, const float* bta, float* orow, int lane) {
    const v4u* xp = (const v4u*)xrow; v4u w[2]; float v[16]; float s = 0.f;
#pragma unroll
    for (int j = 0; j < 2; ++j) { w[j] = xp[lane + 64 * j];
        v[8 * j + 0] = bflo(w[j].x); v[8 * j + 1] = bfhi(w[j].x); v[8 * j + 2] = bflo(w[j].y); v[8 * j + 3] = bfhi(w[j].y);
        v[8 * j + 4] = bflo(w[j].z); v[8 * j + 5] = bfhi(w[j].z); v[8 * j + 6] = bflo(w[j].w); v[8 * j + 7] = bfhi(w[j].w); }
#pragma unroll
    for (int i = 0; i < 16; ++i) s += v[i];
    const float mean = wave_sum(s) * (1.f / DM); float s2 = 0.f;
#pragma unroll
    for (int i = 0; i < 16; ++i) { v[i] -= mean; s2 += v[i] * v[i]; }
    const float rstd = 1.f / sqrtf(wave_sum(s2) * (1.f / DM) + 1e-5f);
#pragma unroll
    for (int j = 0; j < 2; ++j) { const int c0 = 8 * (lane + 64 * j);
        const f32x4 g0 = *(const f32x4*)(g + c0), g1 = *(const f32x4*)(g + c0 + 4), b0 = *(const f32x4*)(bta + c0), b1 = *(const f32x4*)(bta + c0 + 4);
        float r[8];
#pragma unroll
        for (int i = 0; i < 4; ++i) { r[i] = v[8 * j + i] * rstd * g0[i] + b0[i]; r[4 + i] = v[8 * j + 4 + i] * rstd * g1[i] + b1[i]; }
        if (FINAL) { __builtin_nontemporal_store((f32x4){r[0], r[1], r[2], r[3]}, (f32x4*)(orow + c0)); __builtin_nontemporal_store((f32x4){r[4], r[5], r[6], r[7]}, (f32x4*)(orow + c0 + 4)); }
        else { v4u o; o.x = pk2(r[0], r[1]); o.y = pk2(r[2], r[3]); o.z = pk2(r[4], r[5]); o.w = pk2(r[6], r[7]); ((v4u*)xrow)[lane + 64 * j] = o; } }
}

__device__ __forceinline__ void stick_unit(const bf16* QKV, bf16* OCAT, int b, int h, int qt, int lane) {
    const int r32 = lane & 31, hi = lane >> 5, q0 = qt * 32, t = q0 + r32; const size_t rowb = (size_t)b * SEQ;
    bf16x8 qf[4];
    { const bf16* qp = QKV + (rowb + q0 + r32) * NQ0 + C_QB + h * 64 + hi * 8;
#pragma unroll
      for (int ks = 0; ks < 4; ++ks) qf[ks] = *(const bf16x8*)(qp + ks * 16); }
    f32x16 o0 = f32x16{}, o1 = f32x16{}; float carry = 0.f;
    for (int kt = qt; kt >= 0; --kt) {
        const int kb = kt * 32;
        const bf16* kp = QKV + (rowb + kb + r32) * NQ0 + C_KB + h * 64 + hi * 8;
        f32x16 z = f32x16{};
#pragma unroll
        for (int ks = 0; ks < 4; ++ks) { const bf16x8 kf = *(const bf16x8*)(kp + ks * 16); z = __builtin_amdgcn_mfma_f32_32x32x16_bf16(kf, qf[ks], z, 0, 0, 0); }
        bf16x8 vf[2][2];
        { const bf16* vp = QKV + (rowb + kb + 4 * hi) * NQ0 + C_VB + h * 64 + r32;
#pragma unroll
          for (int s = 0; s < 2; ++s)
#pragma unroll
            for (int dh = 0; dh < 2; ++dh)
#pragma unroll
              for (int j = 0; j < 8; ++j) vf[s][dh][j] = (short)vp[(size_t)(16 * s + 8 * (j >> 2) + (j & 3)) * NQ0 + 32 * dh]; }
        float l1m[16], L2v[16];
#pragma unroll
        for (int r = 0; r < 16; ++r) { const float zz = z[r], e = __builtin_amdgcn_exp2f(-__builtin_fabsf(zz)), lg = __builtin_amdgcn_logf(1.0f + e);
            const bool strict = (kb + crow(r, hi)) < t;
            L2v[r] = __builtin_fminf(zz, 0.f) - lg;
            l1m[r] = strict ? -(__builtin_fmaxf(zz, 0.f) + lg) : 0.f; }
        float gs[4], ps[4];
#pragma unroll
        for (int j = 0; j < 4; ++j) { gs[j] = (l1m[4 * j] + l1m[4 * j + 1]) + (l1m[4 * j + 2] + l1m[4 * j + 3]);
            auto sw = __builtin_amdgcn_permlane32_swap(__float_as_uint(gs[j]), __float_as_uint(gs[j]), false, false); ps[j] = __uint_as_float(hi ? sw[0] : sw[1]); }
        float a[16]; float above = carry;
#pragma unroll
        for (int j = 3; j >= 0; --j) {
            float rem = above + (hi == 0 ? ps[j] : 0.f);
#pragma unroll
            for (int i = 3; i >= 0; --i) { const int r = 4 * j + i; const bool strict = (kb + crow(r, hi)) < t;
                a[r] = strict ? __builtin_amdgcn_exp2f(L2v[r] + rem) : 0.f; rem += l1m[r]; }
            above += gs[j] + ps[j]; }
        carry = above;
        bf16x8 pa0, pa1;
#pragma unroll
        for (int j = 0; j < 8; ++j) { pa0[j] = (short)f2bf(a[j]); pa1[j] = (short)f2bf(a[8 + j]); }
        o0 = __builtin_amdgcn_mfma_f32_32x32x16_bf16(pa0, vf[0][0], o0, 0, 0, 0); o1 = __builtin_amdgcn_mfma_f32_32x32x16_bf16(pa0, vf[0][1], o1, 0, 0, 0);
        o0 = __builtin_amdgcn_mfma_f32_32x32x16_bf16(pa1, vf[1][0], o0, 0, 0, 0); o1 = __builtin_amdgcn_mfma_f32_32x32x16_bf16(pa1, vf[1][1], o1, 0, 0, 0);
        if (kt > 0 && __all(carry < -48.f)) break;
    }
    bf16* op = OCAT + (rowb + q0) * KO0 + 512 + h * 64 + r32;
#pragma unroll
    for (int r = 0; r < 16; ++r) { op[(size_t)crow(r, hi) * KO0] = (bf16)f2bf(o0[r]); op[(size_t)crow(r, hi) * KO0 + 32] = (bf16)f2bf(o1[r]); }
}

constexpr int IX_HIST = 0, IX_HSTRIDE = 513;
constexpr int IX_STAGE = 0, IX_SROW = 272, IX_SBYTES = 32 * IX_SROW;
#ifndef DSA_RL
#define DSA_RL 96u
#endif
constexpr int IX_CAP = 640;
constexpr int IX_CU = 0;
constexpr int IX_CK = IX_CU + 32 * IX_CAP * 4;
constexpr int IX_MASK = IX_CK + 32 * IX_CAP * 2;
constexpr int IX_ST = IX_MASK + 16384;
constexpr int IX_SEL = IX_ST + 2048;
constexpr int IX_SELSTRIDE = 256;
constexpr int IX_END = IX_SEL + 16384;
constexpr int IX_QL = NWAVES * IX_SBYTES;
static_assert(IX_QL + 65536 <= IX_ST && 32 * IX_HSTRIDE * 4 <= IX_MASK && IX_END <= LDS_BYTES - 64, "indexer LDS map");
enum { ST_LO = 0, ST_HI = 1, ST_NEED = 2, ST_MODE = 3, ST_TGE = 4, ST_TEQ = 5, ST_TI = 6, ST_ILO = 7, ST_IHI = 8, ST_NSEL = 9, ST_BSTAR = 10, ST_CCNT = 11 };

struct IdxTile { float v[16]; };
__device__ __forceinline__ void idx_load(const bf16* KIDXC, size_t rowb, int kt, int r32, int hi, bf16x8 (&kf)[4]) {
    const bf16* kp = KIDXC + (rowb + 32 * kt + r32) * 64 + hi * 8;
#pragma unroll
    for (int ks = 0; ks < 4; ++ks) kf[ks] = *(const bf16x8*)(kp + ks * 16);
}
__device__ __forceinline__ void idx_comp(const bf16x8 (&kf)[4], const bf16x8 (&qf)[4][4], const float (&w)[4], float (&v)[16]) {
#pragma unroll
    for (int r = 0; r < 16; ++r) v[r] = 0.f;
#pragma unroll
    for (int hd = 0; hd < 4; ++hd) { f32x16 d = f32x16{};
#pragma unroll
        for (int ks = 0; ks < 4; ++ks) d = __builtin_amdgcn_mfma_f32_32x32x16_bf16(kf[ks], qf[hd][ks], d, 0, 0, 0);
#pragma unroll
        for (int r = 0; r < 16; ++r) v[r] = __builtin_fmaf(w[hd], __builtin_fmaxf(d[r], 0.f), v[r]);
        }
}
#define IDX_TILE_LOOP_BEGIN() bf16x8 kfn[4]; if (wave <= qt) idx_load(KIDXC, rowb, wave, r32, hi, kfn); \
    _Pragma("unroll 1") for (int kt = wave; kt <= qt; kt += NWAVES) { bf16x8 kfc[4]; \
        _Pragma("unroll") for (int ks_ = 0; ks_ < 4; ++ks_) kfc[ks_] = kfn[ks_]; \
        if (kt + NWAVES <= qt) idx_load(KIDXC, rowb, kt + NWAVES, r32, hi, kfn); \
        float v[16]; idx_comp(kfc, qf, w, v);
__device__ __forceinline__ unsigned okey(float v) {
    unsigned b = __float_as_uint(v); if ((b << 1) == 0u) b = 0u;
    return b ^ ((unsigned)((int)b >> 31) | 0x80000000u);
}
__device__ __forceinline__ unsigned wave_sum_u32(unsigned x) {
    x += (unsigned)__builtin_amdgcn_update_dpp(0, (int)x, 0xB1, 0xf, 0xf, false);
    x += (unsigned)__builtin_amdgcn_update_dpp(0, (int)x, 0x4E, 0xf, 0xf, false);
    x += (unsigned)__builtin_amdgcn_update_dpp(0, (int)x, 0x124, 0xf, 0xf, false);
    x += (unsigned)__builtin_amdgcn_update_dpp(0, (int)x, 0x128, 0xf, 0xf, false);
    return (unsigned)__builtin_amdgcn_readlane((int)x, 0) + (unsigned)__builtin_amdgcn_readlane((int)x, 16) + (unsigned)__builtin_amdgcn_readlane((int)x, 32) + (unsigned)__builtin_amdgcn_readlane((int)x, 48);
}
__device__ __forceinline__ unsigned row_scan_u32(unsigned x) {
    x += (unsigned)__builtin_amdgcn_update_dpp(0, (int)x, 0x111, 0xf, 0xf, false);
    x += (unsigned)__builtin_amdgcn_update_dpp(0, (int)x, 0x112, 0xf, 0xf, false);
    x += (unsigned)__builtin_amdgcn_update_dpp(0, (int)x, 0x114, 0xf, 0xf, false);
    x += (unsigned)__builtin_amdgcn_update_dpp(0, (int)x, 0x118, 0xf, 0xf, false);
    return x;
}
__device__ __forceinline__ unsigned wave_scan_u32(unsigned x, int lane) {
    x = row_scan_u32(x);
    const unsigned t0 = (unsigned)__builtin_amdgcn_readlane((int)x, 15), t1 = (unsigned)__builtin_amdgcn_readlane((int)x, 31), t2 = (unsigned)__builtin_amdgcn_readlane((int)x, 47); const int row = lane >> 4;
    return x + (row >= 1 ? t0 : 0u) + (row >= 2 ? t1 : 0u) + (row >= 3 ? t2 : 0u);
}
__device__ __forceinline__ unsigned cbin(float v, int key) {
    const unsigned b = __float_as_uint(v), a = b & 0x7fffffffu; const unsigned A0 = 107u << 23, A0n = 111u << 23, A1 = (139u << 23) - 1u;
    const unsigned kp = ((a < A0 ? A0 : (a > A1 ? A1 : a)) - A0) >> 19, kn = ((a < A0n ? A0n : (a > A1 ? A1 : a)) - A0n) >> 19;
    const unsigned nz = ((int)b < 0) ? 447u - kn : 512u + kp;
    return a == 0u ? 448u + (63u - ((unsigned)key >> 6)) : nz;
}
__device__ __forceinline__ float cbin_edge(unsigned bin) {
    const unsigned A0 = 107u << 23, A0n = 111u << 23;
    if (bin >= 1024u) return INFINITY;
    if (bin >= 512u) { const unsigned kp = bin - 512u; return kp == 0u ? __uint_as_float(1u) : __uint_as_float(A0 + (kp << 19)); }
    if (bin >= 448u) return __uint_as_float(1u);
    const unsigned kn = 447u - bin; if (kn >= 447u) return -INFINITY;
    return -__uint_as_float(A0n + ((kn + 1u) << 19) - 1u);
}
__device__ __forceinline__ int range_shift(unsigned span) {
    const int bits = 32 - __builtin_clz(span | 1u); return bits > 10 ? bits - 10 : 0;
}

__device__ __forceinline__ void dsa_unit(const bf16* QKV, const bf16* KIDXC, const bf16* CKVN, const bf16* WUKT, const bf16* WUVT, bf16* OCAT, int b, int qt, LAS unsigned char* lds, int tid, int wave, int lane, bool do_att, int secs, unsigned long long& pacc) {
    asm volatile("" : "+v"(tid)); lane = tid & 63;
#ifdef DSA_TSEC
    unsigned long long tprev_ = __builtin_amdgcn_s_memrealtime();
#define TS(k) do { const unsigned long long now_ = __builtin_amdgcn_s_memrealtime(); if ((k) == DSA_TSEC || DSA_TSEC == 9) pacc += now_ - tprev_; tprev_ = now_; } while (0)
#else
#define TS(k) do { } while (0)
#endif
    const int r32 = lane & 31, hi = lane >> 5, q0 = qt * 32, t = q0 + r32; const size_t rowb = (size_t)b * SEQ;
    LAS unsigned* HIST = (LAS unsigned*)(lds + IX_HIST); LAS unsigned* MASK = (LAS unsigned*)(lds + IX_MASK);
    LAS unsigned short* SEL = (LAS unsigned short*)(lds + IX_SEL); LAS unsigned* ST = (LAS unsigned*)(lds + IX_ST);
    LAS unsigned* CU = (LAS unsigned*)(lds + IX_CU); LAS unsigned short* CK = (LAS unsigned short*)(lds + IX_CK);
#define LOAD_QF() bf16x8 qf[4][4]; float w[4]; \
    { const bf16* qp = QKV + (rowb + t) * NQ0; \
      _Pragma("unroll") for (int hd = 0; hd < 4; ++hd) { w[hd] = bf1(qp[C_WIDX + hd]); \
        _Pragma("unroll") for (int ks = 0; ks < 4; ++ks) qf[hd][ks] = *(const bf16x8*)(qp + C_QIDX + hd * 64 + ks * 16 + hi * 8); } }
    const bool select_all = (q0 + 32 <= TOPK);
    bool need_generic = false;
    if (select_all) {
        for (int i = tid; i < 32 * (qt + 1); i += NTHR) { const int q = i / (qt + 1), wd = i % (qt + 1); const int nb = (q0 + q) - 32 * wd + 1;
            MASK[q * 128 + wd] = nb >= 32 ? 0xffffffffu : (nb <= 0 ? 0u : ((1u << nb) - 1u)); }
    } else {
        for (int i = tid; i < 32 * IX_HSTRIDE; i += NTHR) HIST[i] = 0u;
        for (int i = tid; i < 32 * (qt + 1); i += NTHR) MASK[(i / (qt + 1)) * 128 + (i % (qt + 1))] = 0u;
        if (tid < 32) ST[tid * 16 + ST_CCNT] = 0u;
        __syncthreads();
        if (secs & 1) { LOAD_QF();
          _Pragma("unroll 1") for (int kt = 4 * wave; kt <= qt; kt += 4 * NWAVES) { bf16x8 kfc[4]; idx_load(KIDXC, rowb, kt, r32, hi, kfc);
              float v[16]; idx_comp(kfc, qf, w, v);
#pragma unroll
              for (int r = 0; r < 16; ++r) { const int key = 32 * kt + crow(r, hi); const unsigned bin = cbin(v[r], key);
                  if (key <= t) __hip_atomic_fetch_add(HIST + r32 * IX_HSTRIDE + (bin >> 1), (bin & 1u) ? 0x10000u : 1u, __ATOMIC_RELAXED, __HIP_MEMORY_SCOPE_WORKGROUP); }
          } }
        __syncthreads(); TS(1);
        { const int q = tid >> 4, sub = tid & 15; LAS unsigned* s = ST + q * 16;
          const LAS unsigned* hq = HIST + q * IX_HSTRIDE + sub * 32; unsigned csum = 0;
#pragma unroll 8
          for (int i = 0; i < 32; ++i) { const unsigned x = hq[i]; csum += (x & 0xffffu) + (x >> 16); }
          const unsigned incl = row_scan_u32(csum);
          const unsigned total = __shfl(incl, 15, 16); const unsigned sufx = total - incl, need = DSA_RL;
          const bool isf = (total >= need) && (sufx < need) && (need <= sufx + csum);
          const unsigned long long fm = __ballot(isf); const unsigned rowbits = (unsigned)(fm >> (16 * (lane >> 4))) & 0xffffu;
          if (total < need) { if (sub == 0) s[ST_BSTAR] = 0u; }
          else { const int f = __builtin_ctz(rowbits | 0x10000u);
              const unsigned base = __shfl(sufx, f, 16);
              const LAS unsigned* hf = HIST + q * IX_HSTRIDE + f * 32 + (30 - 2 * sub);
              const unsigned x1 = hf[1], x0 = hf[0]; const unsigned c3 = x1 >> 16, c2 = x1 & 0xffffu, c1 = x0 >> 16, c0 = x0 & 0xffffu;
              const unsigned s4 = (c3 + c2) + (c1 + c0); const unsigned in4 = row_scan_u32(s4); const unsigned above = base + in4 - s4;
              if (above < need && need <= above + s4) { int bsel = 60 - 4 * sub; unsigned cum = above;
                  if (cum + c3 >= need) bsel += 3; else { cum += c3; if (cum + c2 >= need) bsel += 2; else { cum += c2; if (cum + c1 >= need) bsel += 1; } }
                  s[ST_BSTAR] = (unsigned)(f * 64 + bsel); } } }
        __syncthreads(); TS(2);
        if (secs & 2) { const unsigned lbin = ST[r32 * 16 + ST_BSTAR]; const float thL = cbin_edge(lbin);
          LOAD_QF();
          IDX_TILE_LOOP_BEGIN() unsigned flags = 0u;
              const bool zc = (448u + (63u - ((unsigned)kt >> 1))) >= lbin; const int lim = (kt == qt) ? t : 0x7fffffff;
#pragma unroll
              for (int r = 0; r < 16; ++r) { const int key = 32 * kt + crow(r, hi); const float x = v[r]; flags |= (key <= lim && (x == 0.f ? zc : x >= thL)) ? (1u << r) : 0u; }
              const unsigned cnt = (unsigned)__builtin_popcount(flags);
              unsigned pos = 0u; if (cnt) pos = __hip_atomic_fetch_add(ST + r32 * 16 + ST_CCNT, cnt, __ATOMIC_RELAXED, __HIP_MEMORY_SCOPE_WORKGROUP);
#pragma unroll
              for (int r = 0; r < 16; ++r) { if ((flags >> r) & 1u) { if (pos < (unsigned)IX_CAP) { CU[r32 * IX_CAP + pos] = __float_as_uint(v[r]); CK[r32 * IX_CAP + pos] = (unsigned short)(32 * kt + crow(r, hi)); } ++pos; } }
          } }
        __syncthreads(); TS(3);
        { bool bad = false;
#pragma unroll 4
          for (int q = 0; q < 32; ++q) { const unsigned c = ST[q * 16 + ST_CCNT]; bad = bad || (c > (unsigned)IX_CAP) || (c < (unsigned)TOPK); }
#ifdef DSA_NO_FALLBACK
          need_generic = false; (void)bad; }
#else
          need_generic = bad; }
#endif
        if (!need_generic && (secs & 4)) {
            int cmax = 0;
#pragma unroll
            for (int qq = 0; qq < 4; ++qq) { const int C = (int)ST[(wave * 4 + qq) * 16 + ST_CCNT]; cmax = C > cmax ? C : cmax; }
#define DSA_SELECT(NR) do { unsigned u[4][NR], k[4][NR]; \
            _Pragma("unroll") for (int qq = 0; qq < 4; ++qq) { const int q = wave * 4 + qq; const int C = (int)ST[q * 16 + ST_CCNT]; \
                _Pragma("unroll") for (int i = 0; i < NR; ++i) { const int idx = lane + 64 * i; const bool ok = idx < C; u[qq][i] = ok ? okey(__uint_as_float(CU[q * IX_CAP + idx])) : 0u; k[qq][i] = ok ? (unsigned)CK[q * IX_CAP + idx] : 0xffffu; } } \
            unsigned T0 = 0u, T1 = 0u, T2 = 0u, T3 = 0u; \
            for (int bit = 31; bit >= 0; --bit) { const unsigned c0 = T0 | (1u << bit), c1 = T1 | (1u << bit), c2 = T2 | (1u << bit), c3 = T3 | (1u << bit); unsigned n01 = 0u, n23 = 0u; \
                _Pragma("unroll") for (int i = 0; i < NR; ++i) { n01 += (u[0][i] >= c0 ? 1u : 0u) + (u[1][i] >= c1 ? 0x10000u : 0u); n23 += (u[2][i] >= c2 ? 1u : 0u) + (u[3][i] >= c3 ? 0x10000u : 0u); } \
                n01 = wave_sum_u32(n01); n23 = wave_sum_u32(n23); \
                if ((n01 & 0xffffu) >= (unsigned)TOPK) T0 = c0; if ((n01 >> 16) >= (unsigned)TOPK) T1 = c1; if ((n23 & 0xffffu) >= (unsigned)TOPK) T2 = c2; if ((n23 >> 16) >= (unsigned)TOPK) T3 = c3; } \
            _Pragma("unroll") for (int qq = 0; qq < 4; ++qq) { const int q = wave * 4 + qq; const unsigned T = qq == 0 ? T0 : qq == 1 ? T1 : qq == 2 ? T2 : T3; unsigned ng = 0u; \
                _Pragma("unroll") for (int i = 0; i < NR; ++i) ng += (u[qq][i] > T ? 1u : 0u) + (u[qq][i] == T ? 0x10000u : 0u); \
                ng = wave_sum_u32(ng); \
                const int needt = TOPK - (int)(ng & 0xffffu), ceq = (int)(ng >> 16); unsigned Kth = 0xffffu; \
                if (ceq != needt) { Kth = 0u;                     \
                    for (int bit = 11; bit >= 0; --bit) { const unsigned cand = Kth | (1u << bit); unsigned c = 0u; \
                        _Pragma("unroll") for (int i = 0; i < NR; ++i) c += (u[qq][i] == T && k[qq][i] < cand) ? 1u : 0u; \
                        c = wave_sum_u32(c); \
                        if ((int)c < needt) Kth = cand; } } \
                _Pragma("unroll") for (int i = 0; i < NR; ++i) { if (u[qq][i] > T || (u[qq][i] == T && k[qq][i] <= Kth && u[qq][i] != 0u)) \
                        __hip_atomic_fetch_or(MASK + q * 128 + (k[qq][i] >> 5), 1u << (k[qq][i] & 31u), __ATOMIC_RELAXED, __HIP_MEMORY_SCOPE_WORKGROUP); } \
            } } while (0)
            if (cmax <= 448) DSA_SELECT(7); else DSA_SELECT(10);
#undef DSA_SELECT
        }
    }
    if (need_generic) {
        __syncthreads();
    if (tid < 32) { LAS unsigned* s = ST + tid * 16;
        unsigned z_ = 0u; asm volatile("" : "+v"(z_));
        s[ST_LO] = z_; s[ST_HI] = ~z_; s[ST_NEED] = z_ + TOPK; s[ST_MODE] = z_; s[ST_TGE] = z_; s[ST_TEQ] = z_; s[ST_TI] = z_ + 0xffffu; s[ST_ILO] = z_; s[ST_IHI] = (unsigned)(q0 + tid); }
    __syncthreads();
    for (int pass = 0; pass < 12; ++pass) {
        bool alldone = true;
#pragma unroll 4
        for (int q = 0; q < 32; ++q) alldone = alldone && (ST[q * 16 + ST_MODE] == 2u);
        if (alldone) break;
        for (int i = tid; i < 32 * IX_HSTRIDE; i += NTHR) HIST[i] = 0u;
        const unsigned mode = ST[r32 * 16 + ST_MODE], lo = ST[r32 * 16 + ST_LO], hi_u = ST[r32 * 16 + ST_HI], ilo = ST[r32 * 16 + ST_ILO], ihi = ST[r32 * 16 + ST_IHI];
        const bool usek = (mode == 1u); const unsigned ulo = lo, uspan = (mode == 0u) ? hi_u - lo : 0u, klo = (mode == 2u) ? 0xffffffffu : (usek ? ilo : 0u), kspan = usek ? ihi - ilo : ((mode == 2u) ? 0u : 0xffffffffu);
        const int bsh = usek ? range_shift(ihi - ilo) : range_shift(hi_u - lo);
        __syncthreads();
        { LOAD_QF();
        IDX_TILE_LOOP_BEGIN()
#pragma unroll
            for (int r = 0; r < 16; ++r) { const unsigned key = (unsigned)(32 * kt + crow(r, hi)); const unsigned u = okey(v[r]);
                const unsigned du = u - ulo, dk = key - klo; const bool hit = (du <= uspan) && (dk <= kspan) && ((int)key <= t);
                const unsigned bin = (usek ? dk : du) >> bsh;
                if (hit) __hip_atomic_fetch_add(HIST + r32 * IX_HSTRIDE + (bin >> 1), (bin & 1u) ? 0x10000u : 1u, __ATOMIC_RELAXED, __HIP_MEMORY_SCOPE_WORKGROUP); }
        } }
        __syncthreads();
        { const int q = tid >> 4, sub = tid & 15; LAS unsigned* s = ST + q * 16; const unsigned md = s[ST_MODE];
          const LAS unsigned* hq = HIST + q * IX_HSTRIDE + sub * 32; unsigned csum = 0;
#pragma unroll 8
          for (int i = 0; i < 32; ++i) { const unsigned x = hq[i]; csum += (x & 0xffffu) + (x >> 16); }
          unsigned incl = csum;
#pragma unroll
          for (int o = 1; o < 16; o <<= 1) { const unsigned y = __shfl_up(incl, o, 16); if (sub >= o) incl += y; }
          const unsigned total = __shfl(incl, 15, 16);
          const unsigned need = s[ST_NEED];
          if (md == 0u) {
              const unsigned sufx = total - incl;
              if (sufx < need && need <= sufx + csum) {
                  const unsigned lo_ = s[ST_LO], hi_ = s[ST_HI]; const int sh_ = range_shift(hi_ - lo_);
                  unsigned cum = sufx; int bsel = 0; unsigned cb = 0;
                  for (int bn = 63; bn >= 0; --bn) { const unsigned x = hq[bn >> 1]; const unsigned c = (bn & 1) ? (x >> 16) : (x & 0xffffu);
                      if (cum + c >= need) { bsel = bn; cb = c; break; } cum += c; }
                  const unsigned bglob = (unsigned)(sub * 64 + bsel); const unsigned nlo = lo_ + (bglob << sh_); const unsigned wdt = (sh_ >= 32) ? 0xffffffffu : ((1u << sh_) - 1u);
                  const unsigned nhi = (hi_ - nlo < wdt) ? hi_ : nlo + wdt; const unsigned nneed = need - cum;
                  s[ST_LO] = nlo; s[ST_HI] = nhi; s[ST_NEED] = nneed;
                  if (cb == nneed) { s[ST_TGE] = nlo; s[ST_TEQ] = 0u; s[ST_TI] = 0xffffu; s[ST_MODE] = 2u; }
                  else if (nlo == nhi) { s[ST_MODE] = 1u; }
              }
          } else if (md == 1u) {
              const unsigned prefx = incl - csum;
              if (prefx < need && need <= prefx + csum) {
                  const unsigned ilo_ = s[ST_ILO], ihi_ = s[ST_IHI]; const int ish_ = range_shift(ihi_ - ilo_);
                  unsigned cum = prefx; int bsel = 0; unsigned cb = 0;
                  for (int bn = 0; bn < 64; ++bn) { const unsigned x = hq[bn >> 1]; const unsigned c = (bn & 1) ? (x >> 16) : (x & 0xffffu);
                      if (cum + c >= need) { bsel = bn; cb = c; break; } cum += c; }
                  const unsigned bglob = (unsigned)(sub * 64 + bsel); const unsigned nilo = ilo_ + (bglob << ish_); const unsigned wdt = (1u << ish_) - 1u;
                  const unsigned nihi = (ihi_ - nilo < wdt) ? ihi_ : nilo + wdt; const unsigned nneed = need - cum;
                  s[ST_ILO] = nilo; s[ST_IHI] = nihi; s[ST_NEED] = nneed;
                  if (cb == nneed || nilo == nihi) { s[ST_TGE] = s[ST_LO]; s[ST_TEQ] = s[ST_LO]; s[ST_TI] = nihi; s[ST_MODE] = 2u; }
              }
          } }
        __syncthreads();
    }
    { const unsigned tge = ST[r32 * 16 + ST_TGE], teq = ST[r32 * 16 + ST_TEQ], ti = ST[r32 * 16 + ST_TI]; const bool tie = (ti != 0xffffu);
      LOAD_QF();
      IDX_TILE_LOOP_BEGIN() unsigned bits = 0u;
#pragma unroll
          for (int r = 0; r < 16; ++r) { const int key = 32 * kt + crow(r, hi); const unsigned u = okey(v[r]);
              const bool sel = (key <= t) && (u >= tge) && !(tie && u == teq && (unsigned)key > ti);
              bits |= sel ? (1u << crow(r, hi)) : 0u; }
          bits |= __shfl_xor(bits, 32);
          if (hi == 0) MASK[r32 * 128 + kt] = bits; } }
    }
    __syncthreads(); TS(4);
    if (secs & 8) {
        const int w0i = 2 * lane, w1i = 2 * lane + 1; unsigned m0[4], m1[4], cn[4];
#pragma unroll
        for (int qq = 0; qq < 4; ++qq) { const int q = wave * 4 + qq; m0[qq] = (w0i <= qt) ? MASK[q * 128 + w0i] : 0u; m1[qq] = (w1i <= qt) ? MASK[q * 128 + w1i] : 0u;
            cn[qq] = (unsigned)(__builtin_popcount(m0[qq]) + __builtin_popcount(m1[qq])); }
        const unsigned s01 = wave_scan_u32(cn[0] | (cn[1] << 16), lane), s23 = wave_scan_u32(cn[2] | (cn[3] << 16), lane);
        const unsigned tot01 = (unsigned)__builtin_amdgcn_readlane((int)s01, 63), tot23 = (unsigned)__builtin_amdgcn_readlane((int)s23, 63);
#pragma unroll
        for (int qq = 0; qq < 4; ++qq) { const int q = wave * 4 + qq; const unsigned inc = (qq == 0 ? s01 & 0xffffu : qq == 1 ? s01 >> 16 : qq == 2 ? s23 & 0xffffu : s23 >> 16);
            int pos = (int)(inc - cn[qq]); unsigned a0 = m0[qq], a1 = m1[qq];
            while (a0) { const int bpos = __builtin_ctz(a0); a0 &= a0 - 1u; if (pos < TOPK) SEL[q * IX_SELSTRIDE + pos] = (unsigned short)(64 * lane + bpos); ++pos; }
            while (a1) { const int bpos = __builtin_ctz(a1); a1 &= a1 - 1u; if (pos < TOPK) SEL[q * IX_SELSTRIDE + pos] = (unsigned short)(64 * lane + 32 + bpos); ++pos; }
            const unsigned total = (qq == 0 ? tot01 & 0xffffu : qq == 1 ? tot01 >> 16 : qq == 2 ? tot23 & 0xffffu : tot23 >> 16);
            if (lane == 0) ST[q * 16 + ST_NSEL] = total < (unsigned)TOPK ? total : (unsigned)TOPK; } }
    __syncthreads(); TS(5);
    LAS unsigned char* QLb = lds + IX_QL;
    if (do_att) { bf16x8 qb_[4];
      { const bf16* qa = QKV + (rowb + q0 + r32) * NQ0 + C_QA + wave * 64 + hi * 8;
#pragma unroll
        for (int ks = 0; ks < 4; ++ks) qb_[ks] = *(const bf16x8*)(qa + 16 * ks); }
#pragma unroll
      for (int nt = 0; nt < 4; ++nt) { f32x16 d = f32x16{}; const bf16* wp = WUKT + ((size_t)wave * 128 + 32 * nt + r32) * 64 + hi * 8;
#pragma unroll
          for (int ks = 0; ks < 4; ++ks) d = __builtin_amdgcn_mfma_f32_32x32x16_bf16(*(const bf16x8*)(wp + 16 * ks), qb_[ks], d, 0, 0, 0);
#pragma unroll
          for (int j = 0; j < 4; ++j) { v2u wv; wv.x = pk2(d[4 * j], d[4 * j + 1]); wv.y = pk2(d[4 * j + 2], d[4 * j + 3]);
              *(LAS v2u*)(QLb + ((size_t)r32 * 1024 + wave * 128 + 32 * nt + 8 * j + 4 * hi) * 2) = wv; } } }
    __syncthreads(); TS(6);
    if (do_att) { const int c = lane & 15, g = lane >> 4;
      LAS unsigned char* stg = lds + IX_STAGE + wave * IX_SBYTES;
      const float slope2 = (c < 8) ? LOG2E * __builtin_amdgcn_exp2f(-(float)(c + 1)) : 0.f;
      for (int qi = 0; qi < 4; ++qi) { const int q = wave * 4 + qi, tq = q0 + q; const size_t mrow = rowb + tq;
          const int nsel = (int)ST[q * 16 + ST_NSEL]; const int nsteps = (nsel + 31) >> 5;
          bf16x8 ql[4];
#pragma unroll
          for (int ks = 0; ks < 4; ++ks) { ql[ks] = bf16x8{}; if (c < 8) ql[ks] = *(const LAS bf16x8*)(QLb + ((size_t)q * 1024 + c * 128 + 32 * ks + 8 * g) * 2); }
          float mrun = -INFINITY, lrun = 0.f; f32x4 o[8];
#pragma unroll
          for (int dt = 0; dt < 8; ++dt) o[dt] = f32x4{};
          v4u rvA[8], rvB[8], rvC[8];
          {
#pragma unroll
            for (int i = 0; i < 8; ++i) { const int j = 32 * (0) + 4 * i + g; const int key = (j < nsel) ? (int)SEL[q * IX_SELSTRIDE + j] : 0;
                rvA[i] = *(const v4u*)(CKVN + (rowb + key) * 128 + c * 8); }
            if (nsteps > 1) {
#pragma unroll
            for (int i = 0; i < 8; ++i) { const int j = 32 * (1) + 4 * i + g; const int key = (j < nsel) ? (int)SEL[q * IX_SELSTRIDE + j] : 0;
                rvB[i] = *(const v4u*)(CKVN + (rowb + key) * 128 + c * 8); }
            }
            if (nsteps > 2) {
#pragma unroll
            for (int i = 0; i < 8; ++i) { const int j = 32 * (2) + 4 * i + g; const int key = (j < nsel) ? (int)SEL[q * IX_SELSTRIDE + j] : 0;
                rvC[i] = *(const v4u*)(CKVN + (rowb + key) * 128 + c * 8); }
            } }
          for (int st = 0; st < nsteps; st += 3) {
              {
#pragma unroll
              for (int i = 0; i < 8; ++i) *(LAS v4u*)(stg + (4 * i + g) * IX_SROW + c * 16) = rvA[i];
              if (st + 3 < nsteps) {
#pragma unroll
                  for (int i = 0; i < 8; ++i) { const int j = 32 * (st + 3) + 4 * i + g; const int key = (j < nsel) ? (int)SEL[q * IX_SELSTRIDE + j] : 0;
                      rvA[i] = *(const v4u*)(CKVN + (rowb + key) * 128 + c * 8); } }
              float sc[8];
              { const LAS unsigned short* sp = SEL + q * IX_SELSTRIDE + 32 * (st) + 4 * g;
                f32x4 sa = f32x4{}, sb = f32x4{};
#pragma unroll
                for (int ks = 0; ks < 4; ++ks) { const bf16x8 ka = *(const LAS bf16x8*)(stg + c * IX_SROW + (32 * ks + 8 * g) * 2), kb2 = *(const LAS bf16x8*)(stg + (16 + c) * IX_SROW + (32 * ks + 8 * g) * 2);
                    sa = __builtin_amdgcn_mfma_f32_16x16x32_bf16(ka, ql[ks], sa, 0, 0, 0); sb = __builtin_amdgcn_mfma_f32_16x16x32_bf16(kb2, ql[ks], sb, 0, 0, 0); }
#pragma unroll
                for (int jj = 0; jj < 8; ++jj) { const int li = (jj < 4) ? jj : 12 + jj; const int j = 32 * (st) + 4 * g + li;
                    const float raw = (jj < 4) ? sa[jj] : sb[jj - 4]; const float dist = (float)(tq - (int)sp[li]);
                    sc[jj] = (j < nsel) ? raw - slope2 * dist : -INFINITY; } }
              float smax = __builtin_fmaxf(__builtin_fmaxf(__builtin_fmaxf(sc[0], sc[1]), __builtin_fmaxf(sc[2], sc[3])), __builtin_fmaxf(__builtin_fmaxf(sc[4], sc[5]), __builtin_fmaxf(sc[6], sc[7])));
              { auto r16 = __builtin_amdgcn_permlane16_swap(__float_as_uint(smax), __float_as_uint(smax), false, false); smax = __builtin_fmaxf(__uint_as_float(r16[0]), __uint_as_float(r16[1]));
                auto r32_ = __builtin_amdgcn_permlane32_swap(__float_as_uint(smax), __float_as_uint(smax), false, false); smax = __builtin_fmaxf(__uint_as_float(r32_[0]), __uint_as_float(r32_[1])); }
              const float mnew = __builtin_fmaxf(mrun, smax); const float alpha = __builtin_amdgcn_exp2f(mrun - mnew); mrun = mnew;
              bf16x8 pb; float psum = 0.f;
              { float p[8];
#pragma unroll
                for (int jj = 0; jj < 8; ++jj) { p[jj] = __builtin_amdgcn_exp2f(sc[jj] - mnew); psum += p[jj]; }
                typedef float f32x2_t __attribute__((ext_vector_type(2))); typedef __bf16 bf16x2_t __attribute__((ext_vector_type(2)));
#pragma unroll
                for (int jj = 0; jj < 8; jj += 2) { const f32x2_t pv = {p[jj], p[jj + 1]}; const unsigned pk = __builtin_bit_cast(unsigned, __builtin_convertvector(pv, bf16x2_t)); pb[jj] = (short)(pk & 0xffffu); pb[jj + 1] = (short)(pk >> 16); } }
              lrun = lrun * alpha + psum;
              const bool resc = !__all(alpha == 1.0f);
#pragma unroll
              for (int dt = 0; dt < 8; ++dt) { if (resc) o[dt] = o[dt] * alpha;
                  const LAS unsigned char* a0 = stg + (4 * g + (c >> 2)) * IX_SROW + (16 * dt + 4 * (c & 3)) * 2;
                  const s16x4 lo4 = __builtin_bit_cast(s16x4, __builtin_amdgcn_ds_read_tr16_b64_v4i16((LAS s16x4*)a0));
                  const s16x4 hi4 = __builtin_bit_cast(s16x4, __builtin_amdgcn_ds_read_tr16_b64_v4i16((LAS s16x4*)(a0 + 16 * IX_SROW)));
                  const bf16x8 ca = (bf16x8){lo4[0], lo4[1], lo4[2], lo4[3], hi4[0], hi4[1], hi4[2], hi4[3]};
                  o[dt] = __builtin_amdgcn_mfma_f32_16x16x32_bf16(ca, pb, o[dt], 0, 0, 0); }
              LDS_WAIT(); asm volatile("" ::: "memory");
              }
              if (st + 1 < nsteps)
              {
#pragma unroll
              for (int i = 0; i < 8; ++i) *(LAS v4u*)(stg + (4 * i + g) * IX_SROW + c * 16) = rvB[i];
              if (st + 4 < nsteps) {
#pragma unroll
                  for (int i = 0; i < 8; ++i) { const int j = 32 * (st + 4) + 4 * i + g; const int key = (j < nsel) ? (int)SEL[q * IX_SELSTRIDE + j] : 0;
                      rvB[i] = *(const v4u*)(CKVN + (rowb + key) * 128 + c * 8); } }
              float sc[8];
              { const LAS unsigned short* sp = SEL + q * IX_SELSTRIDE + 32 * (st + 1) + 4 * g;
                f32x4 sa = f32x4{}, sb = f32x4{};
#pragma unroll
                for (int ks = 0; ks < 4; ++ks) { const bf16x8 ka = *(const LAS bf16x8*)(stg + c * IX_SROW + (32 * ks + 8 * g) * 2), kb2 = *(const LAS bf16x8*)(stg + (16 + c) * IX_SROW + (32 * ks + 8 * g) * 2);
                    sa = __builtin_amdgcn_mfma_f32_16x16x32_bf16(ka, ql[ks], sa, 0, 0, 0); sb = __builtin_amdgcn_mfma_f32_16x16x32_bf16(kb2, ql[ks], sb, 0, 0, 0); }
#pragma unroll
                for (int jj = 0; jj < 8; ++jj) { const int li = (jj < 4) ? jj : 12 + jj; const int j = 32 * (st + 1) + 4 * g + li;
                    const float raw = (jj < 4) ? sa[jj] : sb[jj - 4]; const float dist = (float)(tq - (int)sp[li]);
                    sc[jj] = (j < nsel) ? raw - slope2 * dist : -INFINITY; } }
              float smax = __builtin_fmaxf(__builtin_fmaxf(__builtin_fmaxf(sc[0], sc[1]), __builtin_fmaxf(sc[2], sc[3])), __builtin_fmaxf(__builtin_fmaxf(sc[4], sc[5]), __builtin_fmaxf(sc[6], sc[7])));
              { auto r16 = __builtin_amdgcn_permlane16_swap(__float_as_uint(smax), __float_as_uint(smax), false, false); smax = __builtin_fmaxf(__uint_as_float(r16[0]), __uint_as_float(r16[1]));
                auto r32_ = __builtin_amdgcn_permlane32_swap(__float_as_uint(smax), __float_as_uint(smax), false, false); smax = __builtin_fmaxf(__uint_as_float(r32_[0]), __uint_as_float(r32_[1])); }
              const float mnew = __builtin_fmaxf(mrun, smax); const float alpha = __builtin_amdgcn_exp2f(mrun - mnew); mrun = mnew;
              bf16x8 pb; float psum = 0.f;
              { float p[8];
#pragma unroll
                for (int jj = 0; jj < 8; ++jj) { p[jj] = __builtin_amdgcn_exp2f(sc[jj] - mnew); psum += p[jj]; }
                typedef float f32x2_t __attribute__((ext_vector_type(2))); typedef __bf16 bf16x2_t __attribute__((ext_vector_type(2)));
#pragma unroll
                for (int jj = 0; jj < 8; jj += 2) { const f32x2_t pv = {p[jj], p[jj + 1]}; const unsigned pk = __builtin_bit_cast(unsigned, __builtin_convertvector(pv, bf16x2_t)); pb[jj] = (short)(pk & 0xffffu); pb[jj + 1] = (short)(pk >> 16); } }
              lrun = lrun * alpha + psum;
              const bool resc = !__all(alpha == 1.0f);
#pragma unroll
              for (int dt = 0; dt < 8; ++dt) { if (resc) o[dt] = o[dt] * alpha;
                  const LAS unsigned char* a0 = stg + (4 * g + (c >> 2)) * IX_SROW + (16 * dt + 4 * (c & 3)) * 2;
                  const s16x4 lo4 = __builtin_bit_cast(s16x4, __builtin_amdgcn_ds_read_tr16_b64_v4i16((LAS s16x4*)a0));
                  const s16x4 hi4 = __builtin_bit_cast(s16x4, __builtin_amdgcn_ds_read_tr16_b64_v4i16((LAS s16x4*)(a0 + 16 * IX_SROW)));
                  const bf16x8 ca = (bf16x8){lo4[0], lo4[1], lo4[2], lo4[3], hi4[0], hi4[1], hi4[2], hi4[3]};
                  o[dt] = __builtin_amdgcn_mfma_f32_16x16x32_bf16(ca, pb, o[dt], 0, 0, 0); }
              LDS_WAIT(); asm volatile("" ::: "memory");
              }
              if (st + 2 < nsteps)
              {
#pragma unroll
              for (int i = 0; i < 8; ++i) *(LAS v4u*)(stg + (4 * i + g) * IX_SROW + c * 16) = rvC[i];
              if (st + 5 < nsteps) {
#pragma unroll
                  for (int i = 0; i < 8; ++i) { const int j = 32 * (st + 5) + 4 * i + g; const int key = (j < nsel) ? (int)SEL[q * IX_SELSTRIDE + j] : 0;
                      rvC[i] = *(const v4u*)(CKVN + (rowb + key) * 128 + c * 8); } }
              float sc[8];
              { const LAS unsigned short* sp = SEL + q * IX_SELSTRIDE + 32 * (st + 2) + 4 * g;
                f32x4 sa = f32x4{}, sb = f32x4{};
#pragma unroll
                for (int ks = 0; ks < 4; ++ks) { const bf16x8 ka = *(const LAS bf16x8*)(stg + c * IX_SROW + (32 * ks + 8 * g) * 2), kb2 = *(const LAS bf16x8*)(stg + (16 + c) * IX_SROW + (32 * ks + 8 * g) * 2);
                    sa = __builtin_amdgcn_mfma_f32_16x16x32_bf16(ka, ql[ks], sa, 0, 0, 0); sb = __builtin_amdgcn_mfma_f32_16x16x32_bf16(kb2, ql[ks], sb, 0, 0, 0); }
#pragma unroll
                for (int jj = 0; jj < 8; ++jj) { const int li = (jj < 4) ? jj : 12 + jj; const int j = 32 * (st + 2) + 4 * g + li;
                    const float raw = (jj < 4) ? sa[jj] : sb[jj - 4]; const float dist = (float)(tq - (int)sp[li]);
                    sc[jj] = (j < nsel) ? raw - slope2 * dist : -INFINITY; } }
              float smax = __builtin_fmaxf(__builtin_fmaxf(__builtin_fmaxf(sc[0], sc[1]), __builtin_fmaxf(sc[2], sc[3])), __builtin_fmaxf(__builtin_fmaxf(sc[4], sc[5]), __builtin_fmaxf(sc[6], sc[7])));
              { auto r16 = __builtin_amdgcn_permlane16_swap(__float_as_uint(smax), __float_as_uint(smax), false, false); smax = __builtin_fmaxf(__uint_as_float(r16[0]), __uint_as_float(r16[1]));
                auto r32_ = __builtin_amdgcn_permlane32_swap(__float_as_uint(smax), __float_as_uint(smax), false, false); smax = __builtin_fmaxf(__uint_as_float(r32_[0]), __uint_as_float(r32_[1])); }
              const float mnew = __builtin_fmaxf(mrun, smax); const float alpha = __builtin_amdgcn_exp2f(mrun - mnew); mrun = mnew;
              bf16x8 pb; float psum = 0.f;
              { float p[8];
#pragma unroll
                for (int jj = 0; jj < 8; ++jj) { p[jj] = __builtin_amdgcn_exp2f(sc[jj] - mnew); psum += p[jj]; }
                typedef float f32x2_t __attribute__((ext_vector_type(2))); typedef __bf16 bf16x2_t __attribute__((ext_vector_type(2)));
#pragma unroll
                for (int jj = 0; jj < 8; jj += 2) { const f32x2_t pv = {p[jj], p[jj + 1]}; const unsigned pk = __builtin_bit_cast(unsigned, __builtin_convertvector(pv, bf16x2_t)); pb[jj] = (short)(pk & 0xffffu); pb[jj + 1] = (short)(pk >> 16); } }
              lrun = lrun * alpha + psum;
              const bool resc = !__all(alpha == 1.0f);
#pragma unroll
              for (int dt = 0; dt < 8; ++dt) { if (resc) o[dt] = o[dt] * alpha;
                  const LAS unsigned char* a0 = stg + (4 * g + (c >> 2)) * IX_SROW + (16 * dt + 4 * (c & 3)) * 2;
                  const s16x4 lo4 = __builtin_bit_cast(s16x4, __builtin_amdgcn_ds_read_tr16_b64_v4i16((LAS s16x4*)a0));
                  const s16x4 hi4 = __builtin_bit_cast(s16x4, __builtin_amdgcn_ds_read_tr16_b64_v4i16((LAS s16x4*)(a0 + 16 * IX_SROW)));
                  const bf16x8 ca = (bf16x8){lo4[0], lo4[1], lo4[2], lo4[3], hi4[0], hi4[1], hi4[2], hi4[3]};
                  o[dt] = __builtin_amdgcn_mfma_f32_16x16x32_bf16(ca, pb, o[dt], 0, 0, 0); }
              LDS_WAIT(); asm volatile("" ::: "memory");
              }
          }
          { auto r16 = __builtin_amdgcn_permlane16_swap(__float_as_uint(lrun), __float_as_uint(lrun), false, false); lrun = __uint_as_float(r16[0]) + __uint_as_float(r16[1]);
            auto r32_ = __builtin_amdgcn_permlane32_swap(__float_as_uint(lrun), __float_as_uint(lrun), false, false); lrun = __uint_as_float(r32_[0]) + __uint_as_float(r32_[1]); }
          const float rl = 1.0f / lrun;
          if (c < 8) { LAS unsigned char* op = QLb + ((size_t)q * 1024 + c * 128 + 4 * g) * 2;
#pragma unroll
              for (int dt = 0; dt < 8; ++dt) { v2u wv; wv.x = pk2(o[dt][0] * rl, o[dt][1] * rl); wv.y = pk2(o[dt][2] * rl, o[dt][3] * rl); *(LAS v2u*)(op + 32 * dt) = wv; } }
      } }
    __syncthreads(); TS(7);
    if (do_att) {
#pragma unroll
      for (int dt = 0; dt < 2; ++dt) { f32x16 d = f32x16{}; const bf16* wp = WUVT + ((size_t)wave * 64 + 32 * dt + r32) * 128 + hi * 8;
#pragma unroll
          for (int ks = 0; ks < 8; ++ks) { const bf16x8 ob = *(const LAS bf16x8*)(QLb + ((size_t)r32 * 1024 + wave * 128 + 16 * ks + 8 * hi) * 2);
              d = __builtin_amdgcn_mfma_f32_32x32x16_bf16(*(const bf16x8*)(wp + 16 * ks), ob, d, 0, 0, 0); }
          bf16* op = OCAT + (rowb + q0 + r32) * KO0 + wave * 64 + 32 * dt + 4 * hi;
#pragma unroll
          for (int j = 0; j < 4; ++j) { v2u wv; wv.x = pk2(d[4 * j], d[4 * j + 1]); wv.y = pk2(d[4 * j + 2], d[4 * j + 3]); *(v2u*)(op + 8 * j) = wv; } } }
    __syncthreads(); TS(8);
#undef LOAD_QF
#undef TS
}
#define XB_TMO      128
#define XB_XCNT(j)  (256  + 64 * (j))
#define XB_XSUB(j)  (1280 + 64 * (j))
#define XB_XGEN(j)  (2304 + 64 * (j))
#define XB_TOP      3328
#define XB_TOPGEN   3392
#define XCD_BAR_WORDS 3456
#define XB_SPIN_CAP (1u << 18)

__device__ __forceinline__ unsigned xb_ld(unsigned* p)              { return __hip_atomic_load(p, __ATOMIC_RELAXED, __HIP_MEMORY_SCOPE_AGENT); }
__device__ __forceinline__ unsigned xb_add(unsigned* p, unsigned v) { return __hip_atomic_fetch_add(p, v, __ATOMIC_RELAXED, __HIP_MEMORY_SCOPE_AGENT); }
__device__ __forceinline__ unsigned xb_xcc_id() { return (unsigned)__builtin_amdgcn_s_getreg((3 << 11) | 20) & 0xFu; }
#define XB_SPIN(cond, bar) do { unsigned _sp = 0; while (cond) { __builtin_amdgcn_s_sleep(1); \
    if ((++_sp & 255u) == 0u) { if (xb_ld(&(bar)[XB_TMO])) break; if (_sp > XB_SPIN_CAP) { atomicAdd(&(bar)[XB_TMO], 1u); break; } } } } while (0)

struct XcdBarrier {
    unsigned* bar; unsigned x;
    volatile LAS unsigned* st;
};

__device__ __forceinline__ XcdBarrier xcd_barrier_post(unsigned* bar, volatile LAS unsigned* st) {
    XcdBarrier b; b.bar = bar; b.x = xb_xcc_id(); b.st = st;
    if (threadIdx.x == 0) (void)xb_add(&bar[XB_XCNT(b.x)], 1u);
    return b;
}
__device__ __forceinline__ void xcd_barrier_complete(unsigned* bar, unsigned x, unsigned& nloc, unsigned& nx) {
    const unsigned G = gridDim.x * gridDim.y * gridDim.z;
    unsigned sum, cnt, mine, sp = 0u;
    for (;;) {
        sum = 0u; cnt = 0u; mine = 0u;
#pragma unroll
        for (unsigned j = 0; j < 16; ++j) { const unsigned c = xb_ld(&bar[XB_XCNT(j)]); sum += c; cnt += (c > 0u) ? 1u : 0u; mine = (j == x) ? c : mine; }
        if (sum == G) break;
        __builtin_amdgcn_s_sleep(1);
        if ((++sp & 255u) == 0u) { if (xb_ld(&bar[XB_TMO])) break; if (sp > XB_SPIN_CAP) { atomicAdd(&bar[XB_TMO], 1u); break; } }
    }
    nloc = mine > 0u ? mine : 1u; nx = cnt > 0u ? cnt : 1u;
}

__device__ __forceinline__ void xcd_barrier(const XcdBarrier& b) {
    asm volatile("s_waitcnt vmcnt(0)" ::: "memory");
    __syncthreads();
    if (threadIdx.x == 0) {
        unsigned* bar = b.bar;
        __builtin_amdgcn_s_waitcnt(0);
        unsigned nloc = b.st[0], nx = b.st[1];
        if (nloc == 0u) { xcd_barrier_complete(bar, b.x, nloc, nx); b.st[0] = nloc; b.st[1] = nx; }
        const unsigned old = xb_add(&bar[XB_XSUB(b.x)], 1u);
        const unsigned gen = old / nloc;
        if (old + 1u == (gen + 1u) * nloc) {
            __builtin_amdgcn_fence(__ATOMIC_RELEASE, "agent");
            asm volatile("s_waitcnt vmcnt(0)" ::: "memory");
            const unsigned og = xb_add(&bar[XB_TOP], 1u);
            const unsigned tg = og / nx;
            if (og + 1u == (tg + 1u) * nx) xb_add(&bar[XB_TOPGEN], 1u);
            else XB_SPIN(xb_ld(&bar[XB_TOPGEN]) == tg, bar);
            __builtin_amdgcn_fence(__ATOMIC_ACQUIRE, "agent");
            xb_add(&bar[XB_XGEN(b.x)], 1u);
            asm volatile("s_waitcnt vmcnt(0)" ::: "memory");
        } else {
            XB_SPIN(xb_ld(&bar[XB_XGEN(b.x)]) == gen, bar);
            __builtin_amdgcn_fence(__ATOMIC_ACQUIRE, "agent");
            asm volatile("s_waitcnt vmcnt(0)" ::: "memory");
        }
    }
    __syncthreads();
}
namespace moba {
using bf16=__hip_bfloat16;
using bf16x8=__attribute__((ext_vector_type(8)))short;
using s16x4=__attribute__((ext_vector_type(4)))short;
using f32x16=__attribute__((ext_vector_type(16)))float;
using u32x4=__attribute__((ext_vector_type(4)))unsigned;
constexpr int SEQ=4096,D=64,PQ=3072,PO=1024;
constexpr int NW=8,QBLK=32,QB=QBLK*NW,KVBLK=64,NQB=SEQ/QB;
constexpr int ATTN_UNIT_ROWS=QB;
__device__ __forceinline__ int crow(int r,int hi){return (r&3)+8*(r>>2)+4*hi;}
#define SBAR() __builtin_amdgcn_sched_barrier(0)
__device__ __forceinline__ void cmask(f32x16&p0,f32x16&p1,int jb,int qrel,int hi){
  const float NEG=-INFINITY; int kb=64*jb+4*hi;
  #pragma unroll
  for(int r=0;r<16;++r){int kv=kb+(r&3)+8*(r>>2); if(kv>qrel)p0[r]=NEG; if(kv+32>qrel)p1[r]=NEG;}
}

constexpr int NSLOT=3, SLOTB=8192;
constexpr int LDS_K=0, LDS_V=NSLOT*SLOTB, LDS_WS=2*NSLOT*SLOTB, LDS_OST=LDS_WS+NW*64*4, LDS_BYTES=LDS_OST+NW*4096;
constexpr float C2=0.125f*1.4426950408889634f;
__device__ __forceinline__ void glds16(const void*gsrc,unsigned lds_dst){unsigned keep;
  asm volatile("s_mov_b32 %0, m0\n\ts_mov_b32 m0, %2\n\ts_nop 0\n\tglobal_load_lds_dwordx4 %1, off\n\ts_mov_b32 m0, %0":"=&s"(keep):"v"(gsrc),"s"(lds_dst):"memory");}
__device__ __forceinline__ float max3f(float a,float b,float c){float r;asm("v_max3_f32 %0, %1, %2, %3":"=v"(r):"v"(a),"v"(b),"v"(c));return r;}
__device__ __forceinline__ float max2f(float a,float b){float r;asm("v_max_f32_e32 %0, %1, %2":"=v"(r):"v"(a),"v"(b));return r;}
__device__ __forceinline__ float fadd_s(float a,float b){float r;asm("v_add_f32_e32 %0, %1, %2":"=v"(r):"v"(a),"v"(b));return r;}
__device__ __forceinline__ float fsub_s(float a,float b){float r;asm("v_sub_f32_e32 %0, %1, %2":"=v"(r):"v"(a),"v"(b));return r;}
typedef float f32x2_t __attribute__((ext_vector_type(2))); typedef __bf16 bf16x2_t __attribute__((ext_vector_type(2)));
__device__ __forceinline__ unsigned cvtpk_s(float lo,float hi){f32x2_t v={lo,hi};bf16x2_t b=__builtin_convertvector(v,bf16x2_t);return __builtin_bit_cast(unsigned,b);}
#define WAIT_BAR(N) asm volatile("s_waitcnt vmcnt(" #N ") lgkmcnt(0)\n\ts_barrier":::"memory")

__device__ __forceinline__ void qkt(f32x16&p0,f32x16&p1,const char*Kslot,const bf16x8*qr,int r32,int hi){ const f32x16 negm=f32x16{};
  const char*kb=Kslot+hi*1024+r32*16;
  #pragma unroll
  for(int d0=0;d0<4;++d0){
    const bf16x8 b0=*reinterpret_cast<const bf16x8*>(kb+d0*2048);
    const bf16x8 b1=*reinterpret_cast<const bf16x8*>(kb+d0*2048+512);
    if(d0==0){p0=__builtin_amdgcn_mfma_f32_32x32x16_bf16(b0,qr[0],negm,0,0,0);p1=__builtin_amdgcn_mfma_f32_32x32x16_bf16(b1,qr[0],negm,0,0,0);}
    else{p0=__builtin_amdgcn_mfma_f32_32x32x16_bf16(b0,qr[d0],p0,0,0,0);p1=__builtin_amdgcn_mfma_f32_32x32x16_bf16(b1,qr[d0],p1,0,0,0);}}
}
typedef __attribute__((address_space(3))) const char* lds_cptr;
typedef short v4i16_t __attribute__((ext_vector_type(4)));
__device__ __forceinline__ void kload8(bf16x8*kf,lds_cptr kp){
  kf[0]=*(const __attribute__((address_space(3))) bf16x8*)(kp);      kf[1]=*(const __attribute__((address_space(3))) bf16x8*)(kp+512);
  kf[2]=*(const __attribute__((address_space(3))) bf16x8*)(kp+2048); kf[3]=*(const __attribute__((address_space(3))) bf16x8*)(kp+2560);
  kf[4]=*(const __attribute__((address_space(3))) bf16x8*)(kp+4096); kf[5]=*(const __attribute__((address_space(3))) bf16x8*)(kp+4608);
  kf[6]=*(const __attribute__((address_space(3))) bf16x8*)(kp+6144); kf[7]=*(const __attribute__((address_space(3))) bf16x8*)(kp+6656);
}
__device__ __forceinline__ void kload2(bf16x8*kf,lds_cptr kp,int j){ kf[2*j]=*(const __attribute__((address_space(3))) bf16x8*)(kp+j*2048); kf[2*j+1]=*(const __attribute__((address_space(3))) bf16x8*)(kp+j*2048+512); }
__device__ __forceinline__ s16x4 vtr(lds_cptr p){ return __builtin_bit_cast(s16x4,__builtin_amdgcn_ds_read_tr16_b64_v4i16((__attribute__((address_space(3))) v4i16_t*)p)); }
__device__ __forceinline__ float rowmax(const f32x16&p0,const f32x16&p1){
  float a=max3f(p0[0],p0[1],p1[0]),b=max3f(p0[2],p0[3],p1[1]);a=max3f(a,p1[2],p1[3]);
  #pragma unroll
  for(int r=4;r<16;r+=4){a=max3f(a,p0[r],p0[r+1]);b=max3f(b,p0[r+2],p0[r+3]);a=max3f(a,p1[r],p1[r+1]);b=max3f(b,p1[r+2],p1[r+3]);}
  const float m=max2f(a,b);
  auto rr=__builtin_amdgcn_permlane32_swap(__float_as_uint(m),__float_as_uint(m),false,false);
  return max2f(__uint_as_float(rr[0]),__uint_as_float(rr[1]));
}
__device__ __forceinline__ void pv(f32x16*o,int vb,bf16x8 pa0,bf16x8 pa1,bf16x8 pa2,bf16x8 pa3){
  #pragma unroll
  for(int d0=0;d0<2;++d0){s16x4 lo[4],hi[4];
    #pragma unroll
    for(int ks=0;ks<4;++ks){
      asm volatile("ds_read_b64_tr_b16 %0,%1 offset:%c2":"=&v"(lo[ks]):"v"(vb),"i"(d0*4096+ks*1024):"memory");
      asm volatile("ds_read_b64_tr_b16 %0,%1 offset:%c2":"=&v"(hi[ks]):"v"(vb),"i"(d0*4096+ks*1024+512):"memory");}
    asm volatile("s_waitcnt lgkmcnt(0)":::"memory");SBAR();
    #define PK(k) (bf16x8){lo[k][0],lo[k][1],lo[k][2],lo[k][3],hi[k][0],hi[k][1],hi[k][2],hi[k][3]}
    o[d0]=__builtin_amdgcn_mfma_f32_32x32x16_bf16(pa0,PK(0),o[d0],0,0,0);
    o[d0]=__builtin_amdgcn_mfma_f32_32x32x16_bf16(pa1,PK(1),o[d0],0,0,0);
    o[d0]=__builtin_amdgcn_mfma_f32_32x32x16_bf16(pa2,PK(2),o[d0],0,0,0);
    o[d0]=__builtin_amdgcn_mfma_f32_32x32x16_bf16(pa3,PK(3),o[d0],0,0,0);
    #undef PK
  }
}

#ifndef ATTN_STORE16
#define ATTN_STORE16(p,v) (*(u32x4*)(p)=(v))
#endif
template<int THRL,bool WITH_BIAS=true> __device__ __forceinline__ void attn_unit(int b,int h,int qb,const bf16*Q,const bf16*__restrict__ K,const bf16*__restrict__ V,bf16*O,const unsigned short*__restrict__ ALLOW,const float*__restrict__ KN2,const float sig2,char*shm){
  int tid_l=threadIdx.x; asm volatile("":"+v"(tid_l)); const int tid=tid_l,lane=tid&63,r32=lane&31,hi=lane>>5; const int wid=__builtin_amdgcn_readfirstlane(tid>>6);
  const long rowbase=(long)b*SEQ; const int q0=qb*QB;
  const bf16*Qw=Q+(rowbase+q0+wid*QBLK)*PQ+h*D;
  const bf16*Kh=K+rowbase*PQ+h*D,*Vh=V+rowbase*PQ+h*D;
  const unsigned lds0=(unsigned)(uintptr_t)shm;
  float*wsf=(float*)(shm+LDS_WS)+wid*64;
  const int NT0=(q0+QB)/KVBLK;
  bf16x8 qr[4];
  #pragma unroll
  for(int d0=0;d0<4;++d0)qr[d0]=*reinterpret_cast<const bf16x8*>(&Qw[(long)r32*PQ+d0*16+hi*8]);
  float mhat=0.f,l_reg=0.f;f32x16 o[2];o[0]=f32x16{};o[1]=f32x16{};
  const int qrel=wid*QBLK+r32; const int qpos=q0+qrel;
  const unsigned allow=ALLOW[(rowbase+qpos)*16+h];
  float qn2=0.f;
  {
    float ss=0.f;
    _Pragma("unroll") for(int d0=0;d0<4;++d0){ const bf16x8 kk=*reinterpret_cast<const bf16x8*>(&Kh[(long)qpos*PQ+d0*16+hi*8]);
      _Pragma("unroll") for(int j=0;j<8;++j){ const float qv=__uint_as_float(((unsigned)(unsigned short)qr[d0][j])<<16); ss+=qv*__uint_as_float(((unsigned)(unsigned short)kk[j])<<16); qn2+=qv*qv; } }
    ss+=__shfl_xor(ss,32); qn2+=__shfl_xor(qn2,32); mhat=ss; }
  int t0=0;
  { float qm=qn2, mm=mhat;
    _Pragma("unroll") for(int off=1;off<32;off<<=1){ qm=__builtin_fmaxf(qm,__shfl_xor(qm,off)); mm=__builtin_fminf(mm,__shfl_xor(mm,off)); }
    float*exch=(float*)(shm+LDS_OST);
    if(lane==0){ exch[2*wid]=qm; exch[2*wid+1]=mm; }
    __syncthreads();
    float Qn2=exch[0], Mmin=exch[1];
    _Pragma("unroll") for(int w=1;w<NW;++w){ Qn2=__builtin_fmaxf(Qn2,exch[2*w]); Mmin=__builtin_fminf(Mmin,exch[2*w+1]); }
    const float kn=KN2[lane];
    const float bound=sqrtf(Qn2*kn)-sig2*(float)(q0-(64*lane+63))-Mmin;
    const unsigned long long nosk=__ballot(!(bound<-40.f)||lane>=NT0-4);
    t0=nosk?(int)__builtin_ctzll(nosk):0; t0&=~1; if(t0>NT0-4)t0=NT0-4; }
  const int NT=NT0-t0;
  const bf16*ksrc=Kh+(long)(lane+t0*KVBLK)*PQ+wid*8;
  const bf16*vsrc=Vh+(long)(16*(wid&3)+(lane>>2)+t0*KVBLK)*PQ+(wid>>2)*32+(lane&3)*8;
  const unsigned kdst=lds0+LDS_K+wid*1024, vdst=lds0+LDS_V+wid*1024;
  #define DMA_K(t,slot) glds16(ksrc+(long)(t)*KVBLK*PQ,(unsigned)__builtin_amdgcn_readfirstlane(kdst+(slot)))
  #define DMA_V(t,slot) glds16(vsrc+(long)(t)*KVBLK*PQ,(unsigned)__builtin_amdgcn_readfirstlane(vdst+(slot)))
  const int vb0=(int)(lds0+LDS_V)+((lane>>4)&1)*32+(lane&3)*8+(4*hi+((lane&15)>>2))*64;
  const char*Kbase=shm+LDS_K; bf16x8 kf[8];
  const lds_cptr shm3=(lds_cptr)shm; const lds_cptr kp0=shm3+LDS_K+hi*1024+r32*16; const lds_cptr vp0=shm3+LDS_V+((lane>>4)&1)*32+(lane&3)*8+(4*hi+((lane&15)>>2))*64;
  DMA_K(0,0);DMA_V(0,0);DMA_K(1,SLOTB);
  const f32x16 negm=f32x16{};
  bf16x8 kx0=bf16x8{}, kx1=bf16x8{};
  if(hi==0){ const short one=(short)0x3F80; const short k0_=(short)(cvtpk_s((float)r32,0.f)&0xffffu), k1_=(short)(cvtpk_s((float)(32+r32),0.f)&0xffffu);
    kx0[0]=one;kx0[1]=one;kx0[2]=one;kx0[3]=k0_;kx0[4]=k0_; kx1[0]=one;kx1[1]=one;kx1[2]=one;kx1[3]=k1_;kx1[4]=k1_; }
  const unsigned sgh_=cvtpk_s(sig2,0.f)&0xffffu, sgl_=cvtpk_s(sig2-__uint_as_float(sgh_<<16),0.f)&0xffffu;
  const float bq=sig2*(float)(-qpos);
  #define BIASM(P0,P1,t) do{ if(!WITH_BIAS)break; const bool al_=((allow>>(((t)+t0)>>2))&1u)!=0u; const float s0_=(bq-mhat)+sig2*(float)(64*((t)+t0)); \
    unsigned h1_=cvtpk_s(s0_,0.f)&0xffffu; const float r1_=s0_-__uint_as_float(h1_<<16); unsigned h2_=cvtpk_s(r1_,0.f)&0xffffu; const float r2_=r1_-__uint_as_float(h2_<<16); unsigned h3_=cvtpk_s(r2_,0.f)&0xffffu; \
    if(!al_){h1_=0xff80u;h2_=0u;h3_=0u;} \
    u32x4 qw_; qw_[0]=hi?0u:(h1_|(h2_<<16)); qw_[1]=hi?0u:(h3_|(sgh_<<16)); qw_[2]=hi?0u:sgl_; qw_[3]=0u; const bf16x8 qx_=__builtin_bit_cast(bf16x8,qw_); \
    P0=__builtin_amdgcn_mfma_f32_32x32x16_bf16(kx0,qx_,P0,0,0,0); P1=__builtin_amdgcn_mfma_f32_32x32x16_bf16(kx1,qx_,P1,0,0,0); }while(0)
  #define CMASK(P0,P1,t) do{int jb_=(t)-(NT-4); if(jb_>=0)cmask(P0,P1,jb_,qrel,hi);}while(0)
  bool resc=false;
  #define MXF3(a,b,c) __builtin_fmaxf(__builtin_fmaxf((a),(b)),(c))
  #define DECIDE(C0,C1) do{ float a=MXF3(C0[0],C0[1],C1[0]),b=MXF3(C0[2],C0[3],C1[1]); a=MXF3(a,C1[2],C1[3]);     \
      _Pragma("unroll") for(int r=4;r<16;r+=4){a=MXF3(a,C0[r],C0[r+1]);b=MXF3(b,C0[r+2],C0[r+3]);a=MXF3(a,C1[r],C1[r+1]);b=MXF3(b,C1[r+2],C1[r+3]);} \
      float rm=__builtin_fmaxf(a,b); { auto rr=__builtin_amdgcn_permlane32_swap(__float_as_uint(rm),__float_as_uint(rm),false,false); rm=__builtin_fmaxf(__uint_as_float(rr[0]),__uint_as_float(rr[1])); } \
      resc=false; \
      if(__builtin_expect(__any(rm>(float)THRL),0)){ const float dl=__builtin_fmaxf(rm,0.f); mhat+=dl; \
        _Pragma("unroll") for(int r=0;r<16;++r){C0[r]-=dl;C1[r]-=dl;} \
        const float f=__builtin_amdgcn_exp2f(-dl); l_reg*=f; if(hi==0)wsf[r32]=f; resc=true; } }while(0)
  #define RESC() do{ if(resc){ asm volatile("s_waitcnt lgkmcnt(0)":::"memory"); \
      _Pragma("unroll") for(int d_=0;d_<2;++d_) _Pragma("unroll") for(int r=0;r<16;++r)o[d_][r]*=wsf[crow(r,hi)]; } }while(0)
  f32x16 pA0,pA1,pB0,pB1;
  int sl_prev=0,sl_cur=0,sl_next=SLOTB;
  #define ROT() do{sl_prev=sl_cur;sl_cur=sl_next;sl_next=(sl_next==(NSLOT-1)*SLOTB)?0:sl_next+SLOTB;}while(0)
  DMA_K(2,2*SLOTB);
  WAIT_BAR(3);
  qkt(pA0,pA1,Kbase,qr,r32,hi);asm volatile("s_nop 15\n\ts_nop 7":"+v"(pA0),"+v"(pA1));BIASM(pA0,pA1,0);CMASK(pA0,pA1,0);
  DECIDE(pA0,pA1); resc=false;
  _Pragma("unroll") for(int r=0;r<16;++r){pA0[r]=__builtin_amdgcn_exp2f(pA0[r]);pA1[r]=__builtin_amdgcn_exp2f(pA1[r]);}
  WAIT_BAR(0);
  DMA_K(3,0);DMA_V(1,SLOTB);
  ROT();
  kload8(kf,kp0+sl_cur);
  WAIT_BAR(2);
  s16x4 vlo[8],vhi[8]; u32x4 pw0,pw1,pw2,pw3;
  #define PKW(P,B) cvtpk_s(P[B],P[B+1])
  #define PAF(k) __builtin_bit_cast(bf16x8,pw##k)
  #define VFR(i) (bf16x8){vlo[i][0],vlo[i][1],vlo[i][2],vlo[i][3],vhi[i][0],vhi[i][1],vhi[i][2],vhi[i][3]}
  #define PIN(x) asm volatile("":"+v"(x))
  #define MX3(a,b,c) __builtin_fmaxf(__builtin_fmaxf((a),(b)),(c))
  #define GAPA(MF,A0,A1,A2,A3,W0,W1,PW) do{ MF; sacc+=A0; sacc+=A1; sacc+=A2; sacc+=A3; PIN(sacc); W0; W1; PIN(PW); SBAR(); }while(0)
  #define EX(v) __builtin_amdgcn_exp2f(v)
  #define GAPB(MF,X,B) do{ MF; X[B]=EX(X[B]); X[B+1]=EX(X[B+1]); X[B+2]=EX(X[B+2]); X[B+3]=EX(X[B+3]); PIN(X); SBAR(); }while(0)
  #define VRD(i) do{ vlo[i]=vtr(vp_+(((i)>>2)*4096+((i)&3)*1024)); vhi[i]=vtr(vp_+(((i)>>2)*4096+((i)&3)*1024+512)); }while(0)
  #define KRD(G,j) do{ if(G){ kload2(kf,kp0+sl_next,j); SBAR(); } }while(0)
  #define STEP(C0,C1,P0,P1,t,GK,GV,GL) do{ SBAR(); \
    const lds_cptr vp_=vp0+sl_prev; \
    VRD(0); SBAR(); float sacc=(P0[0]+P0[1]); \
    GAPA(C0=__builtin_amdgcn_mfma_f32_32x32x16_bf16(kf[0],qr[0],negm,0,0,0), P0[2],P0[3],P0[4],P0[5],     pw0[0]=PKW(P0,0), pw0[1]=PKW(P0,2), pw0); \
    VRD(4); SBAR(); GAPA(C1=__builtin_amdgcn_mfma_f32_32x32x16_bf16(kf[1],qr[0],negm,0,0,0), P0[6],P0[7],P0[8],P0[9],     pw0[2]=PKW(P0,4), pw0[3]=PKW(P0,6), pw0); \
    VRD(1); SBAR(); GAPA(C0=__builtin_amdgcn_mfma_f32_32x32x16_bf16(kf[2],qr[1],C0,0,0,0),   P0[10],P0[11],P0[12],P0[13], pw1[0]=PKW(P0,8), pw1[1]=PKW(P0,10), pw1); \
    VRD(5); SBAR(); GAPA(C1=__builtin_amdgcn_mfma_f32_32x32x16_bf16(kf[3],qr[1],C1,0,0,0),   P0[14],P0[15],P1[0],P1[1],   pw1[2]=PKW(P0,12),pw1[3]=PKW(P0,14), pw1); \
    VRD(2); SBAR(); GAPA(C0=__builtin_amdgcn_mfma_f32_32x32x16_bf16(kf[4],qr[2],C0,0,0,0),   P1[2],P1[3],P1[4],P1[5],     pw2[0]=PKW(P1,0), pw2[1]=PKW(P1,2), pw2); \
    VRD(6); SBAR(); GAPA(C1=__builtin_amdgcn_mfma_f32_32x32x16_bf16(kf[5],qr[2],C1,0,0,0),   P1[6],P1[7],P1[8],P1[9],     pw2[2]=PKW(P1,4), pw2[3]=PKW(P1,6), pw2); \
    VRD(3); SBAR(); GAPA(C0=__builtin_amdgcn_mfma_f32_32x32x16_bf16(kf[6],qr[3],C0,0,0,0),   P1[10],P1[11],P1[12],P1[13], pw3[0]=PKW(P1,8), pw3[1]=PKW(P1,10), pw3); \
    VRD(7); SBAR(); GAPA(C1=__builtin_amdgcn_mfma_f32_32x32x16_bf16(kf[7],qr[3],C1,0,0,0),   P1[14],P1[15],0.f,0.f,       pw3[2]=PKW(P1,12),pw3[3]=PKW(P1,14), pw3); \
    l_reg+=sacc; \
    if(GK){DMA_K((t)+3,sl_cur);} if(GV){DMA_V((t)+1,sl_next);} \
    BIASM(C0,C1,t); CMASK(C0,C1,t); \
    DECIDE(C0,C1); \
    SBAR(); \
    GAPB(o[0]=__builtin_amdgcn_mfma_f32_32x32x16_bf16(PAF(0),VFR(0),o[0],0,0,0), C0,0); \
    GAPB(o[1]=__builtin_amdgcn_mfma_f32_32x32x16_bf16(PAF(0),VFR(4),o[1],0,0,0), C0,4); \
    KRD(GL,0); GAPB(o[0]=__builtin_amdgcn_mfma_f32_32x32x16_bf16(PAF(1),VFR(1),o[0],0,0,0), C0,8); \
    KRD(GL,1); GAPB(o[1]=__builtin_amdgcn_mfma_f32_32x32x16_bf16(PAF(1),VFR(5),o[1],0,0,0), C0,12); \
    KRD(GL,2); GAPB(o[0]=__builtin_amdgcn_mfma_f32_32x32x16_bf16(PAF(2),VFR(2),o[0],0,0,0), C1,0); \
    KRD(GL,3); GAPB(o[1]=__builtin_amdgcn_mfma_f32_32x32x16_bf16(PAF(2),VFR(6),o[1],0,0,0), C1,4); \
    GAPB(o[0]=__builtin_amdgcn_mfma_f32_32x32x16_bf16(PAF(3),VFR(3),o[0],0,0,0), C1,8); \
    GAPB(o[1]=__builtin_amdgcn_mfma_f32_32x32x16_bf16(PAF(3),VFR(7),o[1],0,0,0), C1,12); \
    }while(0)
  int t=1;
  #undef CMASK
  #define CMASK(P0,P1,t) do{}while(0)
  for(;t+5<NT;t+=2){
    STEP(pB0,pB1,pA0,pA1,t,true,true,true);     WAIT_BAR(2); RESC(); ROT();
    STEP(pA0,pA1,pB0,pB1,t+1,true,true,true);   WAIT_BAR(2); RESC(); ROT();
  }
  #undef CMASK
  #define CMASK(P0,P1,t) do{int jb_=(t)-(NT-4); if(jb_>=0)cmask(P0,P1,jb_,qrel,hi);}while(0)
  #define ENDW(tt) do{ if((tt)+3<NT){WAIT_BAR(2);} else if((tt)+2<NT){WAIT_BAR(1);} else {WAIT_BAR(0);} }while(0)
  for(;t+1<NT;t+=2){
    STEP(pB0,pB1,pA0,pA1,t,(t+3<NT),(t+1<NT),(t+1<NT));       ENDW(t);   RESC(); ROT();
    STEP(pA0,pA1,pB0,pB1,t+1,(t+4<NT),(t+2<NT),(t+2<NT));     ENDW(t+1); RESC(); ROT();
  }
  STEP(pB0,pB1,pA0,pA1,NT-1,false,false,false); RESC();
  { float sacc=pB0[0]+pB0[1]; _Pragma("unroll") for(int r=2;r<16;++r)sacc+=pB0[r]; _Pragma("unroll") for(int r=0;r<16;++r)sacc+=pB1[r]; l_reg+=sacc;
    pw0=(u32x4){PKW(pB0,0),PKW(pB0,2),PKW(pB0,4),PKW(pB0,6)};pw1=(u32x4){PKW(pB0,8),PKW(pB0,10),PKW(pB0,12),PKW(pB0,14)};pw2=(u32x4){PKW(pB1,0),PKW(pB1,2),PKW(pB1,4),PKW(pB1,6)};pw3=(u32x4){PKW(pB1,8),PKW(pB1,10),PKW(pB1,12),PKW(pB1,14)};
    SBAR(); pv(o,vb0+sl_cur,PAF(0),PAF(1),PAF(2),PAF(3)); }
  #undef PKW
  #undef PAF
  #undef VFR
  #undef PIN
  #undef MX3
  #undef GAPA
  #undef GAPB
  #undef EX
  #undef VRD
  #undef KRD
  #undef STEP
  #undef ENDW
  {auto rr=__builtin_amdgcn_permlane32_swap(__float_as_uint(l_reg),__float_as_uint(l_reg),false,false);l_reg=__uint_as_float(rr[0])+__uint_as_float(rr[1]);}
  if(hi==0)wsf[32+r32]=l_reg;asm volatile("s_waitcnt lgkmcnt(0)":::"memory");
  float rli[16];
  #pragma unroll
  for(int r=0;r<16;++r)rli[r]=__builtin_amdgcn_rcpf(wsf[32+crow(r,hi)]);
  bf16*Ow=O+(rowbase+q0+wid*QBLK)*PO+h*D;
  { bf16*stg=(bf16*)(shm+LDS_OST)+wid*2048;
    #pragma unroll
    for(int r=0;r<16;++r){const int orow=crow(r,hi);
      #pragma unroll
      for(int d0=0;d0<2;++d0)stg[orow*64+d0*32+r32]=__float2bfloat16(o[d0][r]*rli[r]);}
    asm volatile("s_waitcnt lgkmcnt(0)":::"memory");
    #pragma unroll
    for(int i=0;i<4;++i){const int row=i*8+(lane>>3),ch=lane&7; const u32x4 v=*(const u32x4*)(stg+row*64+ch*8); ATTN_STORE16(Ow+(long)row*PO+ch*8,v);} }
  asm volatile("s_waitcnt lgkmcnt(0)\n\ts_barrier":::"memory");
  #undef DMA_K
  #undef DMA_V
  #undef CMASK
  #undef DECIDE
  #undef MXF3
  #undef BIASM
  #undef RESC
  #undef ROT
}
constexpr int ATTN_LDS_BYTES=LDS_BYTES;
#undef SBAR
#undef WAIT_BAR
}
struct Args { const float* in[15]; float* out; unsigned char* ws; int ph_lo, ph_hi; };
enum { I_X = 0, I_EWIN, I_EKVN, I_EWUK, I_EWUV, I_EWOUT, I_OWIN, I_OWOUT, I_LNMG, I_LNMB, I_FG, I_FU, I_FD, I_LNFG, I_LNFB };
constexpr int NPHASE = 18;

__global__ void __launch_bounds__(NTHR, 2) mega_fwd(Args args) {
    extern __shared__ __attribute__((aligned(16))) unsigned char lds_raw[];
    LAS unsigned char* lds = (LAS unsigned char*)lds_raw;
    cg::grid_group grid = cg::this_grid();
    volatile LAS unsigned* MISC = (volatile LAS unsigned*)(lds + LDS_BYTES - 64);
    if (threadIdx.x < 16) ((LAS unsigned*)(lds + LDS_BYTES - 64))[threadIdx.x] = 0u;
    __syncthreads();
    const int G = gridDim.x; const int bx = blockIdx.x; const int vcu = (G % 8 == 0) ? (bx % 8) * (G / 8) + bx / 8 : bx;
    const int NGW = G * NWAVES;
#ifndef DUP_MASK
#define DUP_MASK 0
#endif
#ifdef DOUBLE_BARRIER
#define SEAM_EXTRA xcd_barrier(bar);
#else
#define SEAM_EXTRA
#endif
#define REP(k) for (int rep_ = 0; rep_ <= ((DUP_MASK >> (k)) & 1); ++rep_)
#define PHASE_IDS() int tid = threadIdx.x; asm volatile("" : "+v"(tid)); const int lane = tid & 63, wave = __builtin_amdgcn_readfirstlane(tid >> 6), gw = vcu * NWAVES + wave; (void)gw; (void)lane; \
    size_t zoff_ = 0; asm volatile("" : "+s"(zoff_)); unsigned char* ws = args.ws + zoff_;     \
    bf16* const W0IN = (bf16*)(ws + WS_W0IN); bf16* const W0OUT = (bf16*)(ws + WS_W0OUT); bf16* const WGU0 = (bf16*)(ws + WS_WGU0); bf16* const WGU1 = (bf16*)(ws + WS_WGU1); \
    bf16* const WDN0 = (bf16*)(ws + WS_WDN0); bf16* const WDN1 = (bf16*)(ws + WS_WDN1); bf16* const W1IN = (bf16*)(ws + WS_W1IN); bf16* const W1OUT = (bf16*)(ws + WS_W1OUT); \
    float* const KMEAN = (float*)(ws + WS_KMEAN); unsigned short* const ALLOW = (unsigned short*)(ws + WS_ALLOW); bf16* const CKVN = (bf16*)(ws + WS_CKVN); \
    bf16* const X = (bf16*)(ws + WS_X); bf16* const R1 = (bf16*)(ws + WS_R1); bf16* const OCAT = (bf16*)(ws + WS_OCAT); \
    (void)W0IN; (void)W0OUT; (void)WGU0; (void)WGU1; (void)WDN0; (void)WDN1; (void)W1IN; (void)W1OUT; (void)KMEAN; (void)ALLOW; (void)CKVN; (void)X; (void)R1; (void)OCAT;
    const int lo = args.ph_lo, hi = args.ph_hi;
#ifdef ONLY_PHASE
#define IN(k) ((k) == ONLY_PHASE && lo <= (k) && (k) < hi)
#else
#define IN(k) (lo <= (k) && (k) < hi)
#endif
    XcdBarrier bar; bar.bar = (unsigned*)args.ws + 4096; bar.x = 0; bar.st = nullptr;
    if (hi - lo > 1) bar = xcd_barrier_post((unsigned*)args.ws + 4096, MISC);
#define SEAM(k) do { if (IN(k) && IN((k) + 1)) { if ((k) == 0) grid.sync(); else { xcd_barrier(bar); SEAM_EXTRA } } } while (0)

    if (IN(0)) REP(0) { PHASE_IDS();
        LAS float* scr = (LAS float*)(lds + wave * 16384);
        int rot = 0;
        const float* ewin = args.in[I_EWIN];
        tr_job(ewin, 2500, 1024, 0, 512, 512, W0IN, 1024, C_QA, 0, C2, 0, scr, lane, gw, NGW, rot);
        tr_job(ewin, 2500, 1024, 512, 128, 128, W0IN, 1024, C_CKV, 0, 1.f, 0, scr, lane, gw, NGW, rot);
        tr_job(ewin, 2500, 1024, 640, 256, 256, W0IN, 1024, C_QIDX, 0, 1.f, 0, scr, lane, gw, NGW, rot);
        tr_job(ewin, 2500, 1024, 896, 64, 64, W0IN, 1024, C_KIDX, 0, 1.f, 0, scr, lane, gw, NGW, rot);
        tr_job(ewin, 2500, 1024, 964, 512, 512, W0IN, 1024, C_QB, 0, C2, 0, scr, lane, gw, NGW, rot);
        tr_job(ewin, 2500, 1024, 1476, 512, 512, W0IN, 1024, C_KB, 0, 1.f, 0, scr, lane, gw, NGW, rot);
        tr_job(ewin, 2500, 1024, 1988, 512, 512, W0IN, 1024, C_VB, 0, 1.f, 0, scr, lane, gw, NGW, rot);
        tr_job(ewin, 2500, 1024, 960, 64, 4, W0IN, 1024, C_WIDX, 0, 1.f, 0, scr, lane, gw, NGW, rot);
        tr_job(args.in[I_EWOUT], 1024, 1024, 0, 1024, 1024, W0OUT, KO0, 0, 0, 1.f, 0, scr, lane, gw, NGW, rot);
        { bf16* WUKT = (bf16*)(ws + WS_WUKT); bf16* WUVT = (bf16*)(ws + WS_WUVT); const float* wuk = args.in[I_EWUK]; const float* wuv = args.in[I_EWUV];
          for (int e = bx * NTHR + tid; e < 8 * 128 * 64; e += G * NTHR) { const int h = e >> 13, r = (e >> 6) & 127, d = e & 63;
              WUKT[e] = (bf16)f2bf(wuk[(h * 64 + d) * 128 + r]); WUVT[(h * 64 + d) * 128 + r] = (bf16)f2bf(wuv[(h * 128 + r) * 64 + d]); } }
        for (int l = 0; l < 2; ++l) {
            tr_job(args.in[I_FG] + (size_t)l * 1024 * DFF, DFF, 1024, 0, DFF, DFF, l ? WGU1 : WGU0, 1024, 0, 0, 1.f, 1, scr, lane, gw, NGW, rot);
            tr_job(args.in[I_FU] + (size_t)l * 1024 * DFF, DFF, 1024, 0, DFF, DFF, l ? WGU1 : WGU0, 1024, 0, 0, 1.f, 2, scr, lane, gw, NGW, rot);
            tr_job(args.in[I_FD] + (size_t)l * DFF * 1024, 1024, DFF, 0, 1024, 1024, l ? WDN1 : WDN0, DFF, 0, 0, 1.f, 0, scr, lane, gw, NGW, rot);
        }
        tr_job(args.in[I_OWIN], 3072, 1024, 0, 1024, 1024, W1IN, 1024, 0, 0, C2, 0, scr, lane, gw, NGW, rot);
        tr_job(args.in[I_OWIN], 3072, 1024, 1024, 2048, 2048, W1IN, 1024, 1024, 0, 1.f, 0, scr, lane, gw, NGW, rot);
        tr_job(args.in[I_OWOUT], 1024, 1024, 0, 1024, 1024, W1OUT, 1024, 0, 0, 1.f, 0, scr, lane, gw, NGW, rot);
        { const float* x = args.in[I_X]; const size_t nchunk = (size_t)M * DM / 8;
          for (size_t i = (size_t)bx * NTHR + tid; i < nchunk; i += (size_t)G * NTHR) { const f32x4 a = __builtin_nontemporal_load((const f32x4*)(x + 8 * i)), b = __builtin_nontemporal_load((const f32x4*)(x + 8 * i + 4));
              v4u o; o.x = pk2(a[0], a[1]); o.y = pk2(a[2], a[3]); o.z = pk2(b[0], b[1]); o.w = pk2(b[2], b[3]); *(v4u*)(X + 8 * i) = o; } }
    }
    SEAM(0);
    if (IN(1)) REP(1) { PHASE_IDS(); pg8::Gemm g{X, W0IN, M, NQ0, DM}; pg8::StaticOrder S; S.init(M, NQ0, G, bx); pg8::EpiBf16<0> E{R1, NQ0, nullptr, 0, 0, 1.f};
        pg8::gemm_phase<pg8::EpiBf16<0>, pg8::StaticOrder, true, true>(lds, g, S, E); }
    SEAM(1);
    if (IN(2)) REP(2) { PHASE_IDS();
        const float* kvn = args.in[I_EKVN];
        for (int m = gw; m < M; m += NGW) { const unsigned wv = *(const unsigned*)(R1 + (size_t)m * NQ0 + C_CKV + 2 * lane); const float a = bflo(wv), b = bfhi(wv);
            const float r = 1.f / sqrtf(wave_sum(a * a + b * b) * (1.f / 128.f) + 1e-6f);
            *(unsigned*)(CKVN + (size_t)m * 128 + 2 * lane) = pk2(a * r * kvn[2 * lane], b * r * kvn[2 * lane + 1]);
            if (lane < 32) *(unsigned*)((bf16*)(ws + WS_KIDXC) + (size_t)m * 64 + 2 * lane) = *(const unsigned*)(R1 + (size_t)m * NQ0 + C_KIDX + 2 * lane); }
        for (int u = gw; u < BATCH * 8 * (SEQ / 32); u += NGW) { const int qt = (SEQ / 32 - 1) - (u / (BATCH * 8)), bh = u % (BATCH * 8); stick_unit(R1, OCAT, bh >> 3, bh & 7, qt, lane); }
    }
    SEAM(2);
    if (IN(3)) REP(3) { PHASE_IDS(); unsigned long long pacc = 0ull;
        if (G == 256 && !(DUP_MASK >> 3 & 1)) {
            unsigned* qctr = (unsigned*)ws + 8192 + 2048 + 64 * (bx & 7);
            const int b = bx & 7;
            if (tid == 0) MISC[4] = __hip_atomic_fetch_add(qctr, 1u, __ATOMIC_RELAXED, __HIP_MEMORY_SCOPE_AGENT);
            __syncthreads();
            int L = (int)MISC[4];
            while (L < 128) { unsigned nxt = 0u;
                if (tid == 0) nxt = __hip_atomic_fetch_add(qctr, 1u, __ATOMIC_RELAXED, __HIP_MEMORY_SCOPE_AGENT);
                dsa_unit(R1, (const bf16*)(ws + WS_KIDXC), CKVN, (const bf16*)(ws + WS_WUKT), (const bf16*)(ws + WS_WUVT), OCAT, b, 127 - L, lds, tid, wave, lane, true, 127, pacc);
                if (tid == 0) MISC[4] = nxt;
                __syncthreads();
                L = (int)MISC[4];
                __syncthreads(); }
        } else {
        const int nun = (G == 256) ? 4 : (BATCH * 128 - bx + G - 1) / G;
#ifndef DSA_ORDER
#define DSA_ORDER(i, j) ((i) == 0 ? 127 - (j) : (i) == 1 ? 64 + (j) : (i) == 2 ? 63 - (j) : (j))
#endif
#ifndef DSA_DUMMY_MASK
#define DSA_DUMMY_MASK 15
#endif
#ifdef DSA_DUP_SEARCH
        for (int i2 = 0; i2 < 2 * nun; ++i2) { const int i = i2 >> 1; const bool do_att = (i2 & 1) != 0; int b, qt;
#else
        for (int i = 0; i < nun; ++i) { const bool do_att = true; int b, qt;
#endif
            if (G == 256) { const int j = vcu & 31; b = vcu >> 5; qt = DSA_ORDER(i, j); }
            else { const int u = bx + i * G; b = u >> 7; qt = u & 127; }
            dsa_unit(R1, (const bf16*)(ws + WS_KIDXC), CKVN, (const bf16*)(ws + WS_WUKT), (const bf16*)(ws + WS_WUVT), OCAT, b, qt, lds, tid, wave, lane, do_att, do_att ? 127 : DSA_DUMMY_MASK, pacc); }
        }
#ifdef DSA_TSEC
        { const unsigned long long t0_ = __builtin_amdgcn_s_memrealtime(); while (__builtin_amdgcn_s_memrealtime() - t0_ < 4ull * pacc) __builtin_amdgcn_s_sleep(8); __syncthreads(); }
#endif
    }
#ifdef DSA_TSEC
    if (IN(3)) {   }
#endif
    SEAM(3);
    if (IN(4)) REP(4) { PHASE_IDS(); pg8::Gemm g{OCAT, W0OUT, M, DM, KO0}; pg8::StaticOrder S; S.init(M, DM, G, bx); pg8::EpiResid E{(DUP_MASK >> 4 & 1) && rep_ == 0 ? R1 : X, DM, ALPHA};
        pg8::gemm_phase<pg8::EpiResid, pg8::StaticOrder, true, true>(lds, g, S, E); }
    SEAM(4);
    if (IN(5)) REP(5) { PHASE_IDS(); for (int m = gw; m < M; m += NGW) ln_row<false>(X + (size_t)m * DM, args.in[I_LNMG], args.in[I_LNMB], nullptr, lane); }
    SEAM(5);
    if (IN(6)) REP(6) { PHASE_IDS(); pg8::Gemm g{X, WGU0, M, NGU, DM}; pg8::StaticOrder S; S.init(M, NGU, G, bx); pg8::EpiSwiGLU E{R1, DFF};
        pg8::gemm_phase<pg8::EpiSwiGLU, pg8::StaticOrder, true, true>(lds, g, S, E); }
    SEAM(6);
    if (IN(7)) REP(7) { PHASE_IDS(); pg8::Gemm g{R1, WDN0, M, DM, DFF}; pg8::StaticOrder S; S.init(M, DM, G, bx); pg8::EpiResid E{(DUP_MASK >> 7 & 1) && rep_ == 0 ? OCAT : X, DM, ALPHA};
        pg8::gemm_phase<pg8::EpiResid, pg8::StaticOrder, true, true>(lds, g, S, E); }
    SEAM(7);
    if (IN(8)) REP(8) { PHASE_IDS(); for (int m = gw; m < M; m += NGW) ln_row<false>(X + (size_t)m * DM, args.in[I_LNFG], args.in[I_LNFB], nullptr, lane); }
    SEAM(8);
    if (IN(9)) REP(9) { PHASE_IDS(); pg8::Gemm g{X, W1IN, M, NQ1, DM}; pg8::StaticOrder S; S.init(M, NQ1, G, bx); pg8::EpiBf16<0> E{R1, NQ1, nullptr, 0, 0, 1.f};
        pg8::gemm_phase<pg8::EpiBf16<0>, pg8::StaticOrder, true, true>(lds, g, S, E); }
    SEAM(9);
    if (IN(10)) REP(10) { PHASE_IDS();
        float* KN2 = (float*)(ws + WS_KN2);
        for (int u = gw; u < BATCH * 16 * 16; u += NGW) { const int b = u >> 8, h = (u >> 4) & 15, n = u & 15;
            const bf16* kp = R1 + ((size_t)b * SEQ + 256 * n + (lane >> 5)) * NQ1 + 1024 + h * 64 + 2 * (lane & 31);
            float s0 = 0.f, s1 = 0.f, nmax = 0.f;
#pragma unroll 4
            for (int i = 0; i < 128; ++i) { const unsigned wv = *(const unsigned*)(kp + (size_t)(2 * i) * NQ1); const float k0 = bflo(wv), k1 = bfhi(wv);
                s0 += k0; s1 += k1;
                float n2 = k0 * k0 + k1 * k1;
                n2 += __builtin_bit_cast(float, __builtin_amdgcn_update_dpp(0, __builtin_bit_cast(int, n2), 0xB1, 0xf, 0xf, false));
                n2 += __builtin_bit_cast(float, __builtin_amdgcn_update_dpp(0, __builtin_bit_cast(int, n2), 0x4E, 0xf, 0xf, false));
                n2 += __builtin_bit_cast(float, __builtin_amdgcn_update_dpp(0, __builtin_bit_cast(int, n2), 0x124, 0xf, 0xf, false));
                n2 += __builtin_bit_cast(float, __builtin_amdgcn_update_dpp(0, __builtin_bit_cast(int, n2), 0x128, 0xf, 0xf, false));
                { auto sw = __builtin_amdgcn_permlane16_swap(__float_as_uint(n2), __float_as_uint(n2), false, false); n2 = __uint_as_float(sw[0]) + __uint_as_float(sw[1]); }
                nmax = __builtin_fmaxf(nmax, n2);
                if ((i & 31) == 31) {
                    const float m = __builtin_fmaxf(nmax, __shfl_xor(nmax, 32));
                    if (lane == 0) KN2[(size_t)u * 4 + (i >> 5)] = m; nmax = 0.f; } }
            s0 += __shfl_xor(s0, 32); s1 += __shfl_xor(s1, 32);
            if (lane < 32) { float* o = KMEAN + (size_t)u * 64 + 2 * lane; o[0] = s0 * (1.f / 256.f); o[1] = s1 * (1.f / 256.f); } }
    }
    SEAM(10);
    if (IN(11)) REP(11) { PHASE_IDS();
        for (size_t e = (size_t)bx * NTHR + tid; e < (size_t)M * 16; e += (size_t)G * NTHR) {
            const int h = (int)(e / M); const int m = (int)(e % M); const int b = m / SEQ, t = m % SEQ, cur = t >> 8;
            float q[64];
            { const bf16* qp = R1 + (size_t)m * NQ1 + h * 64;
#pragma unroll
              for (int i = 0; i < 8; ++i) { const v4u wv = *(const v4u*)(qp + 8 * i); q[8 * i] = bflo(wv.x); q[8 * i + 1] = bfhi(wv.x); q[8 * i + 2] = bflo(wv.y); q[8 * i + 3] = bfhi(wv.y);
                  q[8 * i + 4] = bflo(wv.z); q[8 * i + 5] = bfhi(wv.z); q[8 * i + 6] = bflo(wv.w); q[8 * i + 7] = bfhi(wv.w); } }
            float g0 = -INFINITY, g1 = -INFINITY, g2 = -INFINITY; int i0 = -1, i1 = -1, i2 = -1;
            for (int n = 0; n < cur; ++n) { const float* km = KMEAN + ((size_t)(b * 16 + h) * 16 + n) * 64; float s = 0.f;
#pragma unroll
                for (int d4 = 0; d4 < 16; ++d4) { const f32x4 kv = *(const f32x4*)(km + 4 * d4); s = __builtin_fmaf(q[4 * d4], kv[0], s); s = __builtin_fmaf(q[4 * d4 + 1], kv[1], s); s = __builtin_fmaf(q[4 * d4 + 2], kv[2], s); s = __builtin_fmaf(q[4 * d4 + 3], kv[3], s); }
                if (s > g0) { g2 = g1; i2 = i1; g1 = g0; i1 = i0; g0 = s; i0 = n; } else if (s > g1) { g2 = g1; i2 = i1; g1 = s; i1 = n; } else if (s > g2) { g2 = s; i2 = n; } }
            unsigned mask = 1u << cur; if (i0 >= 0) mask |= 1u << i0; if (i1 >= 0) mask |= 1u << i1; if (i2 >= 0) mask |= 1u << i2;
            ALLOW[(size_t)m * 16 + h] = (unsigned short)mask; }
    }
    SEAM(11);
    if (IN(12)) REP(12) { PHASE_IDS();
        const float* KN2 = (const float*)(ws + WS_KN2);
        if (G == 256) {
            unsigned* qctr = (unsigned*)ws + 8192 + 64 * (bx & 7) + 1024 * rep_;
            const int b = bx & 7;
            if (tid == 0) MISC[4] = __hip_atomic_fetch_add(qctr, 1u, __ATOMIC_RELAXED, __HIP_MEMORY_SCOPE_AGENT);
            __syncthreads();
            int L = (int)MISC[4];
            while (L < 256) { unsigned nxt = 0u;
                if (tid == 0) nxt = __hip_atomic_fetch_add(qctr, 1u, __ATOMIC_RELAXED, __HIP_MEMORY_SCOPE_AGENT);
                const int qb = 15 - (L >> 4), h = 15 - (L & 15);
#ifdef MOBA_PROBE_NOBIAS
                if ((DUP_MASK >> 12 & 1) && rep_ == 0) moba::attn_unit<8, false>(b, h, qb, (const moba::bf16*)R1, (const moba::bf16*)(R1 + 1024), (const moba::bf16*)(R1 + 2048), (moba::bf16*)OCAT, ALLOW, KN2 + (size_t)(b * 16 + h) * 64,
                                   LOG2E * __builtin_amdgcn_exp2f(-0.5f * (float)(h + 1)), (char*)lds_raw); else
#endif
                moba::attn_unit<8>(b, h, qb, (const moba::bf16*)R1, (const moba::bf16*)(R1 + 1024), (const moba::bf16*)(R1 + 2048), (moba::bf16*)OCAT, ALLOW, KN2 + (size_t)(b * 16 + h) * 64,
                                   LOG2E * __builtin_amdgcn_exp2f(-0.5f * (float)(h + 1)), (char*)lds_raw);
                if (tid == 0) MISC[4] = nxt;
                __syncthreads();
                L = (int)MISC[4];
                __syncthreads(); }
        } else for (int u = bx; u < BATCH * 256; u += G) { const int b = u >> 8, h = (u >> 4) & 15, qb = 15 - (u & 15);
            moba::attn_unit<8>(b, h, qb, (const moba::bf16*)R1, (const moba::bf16*)(R1 + 1024), (const moba::bf16*)(R1 + 2048), (moba::bf16*)OCAT, ALLOW, KN2 + (size_t)(b * 16 + h) * 64,
                               LOG2E * __builtin_amdgcn_exp2f(-0.5f * (float)(h + 1)), (char*)lds_raw); }
    }
    SEAM(12);
    if (IN(13)) REP(13) { PHASE_IDS(); pg8::Gemm g{OCAT, W1OUT, M, DM, DM}; pg8::StaticOrder S; S.init(M, DM, G, bx); pg8::EpiResid E{X, DM, ALPHA};
        pg8::gemm_phase<pg8::EpiResid, pg8::StaticOrder, true, true>(lds, g, S, E); }
    SEAM(13);
    if (IN(14)) REP(14) { PHASE_IDS(); for (int m = gw; m < M; m += NGW) ln_row<false>(X + (size_t)m * DM, args.in[I_LNMG] + DM, args.in[I_LNMB] + DM, nullptr, lane); }
    SEAM(14);
    if (IN(15)) REP(15) { PHASE_IDS(); pg8::Gemm g{X, WGU1, M, NGU, DM}; pg8::StaticOrder S; S.init(M, NGU, G, bx); pg8::EpiSwiGLU E{R1, DFF};
        pg8::gemm_phase<pg8::EpiSwiGLU, pg8::StaticOrder, true, true>(lds, g, S, E); }
    SEAM(15);
    if (IN(16)) REP(16) { PHASE_IDS(); pg8::Gemm g{R1, WDN1, M, DM, DFF}; pg8::StaticOrder S; S.init(M, DM, G, bx); pg8::EpiResid E{X, DM, ALPHA};
        pg8::gemm_phase<pg8::EpiResid, pg8::StaticOrder, true, true>(lds, g, S, E); }
    SEAM(16);
    if (IN(17)) REP(17) { PHASE_IDS(); for (int m = gw; m < M; m += NGW) ln_row<true>(X + (size_t)m * DM, args.in[I_LNFG] + DM, args.in[I_LNFB] + DM, args.out + (size_t)m * DM, lane); }
#undef IN
#undef SEAM
}

#ifndef MK_N_LAUNCHES
#define MK_N_LAUNCHES 1
#endif
extern "C" void kernel_launch(void* const* d_in, const int* in_sizes, int n_in, void* d_out, int out_size, void* d_ws, size_t ws_size, hipStream_t stream) {
    static int grid = 0;
    if (grid == 0) {
        if (n_in != 15 || in_sizes[0] != M * DM || out_size != M * DM || ws_size < WS_END) { fprintf(stderr, "kernel_launch: unexpected shapes (n_in %d, in0 %d, out %d, ws %zu); nothing launched\n", n_in, n_in > 0 ? in_sizes[0] : -1, out_size, ws_size); grid = -1; return; }
        int dev = 0, cus = 0, per_cu = 0;
        if (hipGetDevice(&dev) != hipSuccess || hipDeviceGetAttribute(&cus, hipDeviceAttributeMultiprocessorCount, dev) != hipSuccess) { grid = -1; return; }
        if (hipFuncSetAttribute((const void*)mega_fwd, hipFuncAttributeMaxDynamicSharedMemorySize, LDS_BYTES) != hipSuccess) { fprintf(stderr, "kernel_launch: hipFuncSetAttribute failed\n"); grid = -1; return; }
        if (hipOccupancyMaxActiveBlocksPerMultiprocessor(&per_cu, (const void*)mega_fwd, NTHR, LDS_BYTES) != hipSuccess || per_cu < 1) { fprintf(stderr, "kernel_launch: occupancy query reports %d\n", per_cu); per_cu = 1; }
        (void)hipGetLastError();
        grid = cus;
    }
    if (grid < 0) return;
    if (hipMemsetAsync(d_ws, 0, 65536, stream) != hipSuccess) { fprintf(stderr, "kernel_launch: hipMemsetAsync failed\n"); return; }
    Args a{};
    for (int i = 0; i < 15; ++i) a.in[i] = (const float*)d_in[i];
    a.out = (float*)d_out; a.ws = (unsigned char*)d_ws;
    if (MK_N_LAUNCHES == 1) {
        a.ph_lo = 0; a.ph_hi = NPHASE;
        void* kargs[] = {&a};
        hipError_t e = hipLaunchCooperativeKernel((const void*)mega_fwd, dim3(grid), dim3(NTHR), kargs, LDS_BYTES, stream);
        if (e != hipSuccess) fprintf(stderr, "kernel_launch: cooperative launch failed: %s (grid %d)\n", hipGetErrorString(e), grid);
    } else {
        for (int p = 0; p < NPHASE; ++p) { a.ph_lo = p; a.ph_hi = p + 1; hipLaunchKernelGGL(mega_fwd, dim3(grid), dim3(NTHR), LDS_BYTES, stream, a); }
    }
}
```
